# Optimizing an MI355X kernel written in HIP

```python
import jax, jax.numpy as jnp
from jax import lax
import numpy as np

D_MODEL = 2048
BATCH = 8
SEQ = 2048
DEPTH = 1

P_DIM = 256
CHUNK = 64
MIX_WIDTH = D_MODEL
MLSTM_WIDTH = MIX_WIDTH // 2
MLSTM_HEADS = 8
MLSTM_HEAD_DIM = MLSTM_WIDTH // MLSTM_HEADS
QK_CONV = 4
POOL_WIDTH = MIX_WIDTH - MLSTM_WIDTH
POOL_WINDOWS = (2, 4, 8, 16)
POOL_GROUPS = len(POOL_WINDOWS)
POOL_GROUP_WIDTH = POOL_WIDTH // POOL_GROUPS
D_FF = 4 * D_MODEL
IN_COLS = 4 * MLSTM_WIDTH + 2 * MLSTM_HEADS + POOL_WIDTH
SPLITS = [MLSTM_WIDTH, 2 * MLSTM_WIDTH, 3 * MLSTM_WIDTH, 4 * MLSTM_WIDTH,
          4 * MLSTM_WIDTH + MLSTM_HEADS, 4 * MLSTM_WIDTH + 2 * MLSTM_HEADS]
EPS = 1e-6

kernel_name = "hybrid_mlstm_pool_stream_block"


def rms_norm(x, g):
    xf = x.astype(jnp.float32)
    y = xf * lax.rsqrt(jnp.mean(xf * xf, axis=-1, keepdims=True) + EPS)
    return (y * g.astype(jnp.float32)).astype(x.dtype)


def causal_depthwise_conv(x, w):
    K = w.shape[0]
    S = x.shape[1]
    xp = jnp.pad(x, ((0, 0), (K - 1, 0), (0, 0)))
    y = xp[:, 0:S] * w[0]
    for k in range(1, K):
        y = y + xp[:, k:k + S] * w[k]
    return y


def mlstm_chunkwise(q, k, v, log_i, log_f):
    B, S, H, Dh = q.shape
    L = CHUNK
    NC = S // L

    def to_chunks(t):
        t = t.reshape((B, NC, L, H) + t.shape[3:])
        return jnp.moveaxis(t, 3, 1)

    qc = to_chunks(q)
    kc = to_chunks(k) * (Dh ** -0.5)
    vc = to_chunks(v)
    li = to_chunks(log_i)
    lf = to_chunks(log_f)
    b = jnp.cumsum(lf, axis=-1)
    b_tot = b[..., -1]
    a = b_tot[..., None] - b + li
    a_max = jnp.max(a, axis=-1)

    def step(carry, xs):
        C, n, m = carry
        k_c, v_c, a_c, amax_c, btot_c = xs
        m_new = jnp.maximum(btot_c + m, amax_c)
        decay = jnp.exp(btot_c + m - m_new)
        w = jnp.exp(a_c - m_new[..., None])
        C_new = decay[..., None, None] * C + jnp.einsum('bhl,bhld,bhle->bhde', w, v_c, k_c)
        n_new = decay[..., None] * n + jnp.einsum('bhl,bhle->bhe', w, k_c)
        return (C_new, n_new, m_new), (C, n, m)

    xs = (jnp.moveaxis(kc, 2, 0), jnp.moveaxis(vc, 2, 0), jnp.moveaxis(a, 2, 0),
          jnp.moveaxis(a_max, 2, 0), jnp.moveaxis(b_tot, 2, 0))
    init = (jnp.zeros((B, H, Dh, Dh), jnp.float32),
            jnp.zeros((B, H, Dh), jnp.float32),
            jnp.zeros((B, H), jnp.float32))
    _, (C_prev, n_prev, m_prev) = lax.scan(step, init, xs)
    C_prev = jnp.moveaxis(C_prev, 0, 2)
    n_prev = jnp.moveaxis(n_prev, 0, 2)
    m_prev = jnp.moveaxis(m_prev, 0, 2)

    inter_log = b + m_prev[..., None]
    causal = jnp.tril(jnp.ones((L, L), dtype=bool))
    Dlog = b[..., :, None] - b[..., None, :] + li[..., None, :]
    Dlog = jnp.where(causal, Dlog, -jnp.inf)
    m_t = jnp.maximum(inter_log, jnp.max(Dlog, axis=-1))
    Dw = jnp.exp(Dlog - m_t[..., None])
    inter_w = jnp.exp(inter_log - m_t)
    s = jnp.einsum('bhcld,bhcjd->bhclj', qc, kc) * Dw
    num = (inter_w[..., None] * jnp.einsum('bhcde,bhcle->bhcld', C_prev, qc)
           + jnp.einsum('bhclj,bhcjd->bhcld', s, vc))
    den = inter_w * jnp.einsum('bhce,bhcle->bhcl', n_prev, qc) + jnp.sum(s, axis=-1)
    h = num / jnp.maximum(jnp.abs(den), jnp.exp(-m_t))[..., None]
    return jnp.moveaxis(h, 1, 3).reshape(B, S, H, Dh)


def multiscale_pool(u, w_pool, scale):
    B, S, _ = u.shape
    uf = u.astype(jnp.float32)
    cs = jnp.pad(jnp.cumsum(uf, axis=1), ((0, 0), (1, 0), (0, 0)))
    t1 = jnp.arange(1, S + 1, dtype=jnp.float32)
    outs = []
    for g, w in enumerate(POOL_WINDOWS):
        sl = slice(g * POOL_GROUP_WIDTH, (g + 1) * POOL_GROUP_WIDTH)
        hi = cs[:, 1:, sl]
        lo = jnp.pad(cs[:, :S + 1 - w, sl], ((0, 0), (w - 1, 0), (0, 0)))
        mean = (hi - lo) / jnp.minimum(t1, w)[None, :, None]
        outs.append(mean - uf[..., sl])
    pooled = jnp.stack(outs, axis=2).astype(u.dtype)
    mixed = jnp.einsum('bsgc,gcd->bsgd', pooled, w_pool)
    return mixed.reshape(B, S, POOL_WIDTH) * scale


def setup_inputs(seed: int = 0) -> dict:
    key = jax.random.key(seed)
    ks = jax.random.split(key, 24)
    H = MLSTM_HEADS
    nrm = lambda k, shape, s: jax.random.normal(k, shape, jnp.float32) * s
    gain = lambda k, shape: 1.0 + 0.05 * jax.random.normal(k, shape, jnp.float32)
    f_bias = jnp.linspace(3.0, 6.0, H, dtype=jnp.float32)
    b_gates = jnp.concatenate([
        nrm(ks[3], (DEPTH, H), 0.1),
        f_bias[None, :] + nrm(ks[4], (DEPTH, H), 0.1)], axis=-1)
    return {
        "x": nrm(ks[0], (BATCH, SEQ, D_MODEL), 1.0),
        "p": nrm(ks[1], (DEPTH, BATCH, SEQ, P_DIM), 1.0),
        "w_in": nrm(ks[2], (DEPTH, D_MODEL, IN_COLS), D_MODEL ** -0.5),
        "b_gates": b_gates,
        "w_qk_conv": nrm(ks[5], (DEPTH, QK_CONV, 2 * MLSTM_WIDTH), QK_CONV ** -0.5),
        "g_mlstm": gain(ks[6], (DEPTH, MLSTM_WIDTH)),
        "w_pool": nrm(ks[7], (DEPTH, POOL_GROUPS, POOL_GROUP_WIDTH, POOL_GROUP_WIDTH), POOL_GROUP_WIDTH ** -0.5),
        "pool_scale": gain(ks[8], (DEPTH, POOL_WIDTH)),
        "w_out": nrm(ks[9], (DEPTH, MIX_WIDTH, D_MODEL), MIX_WIDTH ** -0.5),
        "g_mix_pre": gain(ks[10], (DEPTH, D_MODEL)),
        "g_mix_post": gain(ks[11], (DEPTH, D_MODEL)),
        "w_ff1": nrm(ks[12], (DEPTH, D_MODEL, D_FF), D_MODEL ** -0.5),
        "w_ff2": nrm(ks[13], (DEPTH, D_FF, D_MODEL), D_FF ** -0.5),
        "g_ff_pre": gain(ks[14], (DEPTH, D_MODEL)),
        "g_ff_post": gain(ks[15], (DEPTH, D_MODEL)),
        "w_ple_proj": nrm(ks[16], (DEPTH, P_DIM, D_MODEL), P_DIM ** -0.5),
        "w_ple_gate": nrm(ks[17], (DEPTH, D_MODEL, D_MODEL), D_MODEL ** -0.5),
        "g_ple_gate": gain(ks[18], (DEPTH, D_MODEL)),
        "g_ple_post": gain(ks[19], (DEPTH, D_MODEL)),
    }


def reference(x, p, w_in, b_gates, w_qk_conv, g_mlstm, w_pool, pool_scale, w_out,
              g_mix_pre, g_mix_post, w_ff1, w_ff2, g_ff_pre, g_ff_post,
              w_ple_proj, w_ple_gate, g_ple_gate, g_ple_post):
    B, S, _ = x.shape
    H, Dh = MLSTM_HEADS, MLSTM_HEAD_DIM
    h = x
    for i in range(DEPTH):
        xn = rms_norm(h, g_mix_pre[i])
        proj = xn @ w_in[i]
        q, k, v, o, gi, gf, u = jnp.split(proj, SPLITS, axis=-1)
        qk = jax.nn.silu(causal_depthwise_conv(jnp.concatenate([q, k], axis=-1), w_qk_conv[i]))
        q, k = jnp.split(qk, 2, axis=-1)
        gates = jnp.concatenate([gi, gf], axis=-1).astype(jnp.float32) + b_gates[i].astype(jnp.float32)
        log_i = gates[..., :H]
        log_f = jax.nn.log_sigmoid(gates[..., H:])
        cell = mlstm_chunkwise(q.reshape(B, S, H, Dh).astype(jnp.float32),
                               k.reshape(B, S, H, Dh).astype(jnp.float32),
                               v.reshape(B, S, H, Dh).astype(jnp.float32),
                               log_i, log_f).astype(x.dtype)
        cell = rms_norm(cell, g_mlstm[i].reshape(H, Dh))
        h_ml = (jax.nn.sigmoid(o).reshape(B, S, H, Dh) * cell).reshape(B, S, MLSTM_WIDTH)
        h_pool = multiscale_pool(u, w_pool[i], pool_scale[i])
        mix = jnp.concatenate([h_ml, h_pool], axis=-1) @ w_out[i]
        h = h + rms_norm(mix, g_mix_post[i])
        hn = rms_norm(h, g_ff_pre[i])
        ff = jnp.square(jax.nn.relu(hn @ w_ff1[i])) @ w_ff2[i]
        h = h + rms_norm(ff, g_ff_post[i])
        gate = jax.nn.sigmoid(rms_norm(h, g_ple_gate[i]) @ w_ple_gate[i])
        e = p[i] @ w_ple_proj[i]
        h = h + rms_norm(e * gate, g_ple_post[i])
    return h
```

```cpp
#include <hip/hip_runtime.h>
#include <cstdio>
#include <cstdint>

constexpr int BATCH = 8, SEQ = 2048, DM = 2048, PD = 256, NH = 8, DH = 128, MW = 1024, PW = 1024, DFF = 8192;
constexpr int INC = 5136;
constexpr int C_Q = 0, C_K = 1024, C_V = 2048, C_O = 3072, C_GI = 4096, C_GF = 4104, C_U = 4112;
constexpr float EPS = 1e-6f;

__device__ __forceinline__ float wave_sum(float v) {
#pragma unroll
    for (int o = 1; o < 64; o <<= 1) v += __shfl_xor(v, o);
    return v;
}
__device__ __forceinline__ float sigmoidf_(float x) { return 1.0f / (1.0f + expf(-x)); }

__global__ void __launch_bounds__(256) k_rms0(const float* __restrict__ x, const float* __restrict__ g, float* __restrict__ out, int rows) {
    const int row = blockIdx.x * 4 + (threadIdx.x >> 6), lane = threadIdx.x & 63;
    if (row >= rows) return;
    const float* xr = x + (size_t)row * DM; float v[32]; float s = 0.f;
#pragma unroll
    for (int j = 0; j < 32; ++j) { v[j] = xr[lane + 64 * j]; s += v[j] * v[j]; }
    const float r = rsqrtf(wave_sum(s) * (1.0f / DM) + EPS);
#pragma unroll
    for (int j = 0; j < 32; ++j) out[(size_t)row * DM + lane + 64 * j] = v[j] * r * g[lane + 64 * j];
}
__global__ void __launch_bounds__(256) k_resnorm(const float* __restrict__ base, const float* __restrict__ y, const float* __restrict__ g1, const float* __restrict__ g2,
                                                 float* __restrict__ hout, float* __restrict__ nout, int rows) {
    const int row = blockIdx.x * 4 + (threadIdx.x >> 6), lane = threadIdx.x & 63;
    if (row >= rows) return;
    float v[32]; float s = 0.f;
#pragma unroll
    for (int j = 0; j < 32; ++j) { v[j] = y[(size_t)row * DM + lane + 64 * j]; s += v[j] * v[j]; }
    const float r = rsqrtf(wave_sum(s) * (1.0f / DM) + EPS);
    float s2 = 0.f;
#pragma unroll
    for (int j = 0; j < 32; ++j) { v[j] = base[(size_t)row * DM + lane + 64 * j] + v[j] * r * g1[lane + 64 * j]; s2 += v[j] * v[j]; }
    const float r2 = rsqrtf(wave_sum(s2) * (1.0f / DM) + EPS);
#pragma unroll
    for (int j = 0; j < 32; ++j) { hout[(size_t)row * DM + lane + 64 * j] = v[j]; if (nout) nout[(size_t)row * DM + lane + 64 * j] = v[j] * r2 * g2[lane + 64 * j]; }
}
__global__ void __launch_bounds__(256) k_final(const float* __restrict__ base, const float* __restrict__ e, const float* __restrict__ gp, const float* __restrict__ g,
                                               float* __restrict__ out, int rows) {
    const int row = blockIdx.x * 4 + (threadIdx.x >> 6), lane = threadIdx.x & 63;
    if (row >= rows) return;
    float v[32]; float s = 0.f;
#pragma unroll
    for (int j = 0; j < 32; ++j) { const size_t i = (size_t)row * DM + lane + 64 * j; v[j] = e[i] * sigmoidf_(gp[i]); s += v[j] * v[j]; }
    const float r = rsqrtf(wave_sum(s) * (1.0f / DM) + EPS);
#pragma unroll
    for (int j = 0; j < 32; ++j) { const size_t i = (size_t)row * DM + lane + 64 * j; out[i] = base[i] + v[j] * r * g[lane + 64 * j]; }
}

__global__ void __launch_bounds__(256) k_gemm(const float* __restrict__ A, int lda, const float* __restrict__ W, int ldw, float* __restrict__ C, int ldc,
                                              int M, int N, int K, int epi, const float* __restrict__ scale) {
    __shared__ float As[16][128 + 4];
    __shared__ float Bs[16][128 + 4];
    const int tid = threadIdx.x, tx = tid & 15, ty = tid >> 4;
    const int m0 = blockIdx.y * 128, n0 = blockIdx.x * 128;
    float acc[8][8];
#pragma unroll
    for (int i = 0; i < 8; ++i)
#pragma unroll
        for (int j = 0; j < 8; ++j) acc[i][j] = 0.f;
    const int ar = tid >> 1, ak = (tid & 1) * 8;
    const int bk = tid >> 4, bn = (tid & 15) * 8;
    for (int k0 = 0; k0 < K; k0 += 16) {
        const float4 a0 = *(const float4*)(A + (size_t)(m0 + ar) * lda + k0 + ak);
        const float4 a1 = *(const float4*)(A + (size_t)(m0 + ar) * lda + k0 + ak + 4);
        float4 b0 = make_float4(0.f, 0.f, 0.f, 0.f), b1 = b0;
        if (n0 + bn < N) b0 = *(const float4*)(W + (size_t)(k0 + bk) * ldw + n0 + bn);
        if (n0 + bn + 4 < N) b1 = *(const float4*)(W + (size_t)(k0 + bk) * ldw + n0 + bn + 4);
        __syncthreads();
        As[ak + 0][ar] = a0.x; As[ak + 1][ar] = a0.y; As[ak + 2][ar] = a0.z; As[ak + 3][ar] = a0.w;
        As[ak + 4][ar] = a1.x; As[ak + 5][ar] = a1.y; As[ak + 6][ar] = a1.z; As[ak + 7][ar] = a1.w;
        *(float4*)&Bs[bk][bn] = b0; *(float4*)&Bs[bk][bn + 4] = b1;
        __syncthreads();
#pragma unroll
        for (int kk = 0; kk < 16; ++kk) {
            float a[8], b[8];
            *(float4*)&a[0] = *(const float4*)&As[kk][ty * 4]; *(float4*)&a[4] = *(const float4*)&As[kk][64 + ty * 4];
            *(float4*)&b[0] = *(const float4*)&Bs[kk][tx * 4]; *(float4*)&b[4] = *(const float4*)&Bs[kk][64 + tx * 4];
#pragma unroll
            for (int i = 0; i < 8; ++i)
#pragma unroll
                for (int j = 0; j < 8; ++j) acc[i][j] = fmaf(a[i], b[j], acc[i][j]);
        }
    }
#pragma unroll
    for (int i = 0; i < 8; ++i) {
        const int m = m0 + (i < 4 ? ty * 4 + i : 64 + ty * 4 + (i - 4));
#pragma unroll
        for (int jj = 0; jj < 2; ++jj) {
            const int n = n0 + jj * 64 + tx * 4;
            if (n < N) {
                float4 o; o.x = acc[i][jj * 4 + 0]; o.y = acc[i][jj * 4 + 1]; o.z = acc[i][jj * 4 + 2]; o.w = acc[i][jj * 4 + 3];
                if (epi == 1) { o.x = fmaxf(o.x, 0.f); o.x *= o.x; o.y = fmaxf(o.y, 0.f); o.y *= o.y; o.z = fmaxf(o.z, 0.f); o.z *= o.z; o.w = fmaxf(o.w, 0.f); o.w *= o.w; }
                if (epi == 2) { o.x *= scale[n]; o.y *= scale[n + 1]; o.z *= scale[n + 2]; o.w *= scale[n + 3]; }
                *(float4*)(C + (size_t)m * ldc + n) = o;
            }
        }
    }
}

__global__ void __launch_bounds__(256) k_conv(const float* __restrict__ proj, const float* __restrict__ wc, float* __restrict__ qk) {
    const int idx = blockIdx.x * 256 + threadIdx.x;
    const int t = idx >> 11, c = idx & 2047;
    float y = 0.f;
#pragma unroll
    for (int k = 0; k < 4; ++k) { const int tt = t - 3 + k; if (tt >= 0) y += wc[k * 2048 + c] * proj[(size_t)tt * INC + c]; }
    qk[idx] = y * sigmoidf_(y);
}

__global__ void __launch_bounds__(256) k_mlstm(const float* __restrict__ proj, const float* __restrict__ qk, const float* __restrict__ bg, float* __restrict__ hcell) {
    const int h = blockIdx.x, tid = threadIdx.x, d = tid >> 1, half = tid & 1, e0 = half * 64;
    __shared__ float sq[128], sk[128], sv[128];
    float C[64], n[64];
#pragma unroll
    for (int j = 0; j < 64; ++j) { C[j] = 0.f; n[j] = 0.f; }
    float m = 0.f;
    const float bi = bg[h], bf = bg[8 + h];
    const float kscale = 0.08838834764831845f;
    for (int t = 0; t < SEQ; ++t) {
        __syncthreads();
        if (tid < 128) { sq[tid] = qk[(size_t)t * 2048 + h * 128 + tid]; sk[tid] = qk[(size_t)t * 2048 + 1024 + h * 128 + tid] * kscale; }
        else { sv[tid - 128] = proj[(size_t)t * INC + C_V + h * 128 + (tid - 128)]; }
        const float li = proj[(size_t)t * INC + C_GI + h] + bi;
        const float gf = proj[(size_t)t * INC + C_GF + h] + bf;
        const float lf = fminf(gf, 0.f) - log1pf(expf(-fabsf(gf)));
        __syncthreads();
        const float mn = fmaxf(lf + m, li);
        const float fd = expf(lf + m - mn), iw = expf(li - mn);
        m = mn;
        const float vd = sv[d] * iw;
        float num = 0.f, den = 0.f;
#pragma unroll
        for (int j = 0; j < 64; ++j) {
            const float kk = sk[e0 + j], qq = sq[e0 + j];
            C[j] = fd * C[j] + vd * kk;
            n[j] = fd * n[j] + iw * kk;
            num = fmaf(C[j], qq, num); den = fmaf(n[j], qq, den);
        }
        num += __shfl_xor(num, 1); den += __shfl_xor(den, 1);
        const float hv = num / fmaxf(fabsf(den), expf(-mn));
        if (half == 0) hcell[(size_t)t * MW + h * 128 + d] = hv;
    }
}
__global__ void __launch_bounds__(256) k_headnorm(const float* __restrict__ hcell, const float* __restrict__ proj, const float* __restrict__ gm, float* __restrict__ mix) {
    const int w = blockIdx.x * 4 + (threadIdx.x >> 6), lane = threadIdx.x & 63;
    const int t = w >> 3, h = w & 7;
    const float a = hcell[(size_t)t * MW + h * 128 + lane], b = hcell[(size_t)t * MW + h * 128 + 64 + lane];
    const float r = rsqrtf(wave_sum(a * a + b * b) * (1.0f / 128.0f) + EPS);
    const float oa = proj[(size_t)t * INC + C_O + h * 128 + lane], ob = proj[(size_t)t * INC + C_O + h * 128 + 64 + lane];
    mix[(size_t)t * DM + h * 128 + lane] = sigmoidf_(oa) * (a * r * gm[h * 128 + lane]);
    mix[(size_t)t * DM + h * 128 + 64 + lane] = sigmoidf_(ob) * (b * r * gm[h * 128 + 64 + lane]);
}
__global__ void __launch_bounds__(256) k_pool(const float* __restrict__ proj, float* __restrict__ pooled) {
    const int idx = blockIdx.x * 256 + threadIdx.x;
    const int t = idx >> 10, c = idx & 1023, g = c >> 8, w = 2 << g;
    float s = 0.f; int cnt = 0;
    for (int j = 0; j < w; ++j) { const int tt = t - j; if (tt >= 0) { s += proj[(size_t)tt * INC + C_U + c]; ++cnt; } }
    pooled[idx] = s / (float)cnt - proj[(size_t)t * INC + C_U + c];
}

static void gemm(const float* A, int lda, const float* W, int ldw, float* C, int ldc, int M, int N, int K, int epi, const float* scale, hipStream_t st) {
    dim3 grid((N + 127) / 128, M / 128);
    hipLaunchKernelGGL(k_gemm, grid, dim3(256), 0, st, A, lda, W, ldw, C, ldc, M, N, K, epi, scale);
}

extern "C" void kernel_launch(void* const* d_in, const int* in_sizes, int n_in, void* d_out, int out_size, void* d_ws, size_t ws_size, hipStream_t stream) {
    const float* x = (const float*)d_in[0];       const float* p = (const float*)d_in[1];        const float* w_in = (const float*)d_in[2];
    const float* b_gates = (const float*)d_in[3]; const float* w_conv = (const float*)d_in[4];   const float* g_mlstm = (const float*)d_in[5];
    const float* w_pool = (const float*)d_in[6];  const float* pool_scale = (const float*)d_in[7]; const float* w_out = (const float*)d_in[8];
    const float* g_mix_pre = (const float*)d_in[9]; const float* g_mix_post = (const float*)d_in[10]; const float* w_ff1 = (const float*)d_in[11];
    const float* w_ff2 = (const float*)d_in[12];  const float* g_ff_pre = (const float*)d_in[13]; const float* g_ff_post = (const float*)d_in[14];
    const float* w_ple_proj = (const float*)d_in[15]; const float* w_ple_gate = (const float*)d_in[16]; const float* g_ple_gate = (const float*)d_in[17];
    const float* g_ple_post = (const float*)d_in[18];
    float* out = (float*)d_out;
    float* ws = (float*)d_ws;
    const size_t S = SEQ;
    float* xn = ws;
    float* proj = xn + S * DM;
    float* qk = proj + S * INC;
    float* hcell = qk + S * DM;
    float* pooled = hcell + S * MW;
    float* mix = pooled + S * PW;
    float* mo = mix + S * DM;
    float* h1 = mo + S * DM;
    float* hn = h1 + S * DM;
    float* hid = hn + S * DM;
    float* ff = hid + S * DFF;
    float* h2 = ff + S * DM;
    float* hg = h2 + S * DM;
    float* gp = hg + S * DM;
    float* ee = gp + S * DM;
    for (int b = 0; b < BATCH; ++b) {
        const float* xb = x + (size_t)b * S * DM; const float* pb = p + (size_t)b * S * PD; float* ob = out + (size_t)b * S * DM;
        hipLaunchKernelGGL(k_rms0, dim3(SEQ / 4), dim3(256), 0, stream, xb, g_mix_pre, xn, SEQ);
        gemm(xn, DM, w_in, INC, proj, INC, SEQ, INC, DM, 0, nullptr, stream);
        hipLaunchKernelGGL(k_conv, dim3(SEQ * 2048 / 256), dim3(256), 0, stream, proj, w_conv, qk);
        hipLaunchKernelGGL(k_mlstm, dim3(NH), dim3(256), 0, stream, proj, qk, b_gates, hcell);
        hipLaunchKernelGGL(k_headnorm, dim3(SEQ * 8 / 4), dim3(256), 0, stream, hcell, proj, g_mlstm, mix);
        hipLaunchKernelGGL(k_pool, dim3(SEQ * 1024 / 256), dim3(256), 0, stream, proj, pooled);
        for (int g = 0; g < 4; ++g)
            gemm(pooled + g * 256, PW, w_pool + (size_t)g * 256 * 256, 256, mix + 1024 + g * 256, DM, SEQ, 256, 256, 2, pool_scale + g * 256, stream);
        gemm(mix, DM, w_out, DM, mo, DM, SEQ, DM, DM, 0, nullptr, stream);
        hipLaunchKernelGGL(k_resnorm, dim3(SEQ / 4), dim3(256), 0, stream, xb, mo, g_mix_post, g_ff_pre, h1, hn, SEQ);
        gemm(hn, DM, w_ff1, DFF, hid, DFF, SEQ, DFF, DM, 1, nullptr, stream);
        gemm(hid, DFF, w_ff2, DM, ff, DM, SEQ, DM, DFF, 0, nullptr, stream);
        hipLaunchKernelGGL(k_resnorm, dim3(SEQ / 4), dim3(256), 0, stream, h1, ff, g_ff_post, g_ple_gate, h2, hg, SEQ);
        gemm(hg, DM, w_ple_gate, DM, gp, DM, SEQ, DM, DM, 0, nullptr, stream);
        gemm(pb, PD, w_ple_proj, DM, ee, DM, SEQ, DM, PD, 0, nullptr, stream);
        hipLaunchKernelGGL(k_final, dim3(SEQ / 4), dim3(256), 0, stream, h2, ee, gp, g_ple_post, ob, SEQ);
    }
}
```

```cpp
#include <hip/hip_runtime.h>
#include <hip/hip_cooperative_groups.h>
#include <cstdio>
#include <cstdint>
namespace cg = cooperative_groups;

#ifndef N_LAUNCH_MODE
#define N_LAUNCH_MODE 1
#endif

namespace pg8 {
#define PG8_LAS __attribute__((address_space(3)))
typedef unsigned short bf16_t;
typedef short bf16x8 __attribute__((ext_vector_type(8)));
typedef float f32x4 __attribute__((ext_vector_type(4)));
typedef unsigned u32x4 __attribute__((ext_vector_type(4)));
typedef unsigned u32x2 __attribute__((ext_vector_type(2)));
constexpr int BM = 256, BK = 64, HALF = 128, HTB = HALF * BK * 2, STAGE_BYTES = 8 * HTB, NXCD = 8, WGM = 8;

__host__ __device__ __forceinline__ int lds_byte(int r, int c) { const int st = (r >> 4) * 2 + (c >> 5), rr = r & 15, cc = c & 31, ob = rr * 64 + cc * 2; return st * 1024 + (ob ^ (((ob >> 9) & 1) << 5)); }
__host__ __device__ __forceinline__ void stage_rc(int b, int& R, int& C) { const int st = b / 1024, sb = b % 1024, swz = sb ^ (((sb >> 9) & 1) << 5); R = (st >> 1) * 16 + swz / 64; C = (st & 1) * 32 + (swz % 64) / 2; }
__host__ __device__ __forceinline__ int perm32(int rho) { const int n = rho >> 4, i = rho & 15; return 8 * (i >> 2) + 4 * n + (i & 3); }

struct Unit { int pm, pn; };
struct Gemm { const bf16_t* A; const bf16_t* Bt; int lda, ldb, K, a_pn_off; };

struct StaticOrder {
    int nM, nN, nwg, G, c;
    __host__ __device__ void init(int M, int N, int G_, int c_) { nM = M / BM; nN = N / BM; nwg = nM * nN; G = G_; c = c_; }
    __host__ __device__ bool next(int i, Unit& u) const {
        const long L = (long)i * G + c; if (L >= nwg) return false;
        int wgid = (int)L; { const int q = nwg / NXCD, r = nwg % NXCD, xcd = wgid % NXCD, off = wgid / NXCD; wgid = (xcd < r ? xcd * (q + 1) : r * (q + 1) + (xcd - r) * q) + off; }
        const int nig = WGM * nN, gid = wgid / nig, fm = gid * WGM, gsz = (nM - fm) < WGM ? (nM - fm) : WGM;
        u.pm = fm + ((wgid % nig) % gsz); u.pn = (wgid % nig) / gsz; return true;
    }
};

__device__ __forceinline__ unsigned cvt_pk_bf16(float lo, float hi) { unsigned r; asm volatile("v_cvt_pk_bf16_f32 %0, %1, %2" : "=v"(r) : "v"(lo), "v"(hi)); return r; }

template <int ACT  > struct EpiBf16 {
    static constexpr bool PERM = true;
    bf16_t* O; int ldc; const float* cscale; int split_cols; size_t split_stride;
    __device__ __forceinline__ void operator()(const f32x4 (&acc)[2][2][4][2], const Unit& u, int wr, int wc, int fr, int fq) const {
        const int row0 = u.pm * BM + wr * 64 + fr; int colt = u.pn * BM; bf16_t* base = O;
        if (split_cols) { const int t = colt / split_cols; base += (size_t)t * split_stride; colt -= t * split_cols; }
        const int col0 = colt + wc * 32 + 8 * fq, bcol0 = u.pn * BM + wc * 32 + 8 * fq;
        f32x4 sv[2][2];
#pragma unroll
        for (int bj = 0; bj < 2; ++bj)
#pragma unroll
            for (int n = 0; n < 2; ++n) sv[bj][n] = cscale ? *(const f32x4*)(cscale + bcol0 + bj * HALF + 4 * n) : (f32x4){1.f, 1.f, 1.f, 1.f};
#pragma unroll
        for (int ai = 0; ai < 2; ++ai)
#pragma unroll
            for (int m = 0; m < 4; ++m) { bf16_t* rowp = base + (size_t)(row0 + ai * HALF + m * 16) * ldc + col0;
#pragma unroll
                for (int bj = 0; bj < 2; ++bj) { f32x4 v0 = acc[ai][bj][m][0], v1 = acc[ai][bj][m][1];
                    if (ACT == 1) {
#pragma unroll
                        for (int j = 0; j < 4; ++j) { const float a = fmaxf(v0[j], 0.f), b = fmaxf(v1[j], 0.f); v0[j] = a * a; v1[j] = b * b; } }
                    v0 = v0 * sv[bj][0]; v1 = v1 * sv[bj][1];
                    u32x4 w; w.x = cvt_pk_bf16(v0[0], v0[1]); w.y = cvt_pk_bf16(v0[2], v0[3]); w.z = cvt_pk_bf16(v1[0], v1[1]); w.w = cvt_pk_bf16(v1[2], v1[3]);
                    *(u32x4*)(rowp + bj * HALF) = w; } }
    }
};
struct EpiF32 {
    static constexpr bool PERM = false;
    float* C; int ldc;
    __device__ __forceinline__ void operator()(const f32x4 (&acc)[2][2][4][2], const Unit& u, int wr, int wc, int fr, int fq) const {
        const int row0 = u.pm * BM + wr * 64 + fr, col0 = u.pn * BM + wc * 32 + 4 * fq;
#pragma unroll
        for (int ai = 0; ai < 2; ++ai)
#pragma unroll
            for (int m = 0; m < 4; ++m) { float* rowp = C + (size_t)(row0 + ai * HALF + m * 16) * ldc + col0;
#pragma unroll
                for (int bj = 0; bj < 2; ++bj)
#pragma unroll
                    for (int n = 0; n < 2; ++n) *(f32x4*)(rowp + bj * HALF + n * 16) = acc[ai][bj][m][n]; }
    }
};
struct EpiGateMul {
    static constexpr bool PERM = false;
    const float* E; bf16_t* O; int ldc;
    __device__ __forceinline__ void operator()(const f32x4 (&acc)[2][2][4][2], const Unit& u, int wr, int wc, int fr, int fq) const {
        const int row0 = u.pm * BM + wr * 64 + fr, col0 = u.pn * BM + wc * 32 + 4 * fq;
#pragma unroll
        for (int ai = 0; ai < 2; ++ai)
#pragma unroll
            for (int m = 0; m < 4; ++m) { const size_t ro = (size_t)(row0 + ai * HALF + m * 16) * ldc + col0;
#pragma unroll
                for (int bj = 0; bj < 2; ++bj)
#pragma unroll
                    for (int n = 0; n < 2; ++n) { const f32x4 e = *(const f32x4*)(E + ro + bj * HALF + n * 16); const f32x4 a = acc[ai][bj][m][n]; f32x4 o;
#pragma unroll
                        for (int j = 0; j < 4; ++j) o[j] = e[j] / (1.0f + __expf(-a[j]));
                        u32x2 w; w.x = cvt_pk_bf16(o[0], o[1]); w.y = cvt_pk_bf16(o[2], o[3]); *(u32x2*)(O + ro + bj * HALF + n * 16) = w; } }
    }
};

template <class Epi, class Sched>
__device__ __forceinline__ void gemm_phase(PG8_LAS unsigned char* lds, const Gemm g, const Sched& S, const Epi& E) {
    int tid_ = threadIdx.x; asm volatile("" : "+v"(tid_));
    const int tid = tid_, wid = __builtin_amdgcn_readfirstlane(tid >> 6), lane = tid & 63, wr = wid >> 2, wc = wid & 3, fr = lane & 15, fq = lane >> 4;
    const int K = g.K, nt = K / BK;
    unsigned voffA[2], voffB[2];
#pragma unroll
    for (int i = 0; i < 2; ++i) { int R, C; stage_rc(tid * 16 + i * 8192, R, C); const int Rb = Epi::PERM ? ((R & ~31) + perm32(R & 31)) : R;
        voffA[i] = (unsigned)(R * g.lda + C) * 2u; voffB[i] = (unsigned)(Rb * g.ldb + C) * 2u; }
    const size_t kstep = (size_t)(BK * 2);
    const size_t hA = (size_t)HALF * g.lda * 2, hB = (size_t)HALF * g.ldb * 2;
    const size_t tA = 2 * hA, tB = 2 * hB;
    const size_t pnA = (size_t)g.a_pn_off * 2;
    const unsigned ldsw = (unsigned)wid * 1024u;
    const int aoff = lds_byte(wr * 64 + fr, fq * 8), boff = lds_byte(wc * 32 + fr, fq * 8);
#define PG8_SA(b, h) (((b) * 2 + (h)) * HTB)
#define PG8_SB(b, h) ((4 + (b) * 2 + (h)) * HTB)
#define PG8_STAGE(bufoff, gbase, voff) do { _Pragma("unroll") for (int _i = 0; _i < 2; ++_i) \
        __builtin_amdgcn_global_load_lds((const unsigned*)((const char*)(gbase) + (voff)[_i]), (PG8_LAS unsigned*)(lds + (bufoff) + ldsw + _i * 8192), 16, 0, 0); } while (0)
#define PG8_LDA(dst, b, h) do { _Pragma("unroll") for (int m = 0; m < 4; ++m) _Pragma("unroll") for (int k = 0; k < 2; ++k) dst[m][k] = *(const PG8_LAS bf16x8*)(lds + PG8_SA(b, h) + aoff + m * 2048 + k * 1024); } while (0)
#define PG8_LDB(dst, b, h) do { _Pragma("unroll") for (int n = 0; n < 2; ++n) _Pragma("unroll") for (int k = 0; k < 2; ++k) dst[n][k] = *(const PG8_LAS bf16x8*)(lds + PG8_SB(b, h) + boff + n * 2048 + k * 1024); } while (0)
#define PG8_MMA(ai, bj, At, Bt) do { __builtin_amdgcn_s_setprio(1); _Pragma("unroll") for (int m = 0; m < 4; ++m) _Pragma("unroll") for (int n = 0; n < 2; ++n) _Pragma("unroll") for (int k = 0; k < 2; ++k) \
        acc[ai][bj][m][n] = __builtin_amdgcn_mfma_f32_16x16x32_bf16(Bt[n][k], At[m][k], acc[ai][bj][m][n], 0, 0, 0); __builtin_amdgcn_s_setprio(0); } while (0)
#define PG8_WAIT_V(n) asm volatile("s_waitcnt vmcnt(" #n ")" ::: "memory")
#define PG8_WAIT_L(n) asm volatile("s_waitcnt lgkmcnt(" #n ")" ::: "memory")
#define PG8_BAR __builtin_amdgcn_s_barrier()
#define PG8_SCHED __builtin_amdgcn_sched_barrier(0)
    Unit cur, nxt; int ui = 0;
    if (!S.next(0, cur)) return;
    f32x4 acc[2][2][4][2];
#pragma unroll
    for (int a = 0; a < 2; ++a)
#pragma unroll
        for (int b = 0; b < 2; ++b)
#pragma unroll
            for (int m = 0; m < 4; ++m)
#pragma unroll
                for (int n = 0; n < 2; ++n) acc[a][b][m][n] = (f32x4){0.f, 0.f, 0.f, 0.f};
    bf16x8 At[4][2], B0[2][2], B1[2][2];
    const char* cA = (const char*)g.A + (size_t)cur.pm * tA + (size_t)cur.pn * pnA; const char* cB = (const char*)g.Bt + (size_t)cur.pn * tB;
    PG8_STAGE(PG8_SB(0, 0), cB, voffB); PG8_STAGE(PG8_SB(0, 1), cB + hB, voffB); PG8_STAGE(PG8_SA(0, 0), cA, voffA); PG8_STAGE(PG8_SA(0, 1), cA + hA, voffA);
    if (wr == 1) PG8_BAR;
    PG8_WAIT_V(2); PG8_BAR;
    PG8_STAGE(PG8_SB(1, 0), cB + kstep, voffB); PG8_STAGE(PG8_SA(1, 0), cA + kstep, voffA); PG8_STAGE(PG8_SB(1, 1), cB + hB + kstep, voffB);
    PG8_WAIT_V(6); PG8_BAR;
    for (;;) {
        const bool has_next = S.next(ui + 1, nxt);
        const char* nA = has_next ? (const char*)g.A + (size_t)nxt.pm * tA + (size_t)nxt.pn * pnA : cA; const char* nB = has_next ? (const char*)g.Bt + (size_t)nxt.pn * tB : cB;
        for (int t = 0; t < nt; t += 2) {
            const bool last = (t == nt - 2);
            const char* a1 = cA + (size_t)(t + 1) * kstep;
            const char* a2 = last ? nA : cA + (size_t)(t + 2) * kstep; const char* b2 = last ? nB : cB + (size_t)(t + 2) * kstep;
            const char* a3 = a2 + kstep; const char* b3 = b2 + kstep;
            PG8_LDB(B0, 0, 0); PG8_LDB(B1, 0, 1); PG8_SCHED; PG8_LDA(At, 0, 0); PG8_STAGE(PG8_SA(1, 1), a1 + hA, voffA);
            PG8_WAIT_V(8); PG8_WAIT_L(0); PG8_BAR; PG8_MMA(0, 0, At, B0); PG8_MMA(0, 1, At, B1); PG8_BAR; PG8_SCHED;
            PG8_LDA(At, 0, 1); PG8_STAGE(PG8_SB(0, 0), b2, voffB); PG8_STAGE(PG8_SB(0, 1), b2 + hB, voffB); PG8_STAGE(PG8_SA(0, 0), a2, voffA);
            PG8_WAIT_V(8); PG8_WAIT_L(0); PG8_BAR; PG8_MMA(1, 0, At, B0); PG8_MMA(1, 1, At, B1); PG8_BAR; PG8_SCHED;
            PG8_LDB(B0, 1, 0); PG8_LDB(B1, 1, 1); PG8_SCHED; PG8_LDA(At, 1, 0); PG8_STAGE(PG8_SA(0, 1), a2 + hA, voffA);
            PG8_WAIT_V(8); PG8_WAIT_L(0); PG8_BAR; PG8_MMA(0, 0, At, B0); PG8_MMA(0, 1, At, B1); PG8_BAR; PG8_SCHED;
            PG8_LDA(At, 1, 1); PG8_STAGE(PG8_SB(1, 0), b3, voffB); PG8_STAGE(PG8_SB(1, 1), b3 + hB, voffB); PG8_STAGE(PG8_SA(1, 0), a3, voffA);
            PG8_WAIT_V(8); PG8_WAIT_L(0); PG8_BAR; PG8_MMA(1, 0, At, B0); PG8_MMA(1, 1, At, B1); PG8_BAR; PG8_SCHED;
        }
        if (wr == 0) PG8_BAR;
        E(acc, cur, wr, wc, fr, fq);
        if (!has_next) break;
#pragma unroll
        for (int a = 0; a < 2; ++a)
#pragma unroll
            for (int b = 0; b < 2; ++b)
#pragma unroll
                for (int m = 0; m < 4; ++m)
#pragma unroll
                    for (int n = 0; n < 2; ++n) acc[a][b][m][n] = (f32x4){0.f, 0.f, 0.f, 0.f};
        cur = nxt; cA = nA; cB = nB; ++ui;
        if (wr == 1) PG8_BAR;
    }
    PG8_WAIT_V(0);
    PG8_BAR;
#undef PG8_SA
#undef PG8_SB
#undef PG8_STAGE
#undef PG8_LDA
#undef PG8_LDB
#undef PG8_MMA
#undef PG8_WAIT_V
#undef PG8_WAIT_L
#undef PG8_BAR
#undef PG8_SCHED
}
}

constexpr int NB = 8, SEQ = 2048, DM = 2048, PD = 256, NH = 8, DH = 128, MW = 1024, PW = 1024, DFF = 8192, CH = 64, NCH = 32;
constexpr int M = NB * SEQ;
constexpr int INC = 5136, NIN = 5120;
constexpr int C_GATE = 4096, C_U = 4112;
constexpr int NITEM = NB * NH * NCH;
constexpr float EPS = 1e-6f;
constexpr size_t MiB = 1u << 20;
constexpr size_t WS_CTL = 0, CTL_BYTES = 1 * MiB;
constexpr size_t WS_WIN = 2 * MiB, WS_WOUT = 22 * MiB, WS_WFF1 = 30 * MiB, WS_WFF2 = 62 * MiB, WS_WPG = 94 * MiB, WS_WPP = 102 * MiB, WS_WPOOL = 103 * MiB;
constexpr size_t WS_GATES = 104 * MiB, WS_NLOC = 105 * MiB, WS_NPREV = 106 * MiB, WS_SCAL = 107 * MiB, WS_PB = 108 * MiB;
constexpr size_t WS_A0 = 116 * MiB;
constexpr size_t WS_Q = 180 * MiB, WS_K = 212 * MiB, WS_V = 244 * MiB, WS_O = 276 * MiB, WS_U = 308 * MiB;
constexpr size_t WS_CPREV = 180 * MiB;
constexpr size_t WS_QC = 340 * MiB, WS_KC = 372 * MiB;
constexpr size_t WS_HB = 180 * MiB;
constexpr size_t WS_E = 180 * MiB;
constexpr size_t WS_HN = 436 * MiB;
constexpr size_t WS_END = 500 * MiB;
constexpr size_t DO_MIX = 0, DO_POOLED = 64 * MiB, DO_VT = 96 * MiB;
constexpr int LDS_BYTES = 147456;
constexpr int MISC_OFF = 131072 + 320;

typedef unsigned short bf16;
typedef short bf16x8 __attribute__((ext_vector_type(8)));
typedef float f32x4 __attribute__((ext_vector_type(4)));
typedef unsigned u32x4 __attribute__((ext_vector_type(4)));
typedef unsigned u32x2 __attribute__((ext_vector_type(2)));
#define LAS __attribute__((address_space(3)))
#define LDS_WAIT() asm volatile("s_waitcnt lgkmcnt(0)" ::: "memory")

__device__ __forceinline__ float bf2f(unsigned short b) { return __uint_as_float(((unsigned)b) << 16); }
__device__ __forceinline__ float bflo(unsigned w) { return __uint_as_float(w << 16); }
__device__ __forceinline__ float bfhi(unsigned w) { return __uint_as_float(w & 0xffff0000u); }
typedef __bf16 bf16v2_t __attribute__((ext_vector_type(2)));
typedef float f32v2_t __attribute__((ext_vector_type(2)));
__device__ __forceinline__ unsigned pk2(float lo, float hi) { const bf16v2_t r = __builtin_convertvector((f32v2_t){lo, hi}, bf16v2_t); return __builtin_bit_cast(unsigned, r); }
__device__ __forceinline__ float wave_sum(float v) {
#pragma unroll
    for (int o = 1; o < 64; o <<= 1) v += __shfl_xor(v, o);
    return v;
}
__device__ __forceinline__ float wave_max(float v) {
#pragma unroll
    for (int o = 1; o < 64; o <<= 1) v = fmaxf(v, __shfl_xor(v, o));
    return v;
}
__device__ __forceinline__ float sigm(float x) { return 1.0f / (1.0f + __expf(-x)); }
__device__ __forceinline__ float logsigm(float x) { return fminf(x, 0.f) - log1pf(__expf(-fabsf(x))); }

#define XB_TMO      128
#define XB_XCNT(j)  (256  + 64 * (j))
#define XB_XSUB(j)  (1280 + 64 * (j))
#define XB_XGEN(j)  (2304 + 64 * (j))
#define XB_TOP      3328
#define XB_TOPGEN   3392
#define XCD_BAR_WORDS 3456
#define XB_SPIN_CAP (1u << 18)
__device__ __forceinline__ unsigned xb_ld(unsigned* p)              { return __hip_atomic_load(p, __ATOMIC_RELAXED, __HIP_MEMORY_SCOPE_AGENT); }
__device__ __forceinline__ unsigned xb_add(unsigned* p, unsigned v) { return __hip_atomic_fetch_add(p, v, __ATOMIC_RELAXED, __HIP_MEMORY_SCOPE_AGENT); }
__device__ __forceinline__ unsigned xb_xcc_id() { return (unsigned)__builtin_amdgcn_s_getreg((3 << 11) | 20) & 0xFu; }
#define XB_SPIN(cond, bar) do { unsigned _sp = 0; while (cond) { __builtin_amdgcn_s_sleep(1); \
    if ((++_sp & 255u) == 0u) { if (xb_ld(&(bar)[XB_TMO])) break; if (_sp > XB_SPIN_CAP) { atomicAdd(&(bar)[XB_TMO], 1u); break; } } } } while (0)
struct XcdBarrier { unsigned* bar; unsigned x; volatile LAS unsigned* st; };
__device__ __forceinline__ XcdBarrier xcd_barrier_post(unsigned* bar, volatile LAS unsigned* st) {
    XcdBarrier b; b.bar = bar; b.x = xb_xcc_id(); b.st = st;
    if (threadIdx.x == 0) (void)xb_add(&bar[XB_XCNT(b.x)], 1u);
    return b;
}
__device__ __forceinline__ void xcd_barrier_complete(unsigned* bar, unsigned x, unsigned& nloc, unsigned& nx) {
    const unsigned G = gridDim.x * gridDim.y * gridDim.z;
    unsigned sum, cnt, mine, sp = 0u;
    for (;;) {
        sum = 0u; cnt = 0u; mine = 0u;
#pragma unroll
        for (unsigned j = 0; j < 16; ++j) { const unsigned c = xb_ld(&bar[XB_XCNT(j)]); sum += c; cnt += (c > 0u) ? 1u : 0u; mine = (j == x) ? c : mine; }
        if (sum == G) break;
        __builtin_amdgcn_s_sleep(1);
        if ((++sp & 255u) == 0u) { if (xb_ld(&bar[XB_TMO])) break; if (sp > XB_SPIN_CAP) { atomicAdd(&bar[XB_TMO], 1u); break; } }
    }
    nloc = mine > 0u ? mine : 1u; nx = cnt > 0u ? cnt : 1u;
}
__device__ __forceinline__ void xcd_barrier(const XcdBarrier& b) {
    asm volatile("s_waitcnt vmcnt(0)" ::: "memory");
    __syncthreads();
    if (threadIdx.x == 0) {
        unsigned* bar = b.bar;
        __builtin_amdgcn_s_waitcnt(0);
        unsigned nloc = b.st[0], nx = b.st[1];
        if (nloc == 0u) { xcd_barrier_complete(bar, b.x, nloc, nx); b.st[0] = nloc; b.st[1] = nx; }
        const unsigned old = xb_add(&bar[XB_XSUB(b.x)], 1u);
        const unsigned gen = old / nloc;
        if (old + 1u == (gen + 1u) * nloc) {
            __builtin_amdgcn_fence(__ATOMIC_RELEASE, "agent");
            asm volatile("s_waitcnt vmcnt(0)" ::: "memory");
            const unsigned og = xb_add(&bar[XB_TOP], 1u);
            const unsigned tg = og / nx;
            if (og + 1u == (tg + 1u) * nx) xb_add(&bar[XB_TOPGEN], 1u);
            else XB_SPIN(xb_ld(&bar[XB_TOPGEN]) == tg, bar);
            __builtin_amdgcn_fence(__ATOMIC_ACQUIRE, "agent");
            xb_add(&bar[XB_XGEN(b.x)], 1u);
            asm volatile("s_waitcnt vmcnt(0)" ::: "memory");
        } else {
            XB_SPIN(xb_ld(&bar[XB_XGEN(b.x)]) == gen, bar);
            __builtin_amdgcn_fence(__ATOMIC_ACQUIRE, "agent");
            asm volatile("s_waitcnt vmcnt(0)" ::: "memory");
        }
    }
    __syncthreads();
}

struct Args { const float* in[19]; float* out; unsigned char* ws; int ph_lo, ph_hi; };
struct Frame {
    LAS unsigned char* lds;
    int tid, lane, wave, G, bid;
    const float *x, *p, *w_in, *b_gates, *w_conv, *g_mlstm, *w_pool, *pool_scale, *w_out, *g_mix_pre, *g_mix_post, *w_ff1, *w_ff2, *g_ff_pre, *g_ff_post, *w_ple_proj, *w_ple_gate, *g_ple_gate, *g_ple_post;
    float* out; unsigned char* ws; unsigned char* ob;
};
#define MK_FRAME(F) Frame F; { int t_ = threadIdx.x; asm volatile("" : "+v"(t_)); F.lds = (LAS unsigned char*)lds_raw; F.tid = t_; F.lane = t_ & 63; F.wave = __builtin_amdgcn_readfirstlane(t_ >> 6); F.G = gridDim.x; F.bid = blockIdx.x; \
    F.out = args.out; F.ws = args.ws; F.ob = (unsigned char*)args.out; }

__device__ __forceinline__ void transpose_item(const float* W, int ldw, int ns0, bf16* WT, int ldt, int nd0, int kb, int nb, LAS float* scr, int lane) {
    const int k0 = 64 * kb, n0 = 32 * nb;
#pragma unroll 8
    for (int i = 0; i < 32; ++i) { const int kk = 2 * i + (lane >> 5); scr[kk * 33 + (lane & 31)] = W[(size_t)(k0 + kk) * ldw + ns0 + n0 + (lane & 31)]; }
    LDS_WAIT(); asm volatile("" ::: "memory");
    const int c = lane & 7;
#pragma unroll
    for (int j = 0; j < 4; ++j) { const int n = (lane >> 3) + 8 * j; const LAS float* s = scr + (8 * c) * 33 + n;
        u32x4 o; o.x = pk2(s[0 * 33], s[1 * 33]); o.y = pk2(s[2 * 33], s[3 * 33]); o.z = pk2(s[4 * 33], s[5 * 33]); o.w = pk2(s[6 * 33], s[7 * 33]);
        *(u32x4*)(WT + (size_t)(nd0 + n0 + n) * ldt + k0 + 8 * c) = o; }
    LDS_WAIT(); asm volatile("" ::: "memory");
}

__device__ __forceinline__ void p0_prologue(Frame& F) {
    const int gw = F.bid * 8 + F.wave, NGW = F.G * 8;
    unsigned char* ws = F.ws;
    {
        LAS float* scr = (LAS float*)(F.lds + F.wave * 16384);
        constexpr int I0 = 32 * 128, I1 = 32 * 32, I2 = 32 * 64, I3 = 32 * 256, I4 = 128 * 64, I5 = 32 * 64, I6 = 4 * 64, I7 = 4 * 32;
        constexpr int NIT = I0 + I1 + I2 + I3 + I4 + I5 + I6 + I7;
        for (int it = gw; it < NIT; it += NGW) {
            int r = it;
            if (r < I0) { transpose_item(F.w_in, INC, 0, (bf16*)(ws + WS_WIN), DM, 0, r / 128, r % 128, scr, F.lane); continue; } r -= I0;
            if (r < I1) { transpose_item(F.w_in, INC, C_U, (bf16*)(ws + WS_WIN), DM, 4096, r / 32, r % 32, scr, F.lane); continue; } r -= I1;
            if (r < I2) { transpose_item(F.w_out, DM, 0, (bf16*)(ws + WS_WOUT), DM, 0, r / 64, r % 64, scr, F.lane); continue; } r -= I2;
            if (r < I3) { transpose_item(F.w_ff1, DFF, 0, (bf16*)(ws + WS_WFF1), DM, 0, r / 256, r % 256, scr, F.lane); continue; } r -= I3;
            if (r < I4) { transpose_item(F.w_ff2, DM, 0, (bf16*)(ws + WS_WFF2), DFF, 0, r / 64, r % 64, scr, F.lane); continue; } r -= I4;
            if (r < I5) { transpose_item(F.w_ple_gate, DM, 0, (bf16*)(ws + WS_WPG), DM, 0, r / 64, r % 64, scr, F.lane); continue; } r -= I5;
            if (r < I6) { transpose_item(F.w_ple_proj, DM, 0, (bf16*)(ws + WS_WPP), PD, 0, r / 64, r % 64, scr, F.lane); continue; } r -= I6;
            { const int g = r / 32, rr = r % 32; transpose_item(F.w_pool + (size_t)g * 256 * 256, 256, 0, (bf16*)(ws + WS_WPOOL), 256, g * 256, rr / 8, rr % 8, scr, F.lane); }
        }
    }
    {
        const int gt = F.bid * 512 + F.tid, NGT = F.G * 512;
        for (int i = gt; i < M * PD / 8; i += NGT) { const f32x4 a = *(const f32x4*)(F.p + (size_t)i * 8), b = *(const f32x4*)(F.p + (size_t)i * 8 + 4);
            u32x4 o; o.x = pk2(a[0], a[1]); o.y = pk2(a[2], a[3]); o.z = pk2(b[0], b[1]); o.w = pk2(b[2], b[3]); *(u32x4*)(ws + WS_PB + (size_t)i * 16) = o; }
    }
    __syncthreads();
    {
        LAS f32x4* wg = (LAS f32x4*)F.lds;
        for (int idx = F.tid; idx < 8192; idx += 512) { const int ln = idx & 63, c4 = (idx >> 6) & 3, i = (idx >> 8) & 3, jj = idx >> 10; const int k = 256 * jj + 4 * ln + i;
            wg[idx] = *(const f32x4*)(F.w_in + (size_t)k * INC + C_GATE + 4 * c4); }
    }
    __syncthreads();
    {
        const LAS f32x4* wg = (const LAS f32x4*)F.lds;
        const int lane = F.lane;
        for (int m = gw; m < M; m += NGW) {
            const float* xr = F.x + (size_t)m * DM;
            f32x4 v[8]; float s = 0.f;
#pragma unroll
            for (int jj = 0; jj < 8; ++jj) { v[jj] = *(const f32x4*)(xr + 256 * jj + 4 * lane); s += (v[jj][0] * v[jj][0] + v[jj][1] * v[jj][1]) + (v[jj][2] * v[jj][2] + v[jj][3] * v[jj][3]); }
            const float rs = rsqrtf(wave_sum(s) * (1.0f / DM) + EPS);
            f32x4 ga[4];
#pragma unroll
            for (int c4 = 0; c4 < 4; ++c4) ga[c4] = (f32x4){0.f, 0.f, 0.f, 0.f};
#pragma unroll
            for (int jj = 0; jj < 8; ++jj) { const f32x4 g = *(const f32x4*)(F.g_mix_pre + 256 * jj + 4 * lane); v[jj] = v[jj] * rs * g;
                u32x2 o; o.x = pk2(v[jj][0], v[jj][1]); o.y = pk2(v[jj][2], v[jj][3]); *(u32x2*)(ws + WS_A0 + ((size_t)m * DM + 256 * jj + 4 * lane) * 2) = o;
#pragma unroll
                for (int i = 0; i < 4; ++i)
#pragma unroll
                    for (int c4 = 0; c4 < 4; ++c4) ga[c4] += wg[((jj * 4 + i) * 4 + c4) * 64 + lane] * v[jj][i];
                asm volatile("" ::: "memory"); }
            float res = 0.f;
#pragma unroll
            for (int c4 = 0; c4 < 4; ++c4)
#pragma unroll
                for (int j = 0; j < 4; ++j) { const float t = wave_sum(ga[c4][j]); if (lane == c4 * 4 + j) res = t; }
            if (lane < 16) ((float*)(ws + WS_GATES))[(size_t)m * 16 + lane] = res + F.b_gates[lane];
        }
    }
}

constexpr int PA_KT = 0, PA_VW = 18432, PA_VT = 36864, PA_W = 53248;
__device__ __forceinline__ int vt_pos(int j) { return (j & 32) | (((j >> 2) & 3) << 3) | (((j >> 4) & 1) << 2) | (j & 3); }
__device__ __forceinline__ void p2_item(Frame& F, int item) {
    unsigned char* ws = F.ws;
    const int tid = F.tid, lane = F.lane, wave = F.wave;
    const int c = item & 31, bh = item >> 5, h = bh & 7, b = bh >> 3;
    const int m0 = b * SEQ + c * CH;
    LAS unsigned char* lds = F.lds;
    LAS float* wl = (LAS float*)(lds + PA_W);
    const float* gates = (const float*)(ws + WS_GATES);
    if (wave == 0) {
        const float li = gates[(size_t)(m0 + lane) * 16 + h], lf = logsigm(gates[(size_t)(m0 + lane) * 16 + 8 + h]);
        float bs = lf;
#pragma unroll
        for (int o = 1; o < 64; o <<= 1) { const float t = __shfl_up(bs, o); if (lane >= o) bs += t; }
        const float btot = __shfl(bs, 63);
        const float a = btot - bs + li, amax = wave_max(a);
        wl[lane] = __expf(a - amax);
        if (lane == 0) { ((float*)(ws + WS_SCAL))[item] = amax; ((float*)(ws + WS_SCAL))[NITEM + item] = btot; }
    }
    const int cg8 = tid & 15, rp = tid >> 4, l0 = 2 * rp, col = h * DH + cg8 * 8;
    u32x4 qr[5], kr[5], vr[2];
#pragma unroll
    for (int i = 0; i < 5; ++i) { const int r = l0 - 3 + i; const bool ok = (c > 0) || (r >= 0);
        const size_t off = ((size_t)(m0 + r) * MW + col) * 2;
        qr[i] = ok ? *(const u32x4*)(ws + WS_Q + off) : (u32x4){0u, 0u, 0u, 0u};
        kr[i] = ok ? *(const u32x4*)(ws + WS_K + off) : (u32x4){0u, 0u, 0u, 0u}; }
#pragma unroll
    for (int i = 0; i < 2; ++i) vr[i] = *(const u32x4*)(ws + WS_V + ((size_t)(m0 + l0 + i) * MW + col) * 2);
    float wq[4][8], wk[4][8];
#pragma unroll
    for (int kk = 0; kk < 4; ++kk) { const f32x4 a = *(const f32x4*)(F.w_conv + kk * 2048 + col), b2 = *(const f32x4*)(F.w_conv + kk * 2048 + col + 4);
        const f32x4 c2 = *(const f32x4*)(F.w_conv + kk * 2048 + 1024 + col), d2 = *(const f32x4*)(F.w_conv + kk * 2048 + 1024 + col + 4);
#pragma unroll
        for (int j = 0; j < 4; ++j) { wq[kk][j] = a[j]; wq[kk][4 + j] = b2[j]; wk[kk][j] = c2[j]; wk[kk][4 + j] = d2[j]; } }
    float qy[2][8], ky[2][8];
#pragma unroll
    for (int rr = 0; rr < 2; ++rr)
#pragma unroll
        for (int j = 0; j < 8; ++j) { float aq = 0.f, ak = 0.f;
#pragma unroll
            for (int kk = 0; kk < 4; ++kk) { const unsigned wqv = qr[rr + kk][j >> 1], wkv = kr[rr + kk][j >> 1];
                const float xq = (j & 1) ? bfhi(wqv) : bflo(wqv), xk = (j & 1) ? bfhi(wkv) : bflo(wkv);
                aq += wq[kk][j] * xq; ak += wk[kk][j] * xk; }
            qy[rr][j] = aq * sigm(aq); ky[rr][j] = ak * sigm(ak) * 0.08838834764831845f; }
#pragma unroll
    for (int rr = 0; rr < 2; ++rr) { const size_t off = ((size_t)(m0 + l0 + rr) * MW + col) * 2;
        u32x4 o; o.x = pk2(qy[rr][0], qy[rr][1]); o.y = pk2(qy[rr][2], qy[rr][3]); o.z = pk2(qy[rr][4], qy[rr][5]); o.w = pk2(qy[rr][6], qy[rr][7]); *(u32x4*)(ws + WS_QC + off) = o;
        u32x4 k2; k2.x = pk2(ky[rr][0], ky[rr][1]); k2.y = pk2(ky[rr][2], ky[rr][3]); k2.z = pk2(ky[rr][4], ky[rr][5]); k2.w = pk2(ky[rr][6], ky[rr][7]); *(u32x4*)(ws + WS_KC + off) = k2; }
    __syncthreads();
    {
        const float w0 = wl[l0], w1 = wl[l0 + 1];
        const int pv = vt_pos(l0);
#pragma unroll
        for (int j = 0; j < 8; ++j) { const int e = cg8 * 8 + j;
            const float v0 = (j & 1) ? bfhi(vr[0][j >> 1]) : bflo(vr[0][j >> 1]), v1 = (j & 1) ? bfhi(vr[1][j >> 1]) : bflo(vr[1][j >> 1]);
            *(LAS unsigned*)(lds + PA_KT + e * 144 + l0 * 2) = pk2(ky[0][j], ky[1][j]);
            *(LAS unsigned*)(lds + PA_VW + e * 144 + l0 * 2) = pk2(v0 * w0, v1 * w1);
            *(LAS unsigned*)(lds + PA_VT + e * 128 + pv * 2) = pk2(v0, v1); }
    }
    __syncthreads();
    {
        const int fr = lane & 15, fq = lane >> 4;
        f32x4 acc[8];
#pragma unroll
        for (int et = 0; et < 8; ++et) acc[et] = (f32x4){0.f, 0.f, 0.f, 0.f};
#pragma unroll
        for (int ks = 0; ks < 2; ++ks) { const bf16x8 bfr = *(const LAS bf16x8*)(lds + PA_VW + (16 * wave + fr) * 144 + (32 * ks + 8 * fq) * 2);
#pragma unroll
            for (int et = 0; et < 8; ++et) { const bf16x8 afr = *(const LAS bf16x8*)(lds + PA_KT + (16 * et + fr) * 144 + (32 * ks + 8 * fq) * 2);
                acc[et] = __builtin_amdgcn_mfma_f32_16x16x32_bf16(afr, bfr, acc[et], 0, 0, 0); } }
        const int d = 16 * wave + fr;
#pragma unroll
        for (int et = 0; et < 8; ++et) { u32x2 o; o.x = pk2(acc[et][0], acc[et][1]); o.y = pk2(acc[et][2], acc[et][3]);
            *(u32x2*)(ws + WS_A0 + (((size_t)item * 128 + d) * 128 + 16 * et + 4 * fq) * 2) = o; }
    }
    if (tid < 128) { float s = 0.f;
#pragma unroll 8
        for (int l = 0; l < 64; ++l) s += wl[l] * bf2f(*(const LAS unsigned short*)(lds + PA_KT + tid * 144 + l * 2));
        ((float*)(ws + WS_NLOC))[(size_t)item * 128 + tid] = s; }
#pragma unroll
    for (int i = 0; i < 2; ++i) { const int idx = tid + 512 * i, row = idx >> 3, chk = idx & 7;
        *(u32x4*)(F.ob + DO_VT + ((size_t)item * 128 + row) * 128 + chk * 16) = *(const LAS u32x4*)(lds + PA_VT + row * 128 + chk * 16); }
    __syncthreads();
}
__device__ __forceinline__ void p2_pooled(Frame& F) {
    const int gt = F.bid * 512 + F.tid, NGT = F.G * 512;
    for (int i = gt; i < M * 128; i += NGT) { const int m = i >> 7, c8 = i & 127, t = m & (SEQ - 1), g = c8 >> 5, w = 2 << g;
        float s[8];
#pragma unroll
        for (int j = 0; j < 8; ++j) s[j] = 0.f;
        const int n = (t + 1 < w) ? t + 1 : w;
        u32x4 cur = (u32x4){0u, 0u, 0u, 0u};
        for (int r = 0; r < n; ++r) { const u32x4 v = *(const u32x4*)(F.ws + WS_U + ((size_t)(m - r) * PW + c8 * 8) * 2); if (r == 0) cur = v;
#pragma unroll
            for (int j = 0; j < 4; ++j) { s[2 * j] += bflo(v[j]); s[2 * j + 1] += bfhi(v[j]); } }
        const float inv = 1.0f / (float)n;
        u32x4 o;
#pragma unroll
        for (int j = 0; j < 4; ++j) o[j] = pk2(s[2 * j] * inv - bflo(cur[j]), s[2 * j + 1] * inv - bfhi(cur[j]));
        *(u32x4*)(F.ob + DO_POOLED + ((size_t)m * PW + c8 * 8) * 2) = o; }
}

__device__ __forceinline__ void p3_scan(Frame& F) {
    unsigned char* ws = F.ws;
    const int gt = F.bid * 512 + F.tid;
    const float* amaxp = (const float*)(ws + WS_SCAL); const float* btotp = amaxp + NITEM; float* mprev = (float*)(ws + WS_SCAL) + 2 * NITEM;
    for (int id = gt; id < 64 * 128 * 16; id += F.G * 512) {
        const int bh = id >> 11, d = (id >> 4) & 127, e8 = id & 15;
        float acc[8], nacc[8];
#pragma unroll
        for (int j = 0; j < 8; ++j) { acc[j] = 0.f; nacc[j] = 0.f; }
        float m = 0.f;
        const bool do_n = (d == 0);
#pragma unroll 4
        for (int c = 0; c < NCH; ++c) { const int item = bh * 32 + c;
            const u32x4 cl = *(const u32x4*)(ws + WS_A0 + (((size_t)item * 128 + d) * 128 + e8 * 8) * 2);
            u32x4 o; o.x = pk2(acc[0], acc[1]); o.y = pk2(acc[2], acc[3]); o.z = pk2(acc[4], acc[5]); o.w = pk2(acc[6], acc[7]);
            *(u32x4*)(ws + WS_CPREV + (((size_t)item * 128 + d) * 128 + e8 * 8) * 2) = o;
            const float amax = amaxp[item], btot = btotp[item];
            const float mn = fmaxf(btot + m, amax), dec = __expf(btot + m - mn), sc = __expf(amax - mn);
            if (do_n) { float* np = (float*)(ws + WS_NPREV) + (size_t)item * 128 + e8 * 8; const float* nl = (const float*)(ws + WS_NLOC) + (size_t)item * 128 + e8 * 8;
                *(f32x4*)np = (f32x4){nacc[0], nacc[1], nacc[2], nacc[3]}; *(f32x4*)(np + 4) = (f32x4){nacc[4], nacc[5], nacc[6], nacc[7]};
                const f32x4 a = *(const f32x4*)nl, b2 = *(const f32x4*)(nl + 4);
#pragma unroll
                for (int j = 0; j < 4; ++j) { nacc[j] = dec * nacc[j] + sc * a[j]; nacc[4 + j] = dec * nacc[4 + j] + sc * b2[j]; }
                if (e8 == 0) mprev[item] = m; }
#pragma unroll
            for (int j = 0; j < 4; ++j) { acc[2 * j] = dec * acc[2 * j] + sc * bflo(cl[j]); acc[2 * j + 1] = dec * acc[2 * j + 1] + sc * bfhi(cl[j]); }
            m = mn; }
    }
}

__device__ __forceinline__ void p4_task(Frame& F, int task) {
    unsigned char* ws = F.ws;
    const int lane = F.lane, fr = lane & 15, fq = lane >> 4;
    const int item = task >> 2, rb = task & 3;
    const int c = item & 31, bh = item >> 5, h = bh & 7, b = bh >> 3;
    const int m0 = b * SEQ + c * CH;
    const float* gates = (const float*)(ws + WS_GATES);
    const float li = gates[(size_t)(m0 + lane) * 16 + h], lf = logsigm(gates[(size_t)(m0 + lane) * 16 + 8 + h]);
    float bs = lf;
#pragma unroll
    for (int o = 1; o < 64; o <<= 1) { const float t = __shfl_up(bs, o); if (lane >= o) bs += t; }
    const float gg = li - bs;
    float pmx = gg;
#pragma unroll
    for (int o = 1; o < 64; o <<= 1) { const float t = __shfl_up(pmx, o); if (lane >= o) pmx = fmaxf(pmx, t); }
    const float m_prev = ((const float*)(ws + WS_SCAL))[2 * NITEM + item];
    const float pm = fmaxf(m_prev, pmx);
    const int l = 16 * rb + fr;
    const float b_l = __shfl(bs, l), pm_l = __shfl(pm, l);
    const float inter_w = __expf(m_prev - pm_l);
    bf16x8 qf[4];
#pragma unroll
    for (int ks = 0; ks < 4; ++ks) qf[ks] = *(const bf16x8*)(ws + WS_QC + ((size_t)(m0 + l) * MW + h * DH + 32 * ks + 8 * fq) * 2);
    f32x4 T[4];
#pragma unroll
    for (int jt = 0; jt < 4; ++jt) { T[jt] = (f32x4){0.f, 0.f, 0.f, 0.f};
        if (jt <= rb) {
#pragma unroll
            for (int ks = 0; ks < 4; ++ks) { const bf16x8 kf = *(const bf16x8*)(ws + WS_KC + ((size_t)(m0 + 16 * jt + fr) * MW + h * DH + 32 * ks + 8 * fq) * 2);
                T[jt] = __builtin_amdgcn_mfma_f32_16x16x32_bf16(kf, qf[ks], T[jt], 0, 0, 0); } } }
    float rowsum = 0.f;
#pragma unroll
    for (int jt = 0; jt < 4; ++jt)
#pragma unroll
        for (int r = 0; r < 4; ++r) { const int j = 16 * jt + 4 * fq + r; const float gj = __shfl(gg, j);
            const float wgt = (j <= l) ? __expf(gj - pm_l) : 0.f; const float sv = T[jt][r] * wgt; T[jt][r] = sv; rowsum += sv; }
    bf16x8 pf[2];
#pragma unroll
    for (int s2 = 0; s2 < 2; ++s2) { u32x4 w; w.x = pk2(T[2 * s2][0], T[2 * s2][1]); w.y = pk2(T[2 * s2][2], T[2 * s2][3]); w.z = pk2(T[2 * s2 + 1][0], T[2 * s2 + 1][1]); w.w = pk2(T[2 * s2 + 1][2], T[2 * s2 + 1][3]);
        pf[s2] = __builtin_bit_cast(bf16x8, w); }
    float nq = 0.f;
#pragma unroll
    for (int ks = 0; ks < 4; ++ks) { const float* np = (const float*)(ws + WS_NPREV) + (size_t)item * 128 + 32 * ks + 8 * fq; const f32x4 a = *(const f32x4*)np, b2 = *(const f32x4*)(np + 4);
        const u32x4 qw = __builtin_bit_cast(u32x4, qf[ks]);
        nq += a[0] * bflo(qw[0]) + a[1] * bfhi(qw[0]) + a[2] * bflo(qw[1]) + a[3] * bfhi(qw[1]) + b2[0] * bflo(qw[2]) + b2[1] * bfhi(qw[2]) + b2[2] * bflo(qw[3]) + b2[3] * bfhi(qw[3]); }
    nq += __shfl_xor(nq, 16); nq += __shfl_xor(nq, 32);
    rowsum += __shfl_xor(rowsum, 16); rowsum += __shfl_xor(rowsum, 32);
    const float den = inter_w * nq + rowsum;
    const float inv = 1.0f / fmaxf(fabsf(den), __expf(-(b_l + pm_l)));
    f32x4 acc[8]; float ss = 0.f;
#pragma unroll
    for (int dt = 0; dt < 8; ++dt) { acc[dt] = (f32x4){0.f, 0.f, 0.f, 0.f};
#pragma unroll
        for (int ks = 0; ks < 4; ++ks) { const bf16x8 cf = *(const bf16x8*)(ws + WS_CPREV + (((size_t)item * 128 + 16 * dt + fr) * 128 + 32 * ks + 8 * fq) * 2);
            acc[dt] = __builtin_amdgcn_mfma_f32_16x16x32_bf16(cf, qf[ks], acc[dt], 0, 0, 0); }
        acc[dt] = acc[dt] * inter_w;
#pragma unroll
        for (int s2 = 0; s2 < 2; ++s2) { if (s2 == 0 || rb >= 2) { const bf16x8 vf = *(const bf16x8*)(F.ob + DO_VT + (((size_t)item * 128 + 16 * dt + fr) * 64 + 32 * s2 + 8 * fq) * 2);
                acc[dt] = __builtin_amdgcn_mfma_f32_16x16x32_bf16(vf, pf[s2], acc[dt], 0, 0, 0); } }
        acc[dt] = acc[dt] * inv;
        ss += (acc[dt][0] * acc[dt][0] + acc[dt][1] * acc[dt][1]) + (acc[dt][2] * acc[dt][2] + acc[dt][3] * acc[dt][3]); }
    ss += __shfl_xor(ss, 16); ss += __shfl_xor(ss, 32);
    const float rn = rsqrtf(ss * (1.0f / DH) + EPS);
#pragma unroll
    for (int dt = 0; dt < 8; ++dt) { const int d0 = 16 * dt + 4 * fq;
        const u32x2 ow = *(const u32x2*)(ws + WS_O + ((size_t)(m0 + l) * MW + h * DH + d0) * 2);
        const f32x4 gm = *(const f32x4*)(F.g_mlstm + h * DH + d0);
        const float o0 = sigm(bflo(ow.x)) * acc[dt][0] * rn * gm[0], o1 = sigm(bfhi(ow.x)) * acc[dt][1] * rn * gm[1];
        const float o2 = sigm(bflo(ow.y)) * acc[dt][2] * rn * gm[2], o3 = sigm(bfhi(ow.y)) * acc[dt][3] * rn * gm[3];
        u32x2 o; o.x = pk2(o0, o1); o.y = pk2(o2, o3);
        *(u32x2*)(F.ob + DO_MIX + ((size_t)(m0 + l) * DM + h * DH + d0) * 2) = o; }
}

__device__ __forceinline__ void row_resnorm(Frame& F, const float* base, const unsigned char* y, const float* g1, const float* g2, float* hout, unsigned char* nout) {
    const int gw = F.bid * 8 + F.wave, NGW = F.G * 8, lane = F.lane;
    for (int m = gw; m < M; m += NGW) {
        float v[32]; float s = 0.f;
#pragma unroll
        for (int j = 0; j < 4; ++j) { const u32x4 w = *(const u32x4*)(y + ((size_t)m * DM + 512 * j + 8 * lane) * 2);
#pragma unroll
            for (int q = 0; q < 4; ++q) { v[8 * j + 2 * q] = bflo(w[q]); v[8 * j + 2 * q + 1] = bfhi(w[q]); } }
#pragma unroll
        for (int i = 0; i < 32; ++i) s += v[i] * v[i];
        const float r1 = rsqrtf(wave_sum(s) * (1.0f / DM) + EPS);
        float s2 = 0.f;
#pragma unroll
        for (int j = 0; j < 4; ++j) { const size_t co = 512 * j + 8 * lane;
            const f32x4 b0 = *(const f32x4*)(base + (size_t)m * DM + co), b1 = *(const f32x4*)(base + (size_t)m * DM + co + 4);
            const f32x4 ga = *(const f32x4*)(g1 + co), gb = *(const f32x4*)(g1 + co + 4);
#pragma unroll
            for (int q = 0; q < 4; ++q) { v[8 * j + q] = b0[q] + v[8 * j + q] * r1 * ga[q]; v[8 * j + 4 + q] = b1[q] + v[8 * j + 4 + q] * r1 * gb[q]; }
            *(f32x4*)(hout + (size_t)m * DM + co) = (f32x4){v[8 * j], v[8 * j + 1], v[8 * j + 2], v[8 * j + 3]};
            *(f32x4*)(hout + (size_t)m * DM + co + 4) = (f32x4){v[8 * j + 4], v[8 * j + 5], v[8 * j + 6], v[8 * j + 7]}; }
#pragma unroll
        for (int i = 0; i < 32; ++i) s2 += v[i] * v[i];
        const float r2 = rsqrtf(wave_sum(s2) * (1.0f / DM) + EPS);
#pragma unroll
        for (int j = 0; j < 4; ++j) { const size_t co = 512 * j + 8 * lane;
            const f32x4 ga = *(const f32x4*)(g2 + co), gb = *(const f32x4*)(g2 + co + 4);
            u32x4 o; o.x = pk2(v[8 * j] * r2 * ga[0], v[8 * j + 1] * r2 * ga[1]); o.y = pk2(v[8 * j + 2] * r2 * ga[2], v[8 * j + 3] * r2 * ga[3]);
            o.z = pk2(v[8 * j + 4] * r2 * gb[0], v[8 * j + 5] * r2 * gb[1]); o.w = pk2(v[8 * j + 6] * r2 * gb[2], v[8 * j + 7] * r2 * gb[3]);
            *(u32x4*)(nout + ((size_t)m * DM + co) * 2) = o; }
    }
}
__device__ __forceinline__ void row_final(Frame& F, const unsigned char* y, const float* g, float* out) {
    const int gw = F.bid * 8 + F.wave, NGW = F.G * 8, lane = F.lane;
    for (int m = gw; m < M; m += NGW) {
        float v[32]; float s = 0.f;
#pragma unroll
        for (int j = 0; j < 4; ++j) { const u32x4 w = *(const u32x4*)(y + ((size_t)m * DM + 512 * j + 8 * lane) * 2);
#pragma unroll
            for (int q = 0; q < 4; ++q) { v[8 * j + 2 * q] = bflo(w[q]); v[8 * j + 2 * q + 1] = bfhi(w[q]); } }
#pragma unroll
        for (int i = 0; i < 32; ++i) s += v[i] * v[i];
        const float r1 = rsqrtf(wave_sum(s) * (1.0f / DM) + EPS);
#pragma unroll
        for (int j = 0; j < 4; ++j) { const size_t co = 512 * j + 8 * lane;
            const f32x4 b0 = *(const f32x4*)(out + (size_t)m * DM + co), b1 = *(const f32x4*)(out + (size_t)m * DM + co + 4);
            const f32x4 ga = *(const f32x4*)(g + co), gb = *(const f32x4*)(g + co + 4);
            f32x4 o0, o1;
#pragma unroll
            for (int q = 0; q < 4; ++q) { o0[q] = b0[q] + v[8 * j + q] * r1 * ga[q]; o1[q] = b1[q] + v[8 * j + 4 + q] * r1 * gb[q]; }
#ifdef DBG_SANITIZE
#pragma unroll
            for (int q = 0; q < 4; ++q) { if (!(fabsf(o0[q]) < 1e30f)) o0[q] = 1.0e4f; if (!(fabsf(o1[q]) < 1e30f)) o1[q] = 1.0e4f; }
#endif
            *(f32x4*)(out + (size_t)m * DM + co) = o0; *(f32x4*)(out + (size_t)m * DM + co + 4) = o1; }
    }
}

constexpr int NPHASE = 12;
__global__ void __launch_bounds__(512, 2) fwd_mega(const Args args) {
    extern __shared__ __attribute__((aligned(16))) unsigned char lds_raw[];
    {
        const int t0 = threadIdx.x;
        for (int u = t0; u < (LDS_BYTES - 131072) / 4; u += 512) ((LAS unsigned*)((LAS unsigned char*)lds_raw + 131072))[u] = 0u;
    }
    __syncthreads();
    const int lo = args.ph_lo, hi = args.ph_hi;
#define IN(k) (lo <= (k) && (k) < hi)
#define BARSETUP() XcdBarrier bar; bar.bar = (unsigned*)(args.ws + WS_CTL) + 4096; bar.x = xb_xcc_id(); bar.st = (volatile LAS unsigned*)((LAS unsigned char*)lds_raw + MISC_OFF) + 8;
#define SEAM(k) do { if (IN(k) && IN((k) + 1)) { if ((k) == 0) { cg::this_grid().sync(); } else { BARSETUP(); xcd_barrier(bar); } } } while (0)
    if (hi - lo > 1) { if (threadIdx.x == 0) (void)xb_add((unsigned*)(args.ws + WS_CTL) + 4096 + XB_XCNT(xb_xcc_id()), 1u); }

    if (IN(0)) { MK_FRAME(F); F.x = args.in[0]; F.p = args.in[1]; F.w_in = args.in[2]; F.b_gates = args.in[3]; F.w_pool = args.in[6]; F.w_out = args.in[8]; F.g_mix_pre = args.in[9];
        F.w_ff1 = args.in[11]; F.w_ff2 = args.in[12]; F.w_ple_proj = args.in[15]; F.w_ple_gate = args.in[16];
        p0_prologue(F); } SEAM(0);
    if (IN(1)) {
        unsigned char* ws = args.ws;
        pg8::Gemm g{(const bf16*)(ws + WS_A0), (const bf16*)(ws + WS_WIN), DM, DM, DM, 0}; pg8::StaticOrder S; S.init(M, NIN, gridDim.x, blockIdx.x);
        pg8::EpiBf16<0> E{(bf16*)(ws + WS_Q), MW, nullptr, 1024, (size_t)(WS_K - WS_Q) / 2};
        pg8::gemm_phase((LAS unsigned char*)lds_raw, g, S, E);
    } SEAM(1);
    if (IN(2)) { MK_FRAME(F); F.w_conv = args.in[4];
        for (int it = F.bid; it < NITEM; it += F.G) p2_item(F, it);
        p2_pooled(F);
    } SEAM(2);
    if (IN(3)) {
        {
            unsigned char* ws = args.ws; unsigned char* ob = (unsigned char*)args.out;
            pg8::Gemm g{(const bf16*)(ob + DO_POOLED), (const bf16*)(ws + WS_WPOOL), PW, 256, 256, 256}; pg8::StaticOrder S; S.init(M, PW, gridDim.x, blockIdx.x);
            pg8::EpiBf16<0> E{(bf16*)(ob + DO_MIX) + 1024, DM, args.in[7], 0, 0};
            pg8::gemm_phase((LAS unsigned char*)lds_raw, g, S, E);
        }
        { MK_FRAME(F); p3_scan(F); }
    } SEAM(3);
    if (IN(4)) { MK_FRAME(F); F.g_mlstm = args.in[5];
        const int gw = F.bid * 8 + F.wave, NGW = F.G * 8;
        for (int task = gw; task < NITEM * 4; task += NGW) p4_task(F, task);
    } SEAM(4);
    if (IN(5)) {
        unsigned char* ws = args.ws; unsigned char* ob = (unsigned char*)args.out;
        pg8::Gemm g{(const bf16*)(ob + DO_MIX), (const bf16*)(ws + WS_WOUT), DM, DM, DM, 0}; pg8::StaticOrder S; S.init(M, DM, gridDim.x, blockIdx.x);
        pg8::EpiBf16<0> E{(bf16*)(ws + WS_A0), DM, nullptr, 0, 0};
        pg8::gemm_phase((LAS unsigned char*)lds_raw, g, S, E);
    } SEAM(5);
    if (IN(6)) { MK_FRAME(F); row_resnorm(F, args.in[0], F.ws + WS_A0, args.in[10], args.in[13], F.out, F.ws + WS_HN); } SEAM(6);
    if (IN(7)) {
        unsigned char* ws = args.ws;
        pg8::Gemm g{(const bf16*)(ws + WS_HN), (const bf16*)(ws + WS_WFF1), DM, DM, DM, 0}; pg8::StaticOrder S; S.init(M, DFF, gridDim.x, blockIdx.x);
        pg8::EpiBf16<1> E{(bf16*)(ws + WS_HB), DFF, nullptr, 0, 0};
        pg8::gemm_phase((LAS unsigned char*)lds_raw, g, S, E);
    } SEAM(7);
    if (IN(8)) {
        unsigned char* ws = args.ws;
        pg8::Gemm g{(const bf16*)(ws + WS_HB), (const bf16*)(ws + WS_WFF2), DFF, DFF, DFF, 0}; pg8::StaticOrder S; S.init(M, DM, gridDim.x, blockIdx.x);
        pg8::EpiBf16<0> E{(bf16*)(ws + WS_A0), DM, nullptr, 0, 0};
        pg8::gemm_phase((LAS unsigned char*)lds_raw, g, S, E);
    } SEAM(8);
    if (IN(9)) { MK_FRAME(F); row_resnorm(F, F.out, F.ws + WS_A0, args.in[14], args.in[17], F.out, F.ws + WS_HN); } SEAM(9);
    if (IN(10)) {
        unsigned char* ws = args.ws;
        {   pg8::Gemm g{(const bf16*)(ws + WS_PB), (const bf16*)(ws + WS_WPP), PD, PD, PD, 0}; pg8::StaticOrder S; S.init(M, DM, gridDim.x, blockIdx.x);
            pg8::EpiF32 E{(float*)(ws + WS_E), DM};
            pg8::gemm_phase((LAS unsigned char*)lds_raw, g, S, E); }
        asm volatile("s_waitcnt vmcnt(0)" ::: "memory"); __syncthreads();
        {   pg8::Gemm g{(const bf16*)(ws + WS_HN), (const bf16*)(ws + WS_WPG), DM, DM, DM, 0}; pg8::StaticOrder S; S.init(M, DM, gridDim.x, blockIdx.x);
            pg8::EpiGateMul E{(const float*)(ws + WS_E), (bf16*)(ws + WS_A0), DM};
            pg8::gemm_phase((LAS unsigned char*)lds_raw, g, S, E); }
    } SEAM(10);
    if (IN(11)) { MK_FRAME(F); row_final(F, F.ws + WS_A0, args.in[18], F.out); }
#undef IN
#undef SEAM
#undef BARSETUP
}


#ifdef DBG_STOP
struct DbgBuf { const void* p; size_t n; int is_f32; int bit; };
__global__ void __launch_bounds__(512) dbg_scan(DbgBuf b0, DbgBuf b1, DbgBuf b2, DbgBuf b3, DbgBuf b4, DbgBuf b5, unsigned* flag) {
    DbgBuf bs[6] = {b0, b1, b2, b3, b4, b5};
    unsigned mask = 0u;
    for (int k = 0; k < 6; ++k) { const DbgBuf b = bs[k]; if (!b.p) continue; bool bad = false;
        for (size_t i = (size_t)blockIdx.x * 512 + threadIdx.x; i < b.n; i += (size_t)gridDim.x * 512) {
            const float v = b.is_f32 ? ((const float*)b.p)[i] : __uint_as_float(((unsigned)((const unsigned short*)b.p)[i]) << 16);
            if (!(fabsf(v) < 1e30f)) bad = true; }
        if (bad) mask |= 1u << b.bit; }
    if (mask) atomicOr(flag, mask);
}
__global__ void __launch_bounds__(512) dbg_write(float* out, size_t n, const unsigned* flag) {
    for (size_t i = (size_t)blockIdx.x * 512 + threadIdx.x; i < n; i += (size_t)gridDim.x * 512) out[i] = (i == 0) ? 1000.0f * (float)(*flag) : 0.f;
}
#endif
extern "C" void kernel_launch(void* const* d_in, const int* in_sizes, int n_in, void* d_out, int out_size, void* d_ws, size_t ws_size, hipStream_t stream) {
    static int grid = 0;
    if (grid == 0) {
        if (n_in != 19 || out_size != M * DM || ws_size < WS_END) { fprintf(stderr, "kernel_launch: unexpected shapes (n_in %d, out %d, ws %zu)\n", n_in, out_size, ws_size); grid = -1; return; }
        int dev = 0, cus = 0, per_cu = 0;
        if (hipGetDevice(&dev) != hipSuccess || hipDeviceGetAttribute(&cus, hipDeviceAttributeMultiprocessorCount, dev) != hipSuccess) { grid = -1; return; }
        if (hipFuncSetAttribute((const void*)fwd_mega, hipFuncAttributeMaxDynamicSharedMemorySize, LDS_BYTES) != hipSuccess) { fprintf(stderr, "kernel_launch: hipFuncSetAttribute failed\n"); grid = -1; return; }
        if (hipOccupancyMaxActiveBlocksPerMultiprocessor(&per_cu, (const void*)fwd_mega, 512, LDS_BYTES) != hipSuccess || per_cu < 1) { fprintf(stderr, "kernel_launch: occupancy query failed (%d)\n", per_cu); (void)hipGetLastError(); per_cu = 1; }
        grid = cus * (per_cu < 1 ? 1 : per_cu);
        if (grid > 256) grid = 256;
        fprintf(stderr, "kernel_launch: %d CUs, %d blocks/CU by the occupancy query, grid %d\n", cus, per_cu, grid);
    }
    if (grid < 0) return;
    (void)hipMemsetAsync((char*)d_ws + WS_CTL, 0, CTL_BYTES, stream);
    Args a{};
    for (int i = 0; i < 19; ++i) a.in[i] = (const float*)d_in[i];
    a.out = (float*)d_out; a.ws = (unsigned char*)d_ws;
#if N_LAUNCH_MODE == 1
    a.ph_lo = 0; a.ph_hi = NPHASE;
    void* kargs[] = {&a};
    hipError_t e = hipLaunchCooperativeKernel((const void*)fwd_mega, dim3(grid), dim3(512), kargs, LDS_BYTES, stream);
    if (e != hipSuccess) fprintf(stderr, "kernel_launch: cooperative launch failed: %s (grid %d)\n", hipGetErrorString(e), grid);
#else
#ifdef DBG_STOP
    for (int ph = 0; ph < DBG_STOP; ++ph) { a.ph_lo = ph; a.ph_hi = ph + 1; hipLaunchKernelGGL(fwd_mega, dim3(grid), dim3(512), LDS_BYTES, stream, a); }
    { unsigned char* ws = (unsigned char*)d_ws; unsigned char* ob = (unsigned char*)d_out; unsigned* flag = (unsigned*)(ws + WS_CTL) + 100000;
      DBG_BUFS
      hipLaunchKernelGGL(dbg_scan, dim3(1024), dim3(512), 0, stream, B0, B1, B2, B3, B4, B5, flag);
      hipLaunchKernelGGL(dbg_write, dim3(1024), dim3(512), 0, stream, (float*)d_out, (size_t)M * DM, (const unsigned*)flag); }
#else
    for (int ph = 0; ph < NPHASE; ++ph) { a.ph_lo = ph; a.ph_hi = ph + 1; hipLaunchKernelGGL(fwd_mega, dim3(grid), dim3(512), LDS_BYTES, stream, a); }
#endif
#endif
}
```

```cpp
#include <hip/hip_runtime.h>
#include <hip/hip_cooperative_groups.h>
#include <cstdio>
#include <cstdint>
namespace cg = cooperative_groups;

#ifndef GEMM_REP
#define GEMM_REP 1
#endif
#ifndef REP_P0
#define REP_P0 1
#endif
#ifndef REP_P0A
#define REP_P0A 1
#endif
#ifndef REP_P0D
#define REP_P0D 1
#endif
#ifndef REP_P2I
#define REP_P2I 1
#endif
#ifndef REP_P3
#define REP_P3 1
#endif
#ifndef REP_P4
#define REP_P4 1
#endif
#ifndef REP_MIX
#define REP_MIX 1
#endif
#ifndef REP_ROW
#define REP_ROW 1
#endif
#ifndef N_LAUNCH_MODE
#define N_LAUNCH_MODE 1
#endif

namespace pg8 {
#define PG8_LAS __attribute__((address_space(3)))
typedef unsigned short bf16_t;
typedef short bf16x8 __attribute__((ext_vector_type(8)));
typedef float f32x4 __attribute__((ext_vector_type(4)));
typedef unsigned u32x4 __attribute__((ext_vector_type(4)));
typedef unsigned u32x2 __attribute__((ext_vector_type(2)));
constexpr int BM = 256, BK = 64, HALF = 128, HTB = HALF * BK * 2, STAGE_BYTES = 8 * HTB, NXCD = 8, WGM = 8;

__host__ __device__ __forceinline__ int lds_byte(int r, int c) { const int st = (r >> 4) * 2 + (c >> 5), rr = r & 15, cc = c & 31, ob = rr * 64 + cc * 2; return st * 1024 + (ob ^ (((ob >> 9) & 1) << 5)); }
__host__ __device__ __forceinline__ void stage_rc(int b, int& R, int& C) { const int st = b / 1024, sb = b % 1024, swz = sb ^ (((sb >> 9) & 1) << 5); R = (st >> 1) * 16 + swz / 64; C = (st & 1) * 32 + (swz % 64) / 2; }
__host__ __device__ __forceinline__ int perm32(int rho) { const int n = rho >> 4, i = rho & 15; return 8 * (i >> 2) + 4 * n + (i & 3); }

struct Unit { int pm, pn; };
struct Gemm { const bf16_t* A; const bf16_t* Bt; int lda, ldb, K, a_pn_off; };

struct StaticOrder {
    int nM, nN, nwg, G, c;
    __host__ __device__ void init(int M, int N, int G_, int c_) { nM = M / BM; nN = N / BM; nwg = nM * nN; G = G_; c = c_; }
    __host__ __device__ bool next(int i, Unit& u) const {
        const long L = (long)i * G + c; if (L >= nwg) return false;
        int wgid = (int)L; { const int q = nwg / NXCD, r = nwg % NXCD, xcd = wgid % NXCD, off = wgid / NXCD; wgid = (xcd < r ? xcd * (q + 1) : r * (q + 1) + (xcd - r) * q) + off; }
        const int nig = WGM * nN, gid = wgid / nig, fm = gid * WGM, gsz = (nM - fm) < WGM ? (nM - fm) : WGM;
        u.pm = fm + ((wgid % nig) % gsz); u.pn = (wgid % nig) / gsz; return true;
    }
};

__device__ __forceinline__ unsigned cvt_pk_bf16(float lo, float hi) { unsigned r; asm volatile("v_cvt_pk_bf16_f32 %0, %1, %2" : "=v"(r) : "v"(lo), "v"(hi)); return r; }

template <int ACT  > struct EpiBf16 {
    static constexpr bool PERM = true;
    bf16_t* O; int ldc; const float* cscale; int split_cols; size_t split_stride;
    __device__ __forceinline__ void operator()(const f32x4 (&acc)[2][2][4][2], const Unit& u, int wr, int wc, int fr, int fq) const {
        const int row0 = u.pm * BM + wr * 64 + fr; int colt = u.pn * BM; bf16_t* base = O;
        if (split_cols) { const int t = colt / split_cols; base += (size_t)t * split_stride; colt -= t * split_cols; }
        const int col0 = colt + wc * 32 + 8 * fq, bcol0 = u.pn * BM + wc * 32 + 8 * fq;
        f32x4 sv[2][2];
#pragma unroll
        for (int bj = 0; bj < 2; ++bj)
#pragma unroll
            for (int n = 0; n < 2; ++n) sv[bj][n] = cscale ? *(const f32x4*)(cscale + bcol0 + bj * HALF + 4 * n) : (f32x4){1.f, 1.f, 1.f, 1.f};
#pragma unroll
        for (int ai = 0; ai < 2; ++ai)
#pragma unroll
            for (int m = 0; m < 4; ++m) { bf16_t* rowp = base + (size_t)(row0 + ai * HALF + m * 16) * ldc + col0;
#pragma unroll
                for (int bj = 0; bj < 2; ++bj) { f32x4 v0 = acc[ai][bj][m][0], v1 = acc[ai][bj][m][1];
                    if (ACT == 1) {
#pragma unroll
                        for (int j = 0; j < 4; ++j) { const float a = fmaxf(v0[j], 0.f), b = fmaxf(v1[j], 0.f); v0[j] = a * a; v1[j] = b * b; } }
                    v0 = v0 * sv[bj][0]; v1 = v1 * sv[bj][1];
                    u32x4 w; w.x = cvt_pk_bf16(v0[0], v0[1]); w.y = cvt_pk_bf16(v0[2], v0[3]); w.z = cvt_pk_bf16(v1[0], v1[1]); w.w = cvt_pk_bf16(v1[2], v1[3]);
                    *(u32x4*)(rowp + bj * HALF) = w; } }
    }
};
struct EpiF32 {
    static constexpr bool PERM = false;
    float* C; int ldc;
    __device__ __forceinline__ void operator()(const f32x4 (&acc)[2][2][4][2], const Unit& u, int wr, int wc, int fr, int fq) const {
        const int row0 = u.pm * BM + wr * 64 + fr, col0 = u.pn * BM + wc * 32 + 4 * fq;
#pragma unroll
        for (int ai = 0; ai < 2; ++ai)
#pragma unroll
            for (int m = 0; m < 4; ++m) { float* rowp = C + (size_t)(row0 + ai * HALF + m * 16) * ldc + col0;
#pragma unroll
                for (int bj = 0; bj < 2; ++bj)
#pragma unroll
                    for (int n = 0; n < 2; ++n) *(f32x4*)(rowp + bj * HALF + n * 16) = acc[ai][bj][m][n]; }
    }
};
struct EpiGateMul {
    static constexpr bool PERM = false;
    const float* E; bf16_t* O; int ldc;
    __device__ __forceinline__ void operator()(const f32x4 (&acc)[2][2][4][2], const Unit& u, int wr, int wc, int fr, int fq) const {
        const int row0 = u.pm * BM + wr * 64 + fr, col0 = u.pn * BM + wc * 32 + 4 * fq;
#pragma unroll
        for (int ai = 0; ai < 2; ++ai)
#pragma unroll
            for (int m = 0; m < 4; ++m) { const size_t ro = (size_t)(row0 + ai * HALF + m * 16) * ldc + col0;
#pragma unroll
                for (int bj = 0; bj < 2; ++bj)
#pragma unroll
                    for (int n = 0; n < 2; ++n) { const f32x4 e = *(const f32x4*)(E + ro + bj * HALF + n * 16); const f32x4 a = acc[ai][bj][m][n]; f32x4 o;
#pragma unroll
                        for (int j = 0; j < 4; ++j) o[j] = e[j] / (1.0f + __expf(-a[j]));
                        u32x2 w; w.x = cvt_pk_bf16(o[0], o[1]); w.y = cvt_pk_bf16(o[2], o[3]); *(u32x2*)(O + ro + bj * HALF + n * 16) = w; } }
    }
};

template <class Epi, class Sched>
__device__ __forceinline__ void gemm_phase(PG8_LAS unsigned char* lds, const Gemm g, const Sched& S, const Epi& E) {
    int tid_ = threadIdx.x; asm volatile("" : "+v"(tid_));
    const int tid = tid_, wid = __builtin_amdgcn_readfirstlane(tid >> 6), lane = tid & 63, wr = wid >> 2, wc = wid & 3, fr = lane & 15, fq = lane >> 4;
    const int K = g.K, nt = K / BK;
    unsigned voffA[2], voffB[2];
#pragma unroll
    for (int i = 0; i < 2; ++i) { int R, C; stage_rc(tid * 16 + i * 8192, R, C); const int Rb = Epi::PERM ? ((R & ~31) + perm32(R & 31)) : R;
        voffA[i] = (unsigned)(R * g.lda + C) * 2u; voffB[i] = (unsigned)(Rb * g.ldb + C) * 2u; }
    const size_t kstep = (size_t)(BK * 2);
    const size_t hA = (size_t)HALF * g.lda * 2, hB = (size_t)HALF * g.ldb * 2;
    const size_t tA = 2 * hA, tB = 2 * hB;
    const size_t pnA = (size_t)g.a_pn_off * 2;
    const unsigned ldsw = (unsigned)wid * 1024u;
    const int aoff = lds_byte(wr * 64 + fr, fq * 8), boff = lds_byte(wc * 32 + fr, fq * 8);
#define PG8_SA(b, h) (((b) * 2 + (h)) * HTB)
#define PG8_SB(b, h) ((4 + (b) * 2 + (h)) * HTB)
#define PG8_STAGE(bufoff, gbase, voff) do { _Pragma("unroll") for (int _i = 0; _i < 2; ++_i) \
        __builtin_amdgcn_global_load_lds((const unsigned*)((const char*)(gbase) + (voff)[_i]), (PG8_LAS unsigned*)(lds + (bufoff) + ldsw + _i * 8192), 16, 0, 0); } while (0)
#define PG8_LDA(dst, b, h) do { _Pragma("unroll") for (int m = 0; m < 4; ++m) _Pragma("unroll") for (int k = 0; k < 2; ++k) dst[m][k] = *(const PG8_LAS bf16x8*)(lds + PG8_SA(b, h) + aoff + m * 2048 + k * 1024); } while (0)
#define PG8_LDB(dst, b, h) do { _Pragma("unroll") for (int n = 0; n < 2; ++n) _Pragma("unroll") for (int k = 0; k < 2; ++k) dst[n][k] = *(const PG8_LAS bf16x8*)(lds + PG8_SB(b, h) + boff + n * 2048 + k * 1024); } while (0)
#define PG8_MMA(ai, bj, At, Bt) do { __builtin_amdgcn_s_setprio(1); _Pragma("unroll") for (int m = 0; m < 4; ++m) _Pragma("unroll") for (int n = 0; n < 2; ++n) _Pragma("unroll") for (int k = 0; k < 2; ++k) \
        acc[ai][bj][m][n] = __builtin_amdgcn_mfma_f32_16x16x32_bf16(Bt[n][k], At[m][k], acc[ai][bj][m][n], 0, 0, 0); __builtin_amdgcn_s_setprio(0); } while (0)
#define PG8_WAIT_V(n) asm volatile("s_waitcnt vmcnt(" #n ")" ::: "memory")
#define PG8_WAIT_L(n) asm volatile("s_waitcnt lgkmcnt(" #n ")" ::: "memory")
#define PG8_BAR __builtin_amdgcn_s_barrier()
#define PG8_SCHED __builtin_amdgcn_sched_barrier(0)
    Unit cur, nxt; int ui = 0;
    if (!S.next(0, cur)) return;
    f32x4 acc[2][2][4][2];
#pragma unroll
    for (int a = 0; a < 2; ++a)
#pragma unroll
        for (int b = 0; b < 2; ++b)
#pragma unroll
            for (int m = 0; m < 4; ++m)
#pragma unroll
                for (int n = 0; n < 2; ++n) acc[a][b][m][n] = (f32x4){0.f, 0.f, 0.f, 0.f};
    bf16x8 At[4][2], B0[2][2], B1[2][2];
    const char* cA = (const char*)g.A + (size_t)cur.pm * tA + (size_t)cur.pn * pnA; const char* cB = (const char*)g.Bt + (size_t)cur.pn * tB;
    PG8_STAGE(PG8_SB(0, 0), cB, voffB); PG8_STAGE(PG8_SB(0, 1), cB + hB, voffB); PG8_STAGE(PG8_SA(0, 0), cA, voffA); PG8_STAGE(PG8_SA(0, 1), cA + hA, voffA);
    if (wr == 1) PG8_BAR;
    PG8_WAIT_V(2); PG8_BAR;
    PG8_STAGE(PG8_SB(1, 0), cB + kstep, voffB); PG8_STAGE(PG8_SA(1, 0), cA + kstep, voffA); PG8_STAGE(PG8_SB(1, 1), cB + hB + kstep, voffB);
    PG8_WAIT_V(6); PG8_BAR;
    for (;;) {
        const bool has_next = S.next(ui + 1, nxt);
        const char* nA = has_next ? (const char*)g.A + (size_t)nxt.pm * tA + (size_t)nxt.pn * pnA : cA; const char* nB = has_next ? (const char*)g.Bt + (size_t)nxt.pn * tB : cB;
        for (int t = 0; t < nt; t += 2) {
            const bool last = (t == nt - 2);
            const char* a1 = cA + (size_t)(t + 1) * kstep;
            const char* a2 = last ? nA : cA + (size_t)(t + 2) * kstep; const char* b2 = last ? nB : cB + (size_t)(t + 2) * kstep;
            const char* a3 = a2 + kstep; const char* b3 = b2 + kstep;
            PG8_LDB(B0, 0, 0); PG8_LDB(B1, 0, 1); PG8_SCHED; PG8_LDA(At, 0, 0); PG8_STAGE(PG8_SA(1, 1), a1 + hA, voffA);
            PG8_WAIT_V(8); PG8_WAIT_L(0); PG8_BAR; PG8_MMA(0, 0, At, B0); PG8_MMA(0, 1, At, B1); PG8_BAR; PG8_SCHED;
            PG8_LDA(At, 0, 1); PG8_STAGE(PG8_SB(0, 0), b2, voffB); PG8_STAGE(PG8_SB(0, 1), b2 + hB, voffB); PG8_STAGE(PG8_SA(0, 0), a2, voffA);
            PG8_WAIT_V(8); PG8_WAIT_L(0); PG8_BAR; PG8_MMA(1, 0, At, B0); PG8_MMA(1, 1, At, B1); PG8_BAR; PG8_SCHED;
            PG8_LDB(B0, 1, 0); PG8_LDB(B1, 1, 1); PG8_SCHED; PG8_LDA(At, 1, 0); PG8_STAGE(PG8_SA(0, 1), a2 + hA, voffA);
            PG8_WAIT_V(8); PG8_WAIT_L(0); PG8_BAR; PG8_MMA(0, 0, At, B0); PG8_MMA(0, 1, At, B1); PG8_BAR; PG8_SCHED;
            PG8_LDA(At, 1, 1); PG8_STAGE(PG8_SB(1, 0), b3, voffB); PG8_STAGE(PG8_SB(1, 1), b3 + hB, voffB); PG8_STAGE(PG8_SA(1, 0), a3, voffA);
            PG8_WAIT_V(8); PG8_WAIT_L(0); PG8_BAR; PG8_MMA(1, 0, At, B0); PG8_MMA(1, 1, At, B1); PG8_BAR; PG8_SCHED;
        }
        if (wr == 0) PG8_BAR;
        E(acc, cur, wr, wc, fr, fq);
        if (!has_next) break;
#pragma unroll
        for (int a = 0; a < 2; ++a)
#pragma unroll
            for (int b = 0; b < 2; ++b)
#pragma unroll
                for (int m = 0; m < 4; ++m)
#pragma unroll
                    for (int n = 0; n < 2; ++n) acc[a][b][m][n] = (f32x4){0.f, 0.f, 0.f, 0.f};
        cur = nxt; cA = nA; cB = nB; ++ui;
        if (wr == 1) PG8_BAR;
    }
    PG8_WAIT_V(0);
    PG8_BAR;
#undef PG8_SA
#undef PG8_SB
#undef PG8_STAGE
#undef PG8_LDA
#undef PG8_LDB
#undef PG8_MMA
#undef PG8_WAIT_V
#undef PG8_WAIT_L
#undef PG8_BAR
#undef PG8_SCHED
}
}

constexpr int NB = 8, SEQ = 2048, DM = 2048, PD = 256, NH = 8, DH = 128, MW = 1024, PW = 1024, DFF = 8192, CH = 64, NCH = 32;
constexpr int M = NB * SEQ;
constexpr int INC = 5136, NIN = 5120;
constexpr int C_GATE = 4096, C_U = 4112;
constexpr int NITEM = NB * NH * NCH;
constexpr float EPS = 1e-6f;
constexpr size_t MiB = 1u << 20;
constexpr size_t WS_CTL = 0, CTL_BYTES = 1 * MiB;
constexpr size_t WS_WIN = 2 * MiB, WS_WOUT = 22 * MiB, WS_WFF1 = 30 * MiB, WS_WFF2 = 62 * MiB, WS_WPG = 94 * MiB, WS_WPP = 102 * MiB, WS_WPOOL = 103 * MiB;
constexpr size_t WS_GATES = 104 * MiB, WS_NLOC = 105 * MiB, WS_NPREV = 106 * MiB, WS_SCAL = 107 * MiB, WS_PB = 108 * MiB;
constexpr size_t WS_A0 = 116 * MiB;
constexpr size_t WS_Q = 180 * MiB, WS_K = 212 * MiB, WS_V = 244 * MiB, WS_O = 276 * MiB, WS_U = 308 * MiB;
constexpr size_t WS_CPREV = 180 * MiB;
constexpr size_t WS_QC = 340 * MiB, WS_KC = 372 * MiB;
constexpr size_t WS_HB = 180 * MiB;
constexpr size_t WS_E = 180 * MiB;
constexpr size_t WS_HN = 436 * MiB;
constexpr size_t WS_END = 500 * MiB;
constexpr size_t DO_MIX = 0, DO_POOLED = 64 * MiB, DO_VT = 96 * MiB;
constexpr int LDS_BYTES = 147456;
constexpr int MISC_OFF = 131072 + 320;

typedef unsigned short bf16;
typedef short bf16x8 __attribute__((ext_vector_type(8)));
typedef float f32x4 __attribute__((ext_vector_type(4)));
typedef unsigned u32x4 __attribute__((ext_vector_type(4)));
typedef unsigned u32x2 __attribute__((ext_vector_type(2)));
#define LAS __attribute__((address_space(3)))
#define LDS_WAIT() asm volatile("s_waitcnt lgkmcnt(0)" ::: "memory")

__device__ __forceinline__ float bf2f(unsigned short b) { return __uint_as_float(((unsigned)b) << 16); }
__device__ __forceinline__ float bflo(unsigned w) { return __uint_as_float(w << 16); }
__device__ __forceinline__ float bfhi(unsigned w) { return __uint_as_float(w & 0xffff0000u); }
typedef __bf16 bf16v2_t __attribute__((ext_vector_type(2)));
typedef float f32v2_t __attribute__((ext_vector_type(2)));
__device__ __forceinline__ unsigned pk2(float lo, float hi) { const bf16v2_t r = __builtin_convertvector((f32v2_t){lo, hi}, bf16v2_t); return __builtin_bit_cast(unsigned, r); }
__device__ __forceinline__ float wave_sum(float v) {
#pragma unroll
    for (int o = 1; o < 64; o <<= 1) v += __shfl_xor(v, o);
    return v;
}
__device__ __forceinline__ float wave_max(float v) {
#pragma unroll
    for (int o = 1; o < 64; o <<= 1) v = fmaxf(v, __shfl_xor(v, o));
    return v;
}
__device__ __forceinline__ float sigm(float x) { return 1.0f / (1.0f + __expf(-x)); }
__device__ __forceinline__ float logsigm(float x) { return fminf(x, 0.f) - log1pf(__expf(-fabsf(x))); }

#define XB_TMO      128
#define XB_XCNT(j)  (256  + 64 * (j))
#define XB_XSUB(j)  (1280 + 64 * (j))
#define XB_XGEN(j)  (2304 + 64 * (j))
#define XB_TOP      3328
#define XB_TOPGEN   3392
#define XCD_BAR_WORDS 3456
#define XB_SPIN_CAP (1u << 18)
__device__ __forceinline__ unsigned xb_ld(unsigned* p)              { return __hip_atomic_load(p, __ATOMIC_RELAXED, __HIP_MEMORY_SCOPE_AGENT); }
__device__ __forceinline__ unsigned xb_add(unsigned* p, unsigned v) { return __hip_atomic_fetch_add(p, v, __ATOMIC_RELAXED, __HIP_MEMORY_SCOPE_AGENT); }
__device__ __forceinline__ unsigned xb_xcc_id() { return (unsigned)__builtin_amdgcn_s_getreg((3 << 11) | 20) & 0xFu; }
#define XB_SPIN(cond, bar) do { unsigned _sp = 0; while (cond) { __builtin_amdgcn_s_sleep(1); \
    if ((++_sp & 255u) == 0u) { if (xb_ld(&(bar)[XB_TMO])) break; if (_sp > XB_SPIN_CAP) { atomicAdd(&(bar)[XB_TMO], 1u); break; } } } } while (0)
struct XcdBarrier { unsigned* bar; unsigned x; volatile LAS unsigned* st; };
__device__ __forceinline__ XcdBarrier xcd_barrier_post(unsigned* bar, volatile LAS unsigned* st) {
    XcdBarrier b; b.bar = bar; b.x = xb_xcc_id(); b.st = st;
    if (threadIdx.x == 0) (void)xb_add(&bar[XB_XCNT(b.x)], 1u);
    return b;
}
__device__ __forceinline__ void xcd_barrier_complete(unsigned* bar, unsigned x, unsigned& nloc, unsigned& nx) {
    const unsigned G = gridDim.x * gridDim.y * gridDim.z;
    unsigned sum, cnt, mine, sp = 0u;
    for (;;) {
        sum = 0u; cnt = 0u; mine = 0u;
#pragma unroll
        for (unsigned j = 0; j < 16; ++j) { const unsigned c = xb_ld(&bar[XB_XCNT(j)]); sum += c; cnt += (c > 0u) ? 1u : 0u; mine = (j == x) ? c : mine; }
        if (sum == G) break;
        __builtin_amdgcn_s_sleep(1);
        if ((++sp & 255u) == 0u) { if (xb_ld(&bar[XB_TMO])) break; if (sp > XB_SPIN_CAP) { atomicAdd(&bar[XB_TMO], 1u); break; } }
    }
    nloc = mine > 0u ? mine : 1u; nx = cnt > 0u ? cnt : 1u;
}
__device__ __forceinline__ void xcd_barrier(const XcdBarrier& b) {
    asm volatile("s_waitcnt vmcnt(0)" ::: "memory");
    __syncthreads();
    if (threadIdx.x == 0) {
        unsigned* bar = b.bar;
        __builtin_amdgcn_s_waitcnt(0);
        unsigned nloc = b.st[0], nx = b.st[1];
        if (nloc == 0u) { xcd_barrier_complete(bar, b.x, nloc, nx); b.st[0] = nloc; b.st[1] = nx; }
        const unsigned old = xb_add(&bar[XB_XSUB(b.x)], 1u);
        const unsigned gen = old / nloc;
        if (old + 1u == (gen + 1u) * nloc) {
            __builtin_amdgcn_fence(__ATOMIC_RELEASE, "agent");
            asm volatile("s_waitcnt vmcnt(0)" ::: "memory");
            const unsigned og = xb_add(&bar[XB_TOP], 1u);
            const unsigned tg = og / nx;
            if (og + 1u == (tg + 1u) * nx) xb_add(&bar[XB_TOPGEN], 1u);
            else XB_SPIN(xb_ld(&bar[XB_TOPGEN]) == tg, bar);
            __builtin_amdgcn_fence(__ATOMIC_ACQUIRE, "agent");
            xb_add(&bar[XB_XGEN(b.x)], 1u);
            asm volatile("s_waitcnt vmcnt(0)" ::: "memory");
        } else {
            XB_SPIN(xb_ld(&bar[XB_XGEN(b.x)]) == gen, bar);
            __builtin_amdgcn_fence(__ATOMIC_ACQUIRE, "agent");
            asm volatile("s_waitcnt vmcnt(0)" ::: "memory");
        }
    }
    __syncthreads();
}

struct Args { const float* in[19]; float* out; unsigned char* ws; int ph_lo, ph_hi; };
struct Frame {
    LAS unsigned char* lds;
    int tid, lane, wave, G, bid;
    const float *x, *p, *w_in, *b_gates, *w_conv, *g_mlstm, *w_pool, *pool_scale, *w_out, *g_mix_pre, *g_mix_post, *w_ff1, *w_ff2, *g_ff_pre, *g_ff_post, *w_ple_proj, *w_ple_gate, *g_ple_gate, *g_ple_post;
    float* out; unsigned char* ws; unsigned char* ob;
};
#define MK_FRAME(F) Frame F; { int t_ = threadIdx.x; asm volatile("" : "+v"(t_)); F.lds = (LAS unsigned char*)lds_raw; F.tid = t_; F.lane = t_ & 63; F.wave = __builtin_amdgcn_readfirstlane(t_ >> 6); F.G = gridDim.x; F.bid = blockIdx.x; \
    F.out = args.out; F.ws = args.ws; F.ob = (unsigned char*)args.out; }

__device__ __forceinline__ void transpose_item(const float* W, int ldw, int ns0, bf16* WT, int ldt, int nd0, int kb, int nb, int lane) {
    const float* src = W + (size_t)(64 * kb) * ldw + ns0 + 64 * nb + lane;
    bf16* dst = WT + (size_t)(nd0 + 64 * nb + lane) * ldt + 64 * kb;
#pragma unroll
    for (int h = 0; h < 2; ++h) {
        float v[32];
#pragma unroll
        for (int i = 0; i < 32; ++i) v[i] = src[(size_t)(32 * h + i) * ldw];
#pragma unroll
        for (int j = 0; j < 4; ++j) { u32x4 o; o.x = pk2(v[8 * j], v[8 * j + 1]); o.y = pk2(v[8 * j + 2], v[8 * j + 3]); o.z = pk2(v[8 * j + 4], v[8 * j + 5]); o.w = pk2(v[8 * j + 6], v[8 * j + 7]);
            *(u32x4*)(dst + 32 * h + 8 * j) = o; }
    }
}

__device__ __forceinline__ void p0_prologue(Frame& F) {
    const int gw = F.bid * 8 + F.wave, NGW = F.G * 8;
    unsigned char* ws = F.ws;
    {
        constexpr int I0 = 32 * 64, I1 = 32 * 16, I2 = 32 * 32, I3 = 32 * 128, I4 = 128 * 32, I5 = 32 * 32, I6 = 4 * 32, I7 = 4 * 16;
        constexpr int NIT = I0 + I1 + I2 + I3 + I4 + I5 + I6 + I7;
        for (int rep_ = 0; rep_ < REP_P0A; ++rep_)
        for (int it = gw; it < NIT; it += NGW) {
            int r = it;
            if (r < I0) { transpose_item(F.w_in, INC, 0, (bf16*)(ws + WS_WIN), DM, 0, r / 64, r % 64, F.lane); continue; } r -= I0;
            if (r < I1) { transpose_item(F.w_in, INC, C_U, (bf16*)(ws + WS_WIN), DM, 4096, r / 16, r % 16, F.lane); continue; } r -= I1;
            if (r < I2) { transpose_item(F.w_out, DM, 0, (bf16*)(ws + WS_WOUT), DM, 0, r / 32, r % 32, F.lane); continue; } r -= I2;
            if (r < I3) { transpose_item(F.w_ff1, DFF, 0, (bf16*)(ws + WS_WFF1), DM, 0, r / 128, r % 128, F.lane); continue; } r -= I3;
            if (r < I4) { transpose_item(F.w_ff2, DM, 0, (bf16*)(ws + WS_WFF2), DFF, 0, r / 32, r % 32, F.lane); continue; } r -= I4;
            if (r < I5) { transpose_item(F.w_ple_gate, DM, 0, (bf16*)(ws + WS_WPG), DM, 0, r / 32, r % 32, F.lane); continue; } r -= I5;
            if (r < I6) { transpose_item(F.w_ple_proj, DM, 0, (bf16*)(ws + WS_WPP), PD, 0, r / 32, r % 32, F.lane); continue; } r -= I6;
            { const int g = r / 16, rr = r % 16; transpose_item(F.w_pool + (size_t)g * 256 * 256, 256, 0, (bf16*)(ws + WS_WPOOL), 256, g * 256, rr / 4, rr % 4, F.lane); }
        }
    }
    {
        const int gt = F.bid * 512 + F.tid, NGT = F.G * 512;
        for (int i = gt; i < M * PD / 8; i += NGT) { const f32x4 a = *(const f32x4*)(F.p + (size_t)i * 8), b = *(const f32x4*)(F.p + (size_t)i * 8 + 4);
            u32x4 o; o.x = pk2(a[0], a[1]); o.y = pk2(a[2], a[3]); o.z = pk2(b[0], b[1]); o.w = pk2(b[2], b[3]); *(u32x4*)(ws + WS_PB + (size_t)i * 16) = o; }
    }
    __syncthreads();
    {
        LAS f32x4* wg = (LAS f32x4*)F.lds;
        for (int idx = F.tid; idx < 8192; idx += 512) { const int ln = idx & 63, c4 = (idx >> 6) & 3, i = (idx >> 8) & 3, jj = idx >> 10; const int k = 256 * jj + 4 * ln + i;
            wg[idx] = *(const f32x4*)(F.w_in + (size_t)k * INC + C_GATE + 4 * c4); }
    }
    __syncthreads();
    {
        const LAS f32x4* wg = (const LAS f32x4*)F.lds;
        const int lane = F.lane;
        for (int rep_ = 0; rep_ < REP_P0D; ++rep_)
        for (int m = gw; m < M; m += NGW) {
            const float* xr = F.x + (size_t)m * DM;
            f32x4 v[8]; float s = 0.f;
#pragma unroll
            for (int jj = 0; jj < 8; ++jj) { v[jj] = *(const f32x4*)(xr + 256 * jj + 4 * lane); s += (v[jj][0] * v[jj][0] + v[jj][1] * v[jj][1]) + (v[jj][2] * v[jj][2] + v[jj][3] * v[jj][3]); }
            const float rs = rsqrtf(wave_sum(s) * (1.0f / DM) + EPS);
            f32x4 ga[4];
#pragma unroll
            for (int c4 = 0; c4 < 4; ++c4) ga[c4] = (f32x4){0.f, 0.f, 0.f, 0.f};
#pragma unroll
            for (int jj = 0; jj < 8; ++jj) { const f32x4 g = *(const f32x4*)(F.g_mix_pre + 256 * jj + 4 * lane); v[jj] = v[jj] * rs * g;
                u32x2 o; o.x = pk2(v[jj][0], v[jj][1]); o.y = pk2(v[jj][2], v[jj][3]); *(u32x2*)(ws + WS_A0 + ((size_t)m * DM + 256 * jj + 4 * lane) * 2) = o;
#pragma unroll
                for (int i = 0; i < 4; ++i)
#pragma unroll
                    for (int c4 = 0; c4 < 4; ++c4) ga[c4] += wg[((jj * 4 + i) * 4 + c4) * 64 + lane] * v[jj][i];
                asm volatile("" ::: "memory"); }
            float res = 0.f;
#pragma unroll
            for (int c4 = 0; c4 < 4; ++c4)
#pragma unroll
                for (int j = 0; j < 4; ++j) { const float t = wave_sum(ga[c4][j]); if (lane == c4 * 4 + j) res = t; }
            if (lane < 16) ((float*)(ws + WS_GATES))[(size_t)m * 16 + lane] = res + F.b_gates[lane];
        }
    }
}

constexpr int PA_KT = 0, PA_VW = 18432, PA_VT = 36864, PA_W = 53248;
__device__ __forceinline__ int vt_pos(int j) { return (j & 32) | (((j >> 2) & 3) << 3) | (((j >> 4) & 1) << 2) | (j & 3); }
__device__ __forceinline__ void p2_item(Frame& F, int item) {
    unsigned char* ws = F.ws;
    const int tid = F.tid, lane = F.lane, wave = F.wave;
    const int c = item & 31, bh = item >> 5, h = bh & 7, b = bh >> 3;
    const int m0 = b * SEQ + c * CH;
    LAS unsigned char* lds = F.lds;
    LAS float* wl = (LAS float*)(lds + PA_W);
    const float* gates = (const float*)(ws + WS_GATES);
    if (wave == 0) {
        const float li = gates[(size_t)(m0 + lane) * 16 + h], lf = logsigm(gates[(size_t)(m0 + lane) * 16 + 8 + h]);
        float bs = lf;
#pragma unroll
        for (int o = 1; o < 64; o <<= 1) { const float t = __shfl_up(bs, o); if (lane >= o) bs += t; }
        const float btot = __shfl(bs, 63);
        const float a = btot - bs + li, amax = wave_max(a);
        wl[lane] = __expf(a - amax);
        if (lane == 0) { ((float*)(ws + WS_SCAL))[item] = amax; ((float*)(ws + WS_SCAL))[NITEM + item] = btot; }
    }
    const int cg8 = tid & 15, rp = tid >> 4, l0 = 2 * rp, col = h * DH + cg8 * 8;
    u32x4 qr[5], kr[5], vr[2];
#pragma unroll
    for (int i = 0; i < 5; ++i) { const int r = l0 - 3 + i; const bool ok = (c > 0) || (r >= 0);
        const size_t off = ((size_t)(m0 + r) * MW + col) * 2;
        qr[i] = ok ? *(const u32x4*)(ws + WS_Q + off) : (u32x4){0u, 0u, 0u, 0u};
        kr[i] = ok ? *(const u32x4*)(ws + WS_K + off) : (u32x4){0u, 0u, 0u, 0u}; }
#pragma unroll
    for (int i = 0; i < 2; ++i) vr[i] = *(const u32x4*)(ws + WS_V + ((size_t)(m0 + l0 + i) * MW + col) * 2);
    float wq[4][8], wk[4][8];
#pragma unroll
    for (int kk = 0; kk < 4; ++kk) { const f32x4 a = *(const f32x4*)(F.w_conv + kk * 2048 + col), b2 = *(const f32x4*)(F.w_conv + kk * 2048 + col + 4);
        const f32x4 c2 = *(const f32x4*)(F.w_conv + kk * 2048 + 1024 + col), d2 = *(const f32x4*)(F.w_conv + kk * 2048 + 1024 + col + 4);
#pragma unroll
        for (int j = 0; j < 4; ++j) { wq[kk][j] = a[j]; wq[kk][4 + j] = b2[j]; wk[kk][j] = c2[j]; wk[kk][4 + j] = d2[j]; } }
    float qy[2][8], ky[2][8];
#pragma unroll
    for (int rr = 0; rr < 2; ++rr)
#pragma unroll
        for (int j = 0; j < 8; ++j) { float aq = 0.f, ak = 0.f;
#pragma unroll
            for (int kk = 0; kk < 4; ++kk) { const unsigned wqv = qr[rr + kk][j >> 1], wkv = kr[rr + kk][j >> 1];
                const float xq = (j & 1) ? bfhi(wqv) : bflo(wqv), xk = (j & 1) ? bfhi(wkv) : bflo(wkv);
                aq += wq[kk][j] * xq; ak += wk[kk][j] * xk; }
            qy[rr][j] = aq * sigm(aq); ky[rr][j] = ak * sigm(ak) * 0.08838834764831845f; }
#pragma unroll
    for (int rr = 0; rr < 2; ++rr) { const size_t off = ((size_t)(m0 + l0 + rr) * MW + col) * 2;
        u32x4 o; o.x = pk2(qy[rr][0], qy[rr][1]); o.y = pk2(qy[rr][2], qy[rr][3]); o.z = pk2(qy[rr][4], qy[rr][5]); o.w = pk2(qy[rr][6], qy[rr][7]); *(u32x4*)(ws + WS_QC + off) = o;
        u32x4 k2; k2.x = pk2(ky[rr][0], ky[rr][1]); k2.y = pk2(ky[rr][2], ky[rr][3]); k2.z = pk2(ky[rr][4], ky[rr][5]); k2.w = pk2(ky[rr][6], ky[rr][7]); *(u32x4*)(ws + WS_KC + off) = k2; }
    __syncthreads();
    {
        const float w0 = wl[l0], w1 = wl[l0 + 1];
        const int pv = vt_pos(l0);
#pragma unroll
        for (int j = 0; j < 8; ++j) { const int e = cg8 * 8 + j;
            const float v0 = (j & 1) ? bfhi(vr[0][j >> 1]) : bflo(vr[0][j >> 1]), v1 = (j & 1) ? bfhi(vr[1][j >> 1]) : bflo(vr[1][j >> 1]);
            *(LAS unsigned*)(lds + PA_KT + e * 144 + l0 * 2) = pk2(ky[0][j], ky[1][j]);
            *(LAS unsigned*)(lds + PA_VW + e * 144 + l0 * 2) = pk2(v0 * w0, v1 * w1);
            *(LAS unsigned*)(lds + PA_VT + e * 128 + pv * 2) = pk2(v0, v1); }
    }
    __syncthreads();
    {
        const int fr = lane & 15, fq = lane >> 4;
        f32x4 acc[8];
#pragma unroll
        for (int et = 0; et < 8; ++et) acc[et] = (f32x4){0.f, 0.f, 0.f, 0.f};
#pragma unroll
        for (int ks = 0; ks < 2; ++ks) { const bf16x8 bfr = *(const LAS bf16x8*)(lds + PA_VW + (16 * wave + fr) * 144 + (32 * ks + 8 * fq) * 2);
#pragma unroll
            for (int et = 0; et < 8; ++et) { const bf16x8 afr = *(const LAS bf16x8*)(lds + PA_KT + (16 * et + fr) * 144 + (32 * ks + 8 * fq) * 2);
                acc[et] = __builtin_amdgcn_mfma_f32_16x16x32_bf16(afr, bfr, acc[et], 0, 0, 0); } }
        const int d = 16 * wave + fr;
#pragma unroll
        for (int et = 0; et < 8; ++et) { u32x2 o; o.x = pk2(acc[et][0], acc[et][1]); o.y = pk2(acc[et][2], acc[et][3]);
            *(u32x2*)(ws + WS_A0 + (((size_t)item * 128 + d) * 128 + 16 * et + 4 * fq) * 2) = o; }
    }
    if (tid < 128) { float s = 0.f;
#pragma unroll 8
        for (int l = 0; l < 64; ++l) s += wl[l] * bf2f(*(const LAS unsigned short*)(lds + PA_KT + tid * 144 + l * 2));
        ((float*)(ws + WS_NLOC))[(size_t)item * 128 + tid] = s; }
#pragma unroll
    for (int i = 0; i < 2; ++i) { const int idx = tid + 512 * i, row = idx >> 3, chk = idx & 7;
        *(u32x4*)(F.ob + DO_VT + ((size_t)item * 128 + row) * 128 + chk * 16) = *(const LAS u32x4*)(lds + PA_VT + row * 128 + chk * 16); }
    __syncthreads();
}
template <int W> __device__ __forceinline__ void pooled_item(const unsigned char* U, unsigned char* P, int m4, int c8) {
    const int t0 = m4 & (SEQ - 1);
    u32x4 rows[W + 3];
#pragma unroll
    for (int i = 0; i < W + 3; ++i) { const int dt = i - (W - 1);
        rows[i] = (t0 + dt >= 0) ? *(const u32x4*)(U + ((size_t)(m4 + dt) * PW + c8 * 8) * 2) : (u32x4){0u, 0u, 0u, 0u}; }
#pragma unroll
    for (int r = 0; r < 4; ++r) { float s[8];
#pragma unroll
        for (int j = 0; j < 8; ++j) s[j] = 0.f;
#pragma unroll
        for (int i = 0; i < W; ++i) { const u32x4 v = rows[r + i];
#pragma unroll
            for (int j = 0; j < 4; ++j) { s[2 * j] += bflo(v[j]); s[2 * j + 1] += bfhi(v[j]); } }
        const int n = (t0 + r + 1 < W) ? (t0 + r + 1) : W; const float inv = 1.0f / (float)n;
        const u32x4 cur = rows[r + W - 1]; u32x4 o;
#pragma unroll
        for (int j = 0; j < 4; ++j) o[j] = pk2(s[2 * j] * inv - bflo(cur[j]), s[2 * j + 1] * inv - bfhi(cur[j]));
        *(u32x4*)(P + ((size_t)(m4 + r) * PW + c8 * 8) * 2) = o; }
}
__device__ __forceinline__ void p2_pooled(Frame& F) {
    const int gt = F.bid * 512 + F.tid, NGT = F.G * 512;
    const unsigned char* U = F.ws + WS_U; unsigned char* P = F.ob + DO_POOLED;
    for (int i = gt; i < (M / 4) * 128; i += NGT) { const int m4 = (i >> 7) * 4, c8 = i & 127, g = c8 >> 5;
        if (g == 0) pooled_item<2>(U, P, m4, c8); else if (g == 1) pooled_item<4>(U, P, m4, c8); else if (g == 2) pooled_item<8>(U, P, m4, c8); else pooled_item<16>(U, P, m4, c8); }
}

__device__ __forceinline__ void p3_scan(Frame& F) {
    unsigned char* ws = F.ws;
    const int gt = F.bid * 512 + F.tid;
    const float* amaxp = (const float*)(ws + WS_SCAL); const float* btotp = amaxp + NITEM; float* mprev = (float*)(ws + WS_SCAL) + 2 * NITEM;
    for (int id = gt; id < 64 * 128 * 16; id += F.G * 512) {
        const int bh = id >> 11, d = (id >> 4) & 127, e8 = id & 15;
        float acc[8], nacc[8];
#pragma unroll
        for (int j = 0; j < 8; ++j) { acc[j] = 0.f; nacc[j] = 0.f; }
        float m = 0.f;
        const bool do_n = (d == 0);
#pragma unroll 4
        for (int c = 0; c < NCH; ++c) { const int item = bh * 32 + c;
            const u32x4 cl = *(const u32x4*)(ws + WS_A0 + (((size_t)item * 128 + d) * 128 + e8 * 8) * 2);
            u32x4 o; o.x = pk2(acc[0], acc[1]); o.y = pk2(acc[2], acc[3]); o.z = pk2(acc[4], acc[5]); o.w = pk2(acc[6], acc[7]);
            *(u32x4*)(ws + WS_CPREV + (((size_t)item * 128 + d) * 128 + e8 * 8) * 2) = o;
            const float amax = amaxp[item], btot = btotp[item];
            const float mn = fmaxf(btot + m, amax), dec = __expf(btot + m - mn), sc = __expf(amax - mn);
            if (do_n) { float* np = (float*)(ws + WS_NPREV) + (size_t)item * 128 + e8 * 8; const float* nl = (const float*)(ws + WS_NLOC) + (size_t)item * 128 + e8 * 8;
                *(f32x4*)np = (f32x4){nacc[0], nacc[1], nacc[2], nacc[3]}; *(f32x4*)(np + 4) = (f32x4){nacc[4], nacc[5], nacc[6], nacc[7]};
                const f32x4 a = *(const f32x4*)nl, b2 = *(const f32x4*)(nl + 4);
#pragma unroll
                for (int j = 0; j < 4; ++j) { nacc[j] = dec * nacc[j] + sc * a[j]; nacc[4 + j] = dec * nacc[4 + j] + sc * b2[j]; }
                if (e8 == 0) mprev[item] = m; }
#pragma unroll
            for (int j = 0; j < 4; ++j) { acc[2 * j] = dec * acc[2 * j] + sc * bflo(cl[j]); acc[2 * j + 1] = dec * acc[2 * j + 1] + sc * bfhi(cl[j]); }
            m = mn; }
    }
}

__device__ __forceinline__ void p4_task(Frame& F, int task) {
    unsigned char* ws = F.ws;
    const int lane = F.lane, fr = lane & 15, fq = lane >> 4;
    const int item = task >> 2, rb = task & 3;
    const int c = item & 31, bh = item >> 5, h = bh & 7, b = bh >> 3;
    const int m0 = b * SEQ + c * CH;
    const float* gates = (const float*)(ws + WS_GATES);
    const float li = gates[(size_t)(m0 + lane) * 16 + h], lf = logsigm(gates[(size_t)(m0 + lane) * 16 + 8 + h]);
    float bs = lf;
#pragma unroll
    for (int o = 1; o < 64; o <<= 1) { const float t = __shfl_up(bs, o); if (lane >= o) bs += t; }
    const float gg = li - bs;
    float pmx = gg;
#pragma unroll
    for (int o = 1; o < 64; o <<= 1) { const float t = __shfl_up(pmx, o); if (lane >= o) pmx = fmaxf(pmx, t); }
    const float m_prev = ((const float*)(ws + WS_SCAL))[2 * NITEM + item];
    const float pm = fmaxf(m_prev, pmx);
    const int l = 16 * rb + fr;
    const float b_l = __shfl(bs, l), pm_l = __shfl(pm, l);
    const float inter_w = __expf(m_prev - pm_l);
    bf16x8 qf[4];
#pragma unroll
    for (int ks = 0; ks < 4; ++ks) qf[ks] = *(const bf16x8*)(ws + WS_QC + ((size_t)(m0 + l) * MW + h * DH + 32 * ks + 8 * fq) * 2);
    f32x4 T[4];
#pragma unroll
    for (int jt = 0; jt < 4; ++jt) { T[jt] = (f32x4){0.f, 0.f, 0.f, 0.f};
        if (jt <= rb) {
#pragma unroll
            for (int ks = 0; ks < 4; ++ks) { const bf16x8 kf = *(const bf16x8*)(ws + WS_KC + ((size_t)(m0 + 16 * jt + fr) * MW + h * DH + 32 * ks + 8 * fq) * 2);
                T[jt] = __builtin_amdgcn_mfma_f32_16x16x32_bf16(kf, qf[ks], T[jt], 0, 0, 0); } } }
    float rowsum = 0.f;
#pragma unroll
    for (int jt = 0; jt < 4; ++jt)
#pragma unroll
        for (int r = 0; r < 4; ++r) { const int j = 16 * jt + 4 * fq + r; const float gj = __shfl(gg, j);
            const float wgt = (j <= l) ? __expf(gj - pm_l) : 0.f; const float sv = T[jt][r] * wgt; T[jt][r] = sv; rowsum += sv; }
    bf16x8 pf[2];
#pragma unroll
    for (int s2 = 0; s2 < 2; ++s2) { u32x4 w; w.x = pk2(T[2 * s2][0], T[2 * s2][1]); w.y = pk2(T[2 * s2][2], T[2 * s2][3]); w.z = pk2(T[2 * s2 + 1][0], T[2 * s2 + 1][1]); w.w = pk2(T[2 * s2 + 1][2], T[2 * s2 + 1][3]);
        pf[s2] = __builtin_bit_cast(bf16x8, w); }
    float nq = 0.f;
#pragma unroll
    for (int ks = 0; ks < 4; ++ks) { const float* np = (const float*)(ws + WS_NPREV) + (size_t)item * 128 + 32 * ks + 8 * fq; const f32x4 a = *(const f32x4*)np, b2 = *(const f32x4*)(np + 4);
        const u32x4 qw = __builtin_bit_cast(u32x4, qf[ks]);
        nq += a[0] * bflo(qw[0]) + a[1] * bfhi(qw[0]) + a[2] * bflo(qw[1]) + a[3] * bfhi(qw[1]) + b2[0] * bflo(qw[2]) + b2[1] * bfhi(qw[2]) + b2[2] * bflo(qw[3]) + b2[3] * bfhi(qw[3]); }
    nq += __shfl_xor(nq, 16); nq += __shfl_xor(nq, 32);
    rowsum += __shfl_xor(rowsum, 16); rowsum += __shfl_xor(rowsum, 32);
    const float den = inter_w * nq + rowsum;
    const float inv = 1.0f / fmaxf(fabsf(den), __expf(-(b_l + pm_l)));
    f32x4 acc[8]; float ss = 0.f;
#pragma unroll
    for (int dt = 0; dt < 8; ++dt) { acc[dt] = (f32x4){0.f, 0.f, 0.f, 0.f};
#pragma unroll
        for (int ks = 0; ks < 4; ++ks) { const bf16x8 cf = *(const bf16x8*)(ws + WS_CPREV + (((size_t)item * 128 + 16 * dt + fr) * 128 + 32 * ks + 8 * fq) * 2);
            acc[dt] = __builtin_amdgcn_mfma_f32_16x16x32_bf16(cf, qf[ks], acc[dt], 0, 0, 0); }
        acc[dt] = acc[dt] * inter_w;
#pragma unroll
        for (int s2 = 0; s2 < 2; ++s2) { if (s2 == 0 || rb >= 2) { const bf16x8 vf = *(const bf16x8*)(F.ob + DO_VT + (((size_t)item * 128 + 16 * dt + fr) * 64 + 32 * s2 + 8 * fq) * 2);
                acc[dt] = __builtin_amdgcn_mfma_f32_16x16x32_bf16(vf, pf[s2], acc[dt], 0, 0, 0); } }
        acc[dt] = acc[dt] * inv;
        ss += (acc[dt][0] * acc[dt][0] + acc[dt][1] * acc[dt][1]) + (acc[dt][2] * acc[dt][2] + acc[dt][3] * acc[dt][3]); }
    ss += __shfl_xor(ss, 16); ss += __shfl_xor(ss, 32);
    const float rn = rsqrtf(ss * (1.0f / DH) + EPS);
#pragma unroll
    for (int dt = 0; dt < 8; ++dt) { const int d0 = 16 * dt + 4 * fq;
        const u32x2 ow = *(const u32x2*)(ws + WS_O + ((size_t)(m0 + l) * MW + h * DH + d0) * 2);
        const f32x4 gm = *(const f32x4*)(F.g_mlstm + h * DH + d0);
        const float o0 = sigm(bflo(ow.x)) * acc[dt][0] * rn * gm[0], o1 = sigm(bfhi(ow.x)) * acc[dt][1] * rn * gm[1];
        const float o2 = sigm(bflo(ow.y)) * acc[dt][2] * rn * gm[2], o3 = sigm(bfhi(ow.y)) * acc[dt][3] * rn * gm[3];
        u32x2 o; o.x = pk2(o0, o1); o.y = pk2(o2, o3);
        *(u32x2*)(F.ob + DO_MIX + ((size_t)(m0 + l) * DM + h * DH + d0) * 2) = o; }
}

__device__ __forceinline__ void row_resnorm(Frame& F, const float* base, const unsigned char* y, const float* g1, const float* g2, float* hout, unsigned char* nout) {
    const int gw = F.bid * 8 + F.wave, NGW = F.G * 8, lane = F.lane;
    for (int m = gw; m < M; m += NGW) {
        float v[32]; float s = 0.f;
#pragma unroll
        for (int j = 0; j < 4; ++j) { const u32x4 w = *(const u32x4*)(y + ((size_t)m * DM + 512 * j + 8 * lane) * 2);
#pragma unroll
            for (int q = 0; q < 4; ++q) { v[8 * j + 2 * q] = bflo(w[q]); v[8 * j + 2 * q + 1] = bfhi(w[q]); } }
#pragma unroll
        for (int i = 0; i < 32; ++i) s += v[i] * v[i];
        const float r1 = rsqrtf(wave_sum(s) * (1.0f / DM) + EPS);
        float s2 = 0.f;
#pragma unroll
        for (int j = 0; j < 4; ++j) { const size_t co = 512 * j + 8 * lane;
            const f32x4 b0 = *(const f32x4*)(base + (size_t)m * DM + co), b1 = *(const f32x4*)(base + (size_t)m * DM + co + 4);
            const f32x4 ga = *(const f32x4*)(g1 + co), gb = *(const f32x4*)(g1 + co + 4);
#pragma unroll
            for (int q = 0; q < 4; ++q) { v[8 * j + q] = b0[q] + v[8 * j + q] * r1 * ga[q]; v[8 * j + 4 + q] = b1[q] + v[8 * j + 4 + q] * r1 * gb[q]; }
            *(f32x4*)(hout + (size_t)m * DM + co) = (f32x4){v[8 * j], v[8 * j + 1], v[8 * j + 2], v[8 * j + 3]};
            *(f32x4*)(hout + (size_t)m * DM + co + 4) = (f32x4){v[8 * j + 4], v[8 * j + 5], v[8 * j + 6], v[8 * j + 7]}; }
#pragma unroll
        for (int i = 0; i < 32; ++i) s2 += v[i] * v[i];
        const float r2 = rsqrtf(wave_sum(s2) * (1.0f / DM) + EPS);
#pragma unroll
        for (int j = 0; j < 4; ++j) { const size_t co = 512 * j + 8 * lane;
            const f32x4 ga = *(const f32x4*)(g2 + co), gb = *(const f32x4*)(g2 + co + 4);
            u32x4 o; o.x = pk2(v[8 * j] * r2 * ga[0], v[8 * j + 1] * r2 * ga[1]); o.y = pk2(v[8 * j + 2] * r2 * ga[2], v[8 * j + 3] * r2 * ga[3]);
            o.z = pk2(v[8 * j + 4] * r2 * gb[0], v[8 * j + 5] * r2 * gb[1]); o.w = pk2(v[8 * j + 6] * r2 * gb[2], v[8 * j + 7] * r2 * gb[3]);
            *(u32x4*)(nout + ((size_t)m * DM + co) * 2) = o; }
    }
}
__device__ __forceinline__ void row_final(Frame& F, const unsigned char* y, const float* g, float* out) {
    const int gw = F.bid * 8 + F.wave, NGW = F.G * 8, lane = F.lane;
    for (int m = gw; m < M; m += NGW) {
        float v[32]; float s = 0.f;
#pragma unroll
        for (int j = 0; j < 4; ++j) { const u32x4 w = *(const u32x4*)(y + ((size_t)m * DM + 512 * j + 8 * lane) * 2);
#pragma unroll
            for (int q = 0; q < 4; ++q) { v[8 * j + 2 * q] = bflo(w[q]); v[8 * j + 2 * q + 1] = bfhi(w[q]); } }
#pragma unroll
        for (int i = 0; i < 32; ++i) s += v[i] * v[i];
        const float r1 = rsqrtf(wave_sum(s) * (1.0f / DM) + EPS);
#pragma unroll
        for (int j = 0; j < 4; ++j) { const size_t co = 512 * j + 8 * lane;
            const f32x4 b0 = *(const f32x4*)(out + (size_t)m * DM + co), b1 = *(const f32x4*)(out + (size_t)m * DM + co + 4);
            const f32x4 ga = *(const f32x4*)(g + co), gb = *(const f32x4*)(g + co + 4);
            f32x4 o0, o1;
#pragma unroll
            for (int q = 0; q < 4; ++q) { o0[q] = b0[q] + v[8 * j + q] * r1 * ga[q]; o1[q] = b1[q] + v[8 * j + 4 + q] * r1 * gb[q]; }
#ifdef DBG_SANITIZE
#pragma unroll
            for (int q = 0; q < 4; ++q) { if (!(fabsf(o0[q]) < 1e30f)) o0[q] = 1.0e4f; if (!(fabsf(o1[q]) < 1e30f)) o1[q] = 1.0e4f; }
#endif
            *(f32x4*)(out + (size_t)m * DM + co) = o0; *(f32x4*)(out + (size_t)m * DM + co + 4) = o1; }
    }
}

constexpr int NPHASE = 12;
__global__ void __launch_bounds__(512, 2) fwd_mega(const Args args) {
    extern __shared__ __attribute__((aligned(16))) unsigned char lds_raw[];
    {
        const int t0 = threadIdx.x;
        for (int u = t0; u < (LDS_BYTES - 131072) / 4; u += 512) ((LAS unsigned*)((LAS unsigned char*)lds_raw + 131072))[u] = 0u;
    }
    __syncthreads();
    const int lo = args.ph_lo, hi = args.ph_hi;
#define IN(k) (lo <= (k) && (k) < hi)
#define BARSETUP() XcdBarrier bar; bar.bar = (unsigned*)(args.ws + WS_CTL) + 4096; bar.x = xb_xcc_id(); bar.st = (volatile LAS unsigned*)((LAS unsigned char*)lds_raw + MISC_OFF) + 8;
#define SEAM(k) do { if (IN(k) && IN((k) + 1)) { if ((k) == 0) { cg::this_grid().sync(); } else { BARSETUP(); xcd_barrier(bar); } } } while (0)
    if (hi - lo > 1) { if (threadIdx.x == 0) (void)xb_add((unsigned*)(args.ws + WS_CTL) + 4096 + XB_XCNT(xb_xcc_id()), 1u); }

    if (IN(0)) { MK_FRAME(F); F.x = args.in[0]; F.p = args.in[1]; F.w_in = args.in[2]; F.b_gates = args.in[3]; F.w_pool = args.in[6]; F.w_out = args.in[8]; F.g_mix_pre = args.in[9];
        F.w_ff1 = args.in[11]; F.w_ff2 = args.in[12]; F.w_ple_proj = args.in[15]; F.w_ple_gate = args.in[16];
        for (int rep_ = 0; rep_ < REP_P0; ++rep_) { p0_prologue(F); __syncthreads(); } } SEAM(0);
    if (IN(1)) {
        unsigned char* ws = args.ws;
        pg8::Gemm g{(const bf16*)(ws + WS_A0), (const bf16*)(ws + WS_WIN), DM, DM, DM, 0}; pg8::StaticOrder S; S.init(M, NIN, gridDim.x, blockIdx.x);
        pg8::EpiBf16<0> E{(bf16*)(ws + WS_Q), MW, nullptr, 1024, (size_t)(WS_K - WS_Q) / 2};
        for (int rep_ = 0; rep_ < GEMM_REP; ++rep_) pg8::gemm_phase((LAS unsigned char*)lds_raw, g, S, E);
    } SEAM(1);
    if (IN(2)) { MK_FRAME(F); F.w_conv = args.in[4];
        for (int rep_ = 0; rep_ < REP_P2I; ++rep_)
        for (int it = F.bid; it < NITEM; it += F.G) p2_item(F, it);
        for (int rep_ = 0; rep_ < REP_MIX; ++rep_) p2_pooled(F);
    } SEAM(2);
    if (IN(3)) { for (int rep_ = 0; rep_ < REP_P3; ++rep_) {
        {
            unsigned char* ws = args.ws; unsigned char* ob = (unsigned char*)args.out;
            pg8::Gemm g{(const bf16*)(ob + DO_POOLED), (const bf16*)(ws + WS_WPOOL), PW, 256, 256, 256}; pg8::StaticOrder S; S.init(M, PW, gridDim.x, blockIdx.x);
            pg8::EpiBf16<0> E{(bf16*)(ob + DO_MIX) + 1024, DM, args.in[7], 0, 0};
            pg8::gemm_phase((LAS unsigned char*)lds_raw, g, S, E);
        }
        { MK_FRAME(F); p3_scan(F); } }
    } SEAM(3);
    if (IN(4)) { MK_FRAME(F); F.g_mlstm = args.in[5];
        const int gw = F.bid * 8 + F.wave, NGW = F.G * 8;
        for (int rep_ = 0; rep_ < REP_P4; ++rep_)
        for (int task = gw; task < NITEM * 4; task += NGW) p4_task(F, task);
    } SEAM(4);
    if (IN(5)) {
        unsigned char* ws = args.ws; unsigned char* ob = (unsigned char*)args.out;
        pg8::Gemm g{(const bf16*)(ob + DO_MIX), (const bf16*)(ws + WS_WOUT), DM, DM, DM, 0}; pg8::StaticOrder S; S.init(M, DM, gridDim.x, blockIdx.x);
        pg8::EpiBf16<0> E{(bf16*)(ws + WS_A0), DM, nullptr, 0, 0};
        for (int rep_ = 0; rep_ < GEMM_REP; ++rep_) pg8::gemm_phase((LAS unsigned char*)lds_raw, g, S, E);
    } SEAM(5);
    if (IN(6)) { MK_FRAME(F); for (int rep_ = 0; rep_ < REP_ROW; ++rep_) row_resnorm(F, args.in[0], F.ws + WS_A0, args.in[10], args.in[13], F.out, F.ws + WS_HN); } SEAM(6);
    if (IN(7)) {
        unsigned char* ws = args.ws;
        pg8::Gemm g{(const bf16*)(ws + WS_HN), (const bf16*)(ws + WS_WFF1), DM, DM, DM, 0}; pg8::StaticOrder S; S.init(M, DFF, gridDim.x, blockIdx.x);
        pg8::EpiBf16<1> E{(bf16*)(ws + WS_HB), DFF, nullptr, 0, 0};
        for (int rep_ = 0; rep_ < GEMM_REP; ++rep_) pg8::gemm_phase((LAS unsigned char*)lds_raw, g, S, E);
    } SEAM(7);
    if (IN(8)) {
        unsigned char* ws = args.ws;
        pg8::Gemm g{(const bf16*)(ws + WS_HB), (const bf16*)(ws + WS_WFF2), DFF, DFF, DFF, 0}; pg8::StaticOrder S; S.init(M, DM, gridDim.x, blockIdx.x);
        pg8::EpiBf16<0> E{(bf16*)(ws + WS_A0), DM, nullptr, 0, 0};
        for (int rep_ = 0; rep_ < GEMM_REP; ++rep_) pg8::gemm_phase((LAS unsigned char*)lds_raw, g, S, E);
    } SEAM(8);
    if (IN(9)) { MK_FRAME(F); row_resnorm(F, F.out, F.ws + WS_A0, args.in[14], args.in[17], F.out, F.ws + WS_HN); } SEAM(9);
    if (IN(10)) {
        unsigned char* ws = args.ws;
        {   pg8::Gemm g{(const bf16*)(ws + WS_PB), (const bf16*)(ws + WS_WPP), PD, PD, PD, 0}; pg8::StaticOrder S; S.init(M, DM, gridDim.x, blockIdx.x);
            pg8::EpiF32 E{(float*)(ws + WS_E), DM};
            for (int rep_ = 0; rep_ < GEMM_REP; ++rep_) pg8::gemm_phase((LAS unsigned char*)lds_raw, g, S, E); }
        asm volatile("s_waitcnt vmcnt(0)" ::: "memory"); __syncthreads();
        {   pg8::Gemm g{(const bf16*)(ws + WS_HN), (const bf16*)(ws + WS_WPG), DM, DM, DM, 0}; pg8::StaticOrder S; S.init(M, DM, gridDim.x, blockIdx.x);
            pg8::EpiGateMul E{(const float*)(ws + WS_E), (bf16*)(ws + WS_A0), DM};
            for (int rep_ = 0; rep_ < GEMM_REP; ++rep_) pg8::gemm_phase((LAS unsigned char*)lds_raw, g, S, E); }
    } SEAM(10);
    if (IN(11)) { MK_FRAME(F); row_final(F, F.ws + WS_A0, args.in[18], F.out); }
#undef IN
#undef SEAM
#undef BARSETUP
}


#ifdef DBG_STOP
struct DbgBuf { const void* p; size_t n; int is_f32; int bit; };
__global__ void __launch_bounds__(512) dbg_scan(DbgBuf b0, DbgBuf b1, DbgBuf b2, DbgBuf b3, DbgBuf b4, DbgBuf b5, unsigned* flag) {
    DbgBuf bs[6] = {b0, b1, b2, b3, b4, b5};
    unsigned mask = 0u;
    for (int k = 0; k < 6; ++k) { const DbgBuf b = bs[k]; if (!b.p) continue; bool bad = false;
        for (size_t i = (size_t)blockIdx.x * 512 + threadIdx.x; i < b.n; i += (size_t)gridDim.x * 512) {
            const float v = b.is_f32 ? ((const float*)b.p)[i] : __uint_as_float(((unsigned)((const unsigned short*)b.p)[i]) << 16);
            if (!(fabsf(v) < 1e30f)) bad = true; }
        if (bad) mask |= 1u << b.bit; }
    if (mask) atomicOr(flag, mask);
}
__global__ void __launch_bounds__(512) dbg_write(float* out, size_t n, const unsigned* flag) {
    for (size_t i = (size_t)blockIdx.x * 512 + threadIdx.x; i < n; i += (size_t)gridDim.x * 512) out[i] = (i == 0) ? 1000.0f * (float)(*flag) : 0.f;
}
#endif
extern "C" void kernel_launch(void* const* d_in, const int* in_sizes, int n_in, void* d_out, int out_size, void* d_ws, size_t ws_size, hipStream_t stream) {
    static int grid = 0;
    if (grid == 0) {
        if (n_in != 19 || out_size != M * DM || ws_size < WS_END) { fprintf(stderr, "kernel_launch: unexpected shapes (n_in %d, out %d, ws %zu)\n", n_in, out_size, ws_size); grid = -1; return; }
        int dev = 0, cus = 0, per_cu = 0;
        if (hipGetDevice(&dev) != hipSuccess || hipDeviceGetAttribute(&cus, hipDeviceAttributeMultiprocessorCount, dev) != hipSuccess) { grid = -1; return; }
        if (hipFuncSetAttribute((const void*)fwd_mega, hipFuncAttributeMaxDynamicSharedMemorySize, LDS_BYTES) != hipSuccess) { fprintf(stderr, "kernel_launch: hipFuncSetAttribute failed\n"); grid = -1; return; }
        if (hipOccupancyMaxActiveBlocksPerMultiprocessor(&per_cu, (const void*)fwd_mega, 512, LDS_BYTES) != hipSuccess || per_cu < 1) { fprintf(stderr, "kernel_launch: occupancy query failed (%d)\n", per_cu); (void)hipGetLastError(); per_cu = 1; }
        grid = cus * (per_cu < 1 ? 1 : per_cu);
        if (grid > 256) grid = 256;
        fprintf(stderr, "kernel_launch: %d CUs, %d blocks/CU by the occupancy query, grid %d\n", cus, per_cu, grid);
    }
    if (grid < 0) return;
    (void)hipMemsetAsync((char*)d_ws + WS_CTL, 0, CTL_BYTES, stream);
    Args a{};
    for (int i = 0; i < 19; ++i) a.in[i] = (const float*)d_in[i];
    a.out = (float*)d_out; a.ws = (unsigned char*)d_ws;
#if N_LAUNCH_MODE == 1
    a.ph_lo = 0; a.ph_hi = NPHASE;
    void* kargs[] = {&a};
    hipError_t e = hipLaunchCooperativeKernel((const void*)fwd_mega, dim3(grid), dim3(512), kargs, LDS_BYTES, stream);
    if (e != hipSuccess) fprintf(stderr, "kernel_launch: cooperative launch failed: %s (grid %d)\n", hipGetErrorString(e), grid);
#else
#ifdef DBG_STOP
    for (int ph = 0; ph < DBG_STOP; ++ph) { a.ph_lo = ph; a.ph_hi = ph + 1; hipLaunchKernelGGL(fwd_mega, dim3(grid), dim3(512), LDS_BYTES, stream, a); }
    { unsigned char* ws = (unsigned char*)d_ws; unsigned char* ob = (unsigned char*)d_out; unsigned* flag = (unsigned*)(ws + WS_CTL) + 100000;
      DBG_BUFS
      hipLaunchKernelGGL(dbg_scan, dim3(1024), dim3(512), 0, stream, B0, B1, B2, B3, B4, B5, flag);
      hipLaunchKernelGGL(dbg_write, dim3(1024), dim3(512), 0, stream, (float*)d_out, (size_t)M * DM, (const unsigned*)flag); }
#else
    for (int ph = 0; ph < NPHASE; ++ph) { a.ph_lo = ph; a.ph_hi = ph + 1; hipLaunchKernelGGL(fwd_mega, dim3(grid), dim3(512), LDS_BYTES, stream, a); }
#endif
#endif
}
```

```cpp
#include <hip/hip_runtime.h>
#include <hip/hip_cooperative_groups.h>
#include <cstdio>
#include <cstdint>
namespace cg = cooperative_groups;

#ifndef GEMM_REP
#define GEMM_REP 1
#endif
#ifndef REP_P0
#define REP_P0 1
#endif
#ifndef REP_P0A
#define REP_P0A 1
#endif
#ifndef REP_P0D
#define REP_P0D 1
#endif
#ifndef REP_P2I
#define REP_P2I 1
#endif
#ifndef REP_P3
#define REP_P3 1
#endif
#ifndef REP_P4
#define REP_P4 1
#endif
#ifndef REP_MIX
#define REP_MIX 1
#endif
#ifndef REP_ROW
#define REP_ROW 1
#endif
#ifndef N_LAUNCH_MODE
#define N_LAUNCH_MODE 1
#endif

namespace pg8 {
#define PG8_LAS __attribute__((address_space(3)))
typedef unsigned short bf16_t;
typedef short bf16x8 __attribute__((ext_vector_type(8)));
typedef float f32x4 __attribute__((ext_vector_type(4)));
typedef unsigned u32x4 __attribute__((ext_vector_type(4)));
typedef unsigned u32x2 __attribute__((ext_vector_type(2)));
constexpr int BM = 256, BK = 64, HALF = 128, HTB = HALF * BK * 2, STAGE_BYTES = 8 * HTB, NXCD = 8, WGM = 8;

__host__ __device__ __forceinline__ int lds_byte(int r, int c) { const int st = (r >> 4) * 2 + (c >> 5), rr = r & 15, cc = c & 31, ob = rr * 64 + cc * 2; return st * 1024 + (ob ^ (((ob >> 9) & 1) << 5)); }
__host__ __device__ __forceinline__ void stage_rc(int b, int& R, int& C) { const int st = b / 1024, sb = b % 1024, swz = sb ^ (((sb >> 9) & 1) << 5); R = (st >> 1) * 16 + swz / 64; C = (st & 1) * 32 + (swz % 64) / 2; }
__host__ __device__ __forceinline__ int perm32(int rho) { const int n = rho >> 4, i = rho & 15; return 8 * (i >> 2) + 4 * n + (i & 3); }

struct Unit { int pm, pn; };
struct Gemm { const bf16_t* A; const bf16_t* Bt; int lda, ldb, K, a_pn_off; };

struct StaticOrder {
    int nM, nN, nwg, G, c;
    __host__ __device__ void init(int M, int N, int G_, int c_) { nM = M / BM; nN = N / BM; nwg = nM * nN; G = G_; c = c_; }
    __host__ __device__ bool next(int i, Unit& u) const {
        const long L = (long)i * G + c; if (L >= nwg) return false;
        int wgid = (int)L; { const int q = nwg / NXCD, r = nwg % NXCD, xcd = wgid % NXCD, off = wgid / NXCD; wgid = (xcd < r ? xcd * (q + 1) : r * (q + 1) + (xcd - r) * q) + off; }
        const int nig = WGM * nN, gid = wgid / nig, fm = gid * WGM, gsz = (nM - fm) < WGM ? (nM - fm) : WGM;
        u.pm = fm + ((wgid % nig) % gsz); u.pn = (wgid % nig) / gsz; return true;
    }
};

__device__ __forceinline__ unsigned cvt_pk_bf16(float lo, float hi) { unsigned r; asm volatile("v_cvt_pk_bf16_f32 %0, %1, %2" : "=v"(r) : "v"(lo), "v"(hi)); return r; }

template <int ACT  > struct EpiBf16 {
    static constexpr bool PERM = true;
    bf16_t* O; int ldc; const float* cscale; int split_cols; size_t split_stride;
    __device__ __forceinline__ void operator()(const f32x4 (&acc)[2][2][4][2], const Unit& u, int wr, int wc, int fr, int fq) const {
        const int row0 = u.pm * BM + wr * 64 + fr; int colt = u.pn * BM; bf16_t* base = O;
        if (split_cols) { const int t = colt / split_cols; base += (size_t)t * split_stride; colt -= t * split_cols; }
        const int col0 = colt + wc * 32 + 8 * fq, bcol0 = u.pn * BM + wc * 32 + 8 * fq;
        f32x4 sv[2][2];
#pragma unroll
        for (int bj = 0; bj < 2; ++bj)
#pragma unroll
            for (int n = 0; n < 2; ++n) sv[bj][n] = cscale ? *(const f32x4*)(cscale + bcol0 + bj * HALF + 4 * n) : (f32x4){1.f, 1.f, 1.f, 1.f};
#pragma unroll
        for (int ai = 0; ai < 2; ++ai)
#pragma unroll
            for (int m = 0; m < 4; ++m) { bf16_t* rowp = base + (size_t)(row0 + ai * HALF + m * 16) * ldc + col0;
#pragma unroll
                for (int bj = 0; bj < 2; ++bj) { f32x4 v0 = acc[ai][bj][m][0], v1 = acc[ai][bj][m][1];
                    if (ACT == 1) {
#pragma unroll
                        for (int j = 0; j < 4; ++j) { const float a = fmaxf(v0[j], 0.f), b = fmaxf(v1[j], 0.f); v0[j] = a * a; v1[j] = b * b; } }
                    v0 = v0 * sv[bj][0]; v1 = v1 * sv[bj][1];
                    u32x4 w; w.x = cvt_pk_bf16(v0[0], v0[1]); w.y = cvt_pk_bf16(v0[2], v0[3]); w.z = cvt_pk_bf16(v1[0], v1[1]); w.w = cvt_pk_bf16(v1[2], v1[3]);
                    *(u32x4*)(rowp + bj * HALF) = w; } }
    }
};
struct EpiF32 {
    static constexpr bool PERM = false;
    float* C; int ldc;
    __device__ __forceinline__ void operator()(const f32x4 (&acc)[2][2][4][2], const Unit& u, int wr, int wc, int fr, int fq) const {
        const int row0 = u.pm * BM + wr * 64 + fr, col0 = u.pn * BM + wc * 32 + 4 * fq;
#pragma unroll
        for (int ai = 0; ai < 2; ++ai)
#pragma unroll
            for (int m = 0; m < 4; ++m) { float* rowp = C + (size_t)(row0 + ai * HALF + m * 16) * ldc + col0;
#pragma unroll
                for (int bj = 0; bj < 2; ++bj)
#pragma unroll
                    for (int n = 0; n < 2; ++n) *(f32x4*)(rowp + bj * HALF + n * 16) = acc[ai][bj][m][n]; }
    }
};
struct EpiGateMul {
    static constexpr bool PERM = false;
    const float* E; bf16_t* O; int ldc;
    __device__ __forceinline__ void operator()(const f32x4 (&acc)[2][2][4][2], const Unit& u, int wr, int wc, int fr, int fq) const {
        const int row0 = u.pm * BM + wr * 64 + fr, col0 = u.pn * BM + wc * 32 + 4 * fq;
#pragma unroll
        for (int ai = 0; ai < 2; ++ai)
#pragma unroll
            for (int m = 0; m < 4; ++m) { const size_t ro = (size_t)(row0 + ai * HALF + m * 16) * ldc + col0;
#pragma unroll
                for (int bj = 0; bj < 2; ++bj)
#pragma unroll
                    for (int n = 0; n < 2; ++n) { const f32x4 e = *(const f32x4*)(E + ro + bj * HALF + n * 16); const f32x4 a = acc[ai][bj][m][n]; f32x4 o;
#pragma unroll
                        for (int j = 0; j < 4; ++j) o[j] = e[j] / (1.0f + __expf(-a[j]));
                        u32x2 w; w.x = cvt_pk_bf16(o[0], o[1]); w.y = cvt_pk_bf16(o[2], o[3]); *(u32x2*)(O + ro + bj * HALF + n * 16) = w; } }
    }
};

template <class Epi, class Sched>
__device__ __forceinline__ void gemm_phase(PG8_LAS unsigned char* lds, const Gemm g, const Sched& S, const Epi& E) {
    int tid_ = threadIdx.x; asm volatile("" : "+v"(tid_));
    const int tid = tid_, wid = __builtin_amdgcn_readfirstlane(tid >> 6), lane = tid & 63, wr = wid >> 2, wc = wid & 3, fr = lane & 15, fq = lane >> 4;
    const int K = g.K, nt = K / BK;
    unsigned voffA[2], voffB[2];
#pragma unroll
    for (int i = 0; i < 2; ++i) { int R, C; stage_rc(tid * 16 + i * 8192, R, C); const int Rb = Epi::PERM ? ((R & ~31) + perm32(R & 31)) : R;
        voffA[i] = (unsigned)(R * g.lda + C) * 2u; voffB[i] = (unsigned)(Rb * g.ldb + C) * 2u; }
    const size_t kstep = (size_t)(BK * 2);
    const size_t hA = (size_t)HALF * g.lda * 2, hB = (size_t)HALF * g.ldb * 2;
    const size_t tA = 2 * hA, tB = 2 * hB;
    const size_t pnA = (size_t)g.a_pn_off * 2;
    const unsigned ldsw = (unsigned)wid * 1024u;
    const int aoff = lds_byte(wr * 64 + fr, fq * 8), boff = lds_byte(wc * 32 + fr, fq * 8);
#define PG8_SA(b, h) (((b) * 2 + (h)) * HTB)
#define PG8_SB(b, h) ((4 + (b) * 2 + (h)) * HTB)
#define PG8_STAGE(bufoff, gbase, voff) do { _Pragma("unroll") for (int _i = 0; _i < 2; ++_i) \
        __builtin_amdgcn_global_load_lds((const unsigned*)((const char*)(gbase) + (voff)[_i]), (PG8_LAS unsigned*)(lds + (bufoff) + ldsw + _i * 8192), 16, 0, 0); } while (0)
#define PG8_LDA(dst, b, h) do { _Pragma("unroll") for (int m = 0; m < 4; ++m) _Pragma("unroll") for (int k = 0; k < 2; ++k) dst[m][k] = *(const PG8_LAS bf16x8*)(lds + PG8_SA(b, h) + aoff + m * 2048 + k * 1024); } while (0)
#define PG8_LDB(dst, b, h) do { _Pragma("unroll") for (int n = 0; n < 2; ++n) _Pragma("unroll") for (int k = 0; k < 2; ++k) dst[n][k] = *(const PG8_LAS bf16x8*)(lds + PG8_SB(b, h) + boff + n * 2048 + k * 1024); } while (0)
#define PG8_MMA(ai, bj, At, Bt) do { __builtin_amdgcn_s_setprio(1); _Pragma("unroll") for (int m = 0; m < 4; ++m) _Pragma("unroll") for (int n = 0; n < 2; ++n) _Pragma("unroll") for (int k = 0; k < 2; ++k) \
        acc[ai][bj][m][n] = __builtin_amdgcn_mfma_f32_16x16x32_bf16(Bt[n][k], At[m][k], acc[ai][bj][m][n], 0, 0, 0); __builtin_amdgcn_s_setprio(0); } while (0)
#define PG8_WAIT_V(n) asm volatile("s_waitcnt vmcnt(" #n ")" ::: "memory")
#define PG8_WAIT_L(n) asm volatile("s_waitcnt lgkmcnt(" #n ")" ::: "memory")
#define PG8_BAR __builtin_amdgcn_s_barrier()
#define PG8_SCHED __builtin_amdgcn_sched_barrier(0)
    Unit cur, nxt; int ui = 0;
    if (!S.next(0, cur)) return;
    f32x4 acc[2][2][4][2];
#pragma unroll
    for (int a = 0; a < 2; ++a)
#pragma unroll
        for (int b = 0; b < 2; ++b)
#pragma unroll
            for (int m = 0; m < 4; ++m)
#pragma unroll
                for (int n = 0; n < 2; ++n) acc[a][b][m][n] = (f32x4){0.f, 0.f, 0.f, 0.f};
    bf16x8 At[4][2], B0[2][2], B1[2][2];
    const char* cA = (const char*)g.A + (size_t)cur.pm * tA + (size_t)cur.pn * pnA; const char* cB = (const char*)g.Bt + (size_t)cur.pn * tB;
    PG8_STAGE(PG8_SB(0, 0), cB, voffB); PG8_STAGE(PG8_SB(0, 1), cB + hB, voffB); PG8_STAGE(PG8_SA(0, 0), cA, voffA); PG8_STAGE(PG8_SA(0, 1), cA + hA, voffA);
    if (wr == 1) PG8_BAR;
    PG8_WAIT_V(2); PG8_BAR;
    PG8_STAGE(PG8_SB(1, 0), cB + kstep, voffB); PG8_STAGE(PG8_SA(1, 0), cA + kstep, voffA); PG8_STAGE(PG8_SB(1, 1), cB + hB + kstep, voffB);
    PG8_WAIT_V(6); PG8_BAR;
    for (;;) {
        const bool has_next = S.next(ui + 1, nxt);
        const char* nA = has_next ? (const char*)g.A + (size_t)nxt.pm * tA + (size_t)nxt.pn * pnA : cA; const char* nB = has_next ? (const char*)g.Bt + (size_t)nxt.pn * tB : cB;
        for (int t = 0; t < nt; t += 2) {
            const bool last = (t == nt - 2);
            const char* a1 = cA + (size_t)(t + 1) * kstep;
            const char* a2 = last ? nA : cA + (size_t)(t + 2) * kstep; const char* b2 = last ? nB : cB + (size_t)(t + 2) * kstep;
            const char* a3 = a2 + kstep; const char* b3 = b2 + kstep;
            PG8_LDB(B0, 0, 0); PG8_LDB(B1, 0, 1); PG8_SCHED; PG8_LDA(At, 0, 0); PG8_STAGE(PG8_SA(1, 1), a1 + hA, voffA);
            PG8_WAIT_V(8); PG8_WAIT_L(0); PG8_BAR; PG8_MMA(0, 0, At, B0); PG8_MMA(0, 1, At, B1); PG8_BAR; PG8_SCHED;
            PG8_LDA(At, 0, 1); PG8_STAGE(PG8_SB(0, 0), b2, voffB); PG8_STAGE(PG8_SB(0, 1), b2 + hB, voffB); PG8_STAGE(PG8_SA(0, 0), a2, voffA);
            PG8_WAIT_V(8); PG8_WAIT_L(0); PG8_BAR; PG8_MMA(1, 0, At, B0); PG8_MMA(1, 1, At, B1); PG8_BAR; PG8_SCHED;
            PG8_LDB(B0, 1, 0); PG8_LDB(B1, 1, 1); PG8_SCHED; PG8_LDA(At, 1, 0); PG8_STAGE(PG8_SA(0, 1), a2 + hA, voffA);
            PG8_WAIT_V(8); PG8_WAIT_L(0); PG8_BAR; PG8_MMA(0, 0, At, B0); PG8_MMA(0, 1, At, B1); PG8_BAR; PG8_SCHED;
            PG8_LDA(At, 1, 1); PG8_STAGE(PG8_SB(1, 0), b3, voffB); PG8_STAGE(PG8_SB(1, 1), b3 + hB, voffB); PG8_STAGE(PG8_SA(1, 0), a3, voffA);
            PG8_WAIT_V(8); PG8_WAIT_L(0); PG8_BAR; PG8_MMA(1, 0, At, B0); PG8_MMA(1, 1, At, B1); PG8_BAR; PG8_SCHED;
        }
        if (wr == 0) PG8_BAR;
        E(acc, cur, wr, wc, fr, fq);
        if (!has_next) break;
#pragma unroll
        for (int a = 0; a < 2; ++a)
#pragma unroll
            for (int b = 0; b < 2; ++b)
#pragma unroll
                for (int m = 0; m < 4; ++m)
#pragma unroll
                    for (int n = 0; n < 2; ++n) acc[a][b][m][n] = (f32x4){0.f, 0.f, 0.f, 0.f};
        cur = nxt; cA = nA; cB = nB; ++ui;
        if (wr == 1) PG8_BAR;
    }
    PG8_WAIT_V(0);
    PG8_BAR;
#undef PG8_SA
#undef PG8_SB
#undef PG8_STAGE
#undef PG8_LDA
#undef PG8_LDB
#undef PG8_MMA
#undef PG8_WAIT_V
#undef PG8_WAIT_L
#undef PG8_BAR
#undef PG8_SCHED
}
}

constexpr int NB = 8, SEQ = 2048, DM = 2048, PD = 256, NH = 8, DH = 128, MW = 1024, PW = 1024, DFF = 8192, CH = 64, NCH = 32;
constexpr int M = NB * SEQ;
constexpr int INC = 5136, NIN = 5120;
constexpr int C_GATE = 4096, C_U = 4112;
constexpr int NITEM = NB * NH * NCH;
constexpr float EPS = 1e-6f;
constexpr size_t MiB = 1u << 20;
constexpr size_t WS_CTL = 0, CTL_BYTES = 1 * MiB;
constexpr size_t WS_WIN = 2 * MiB, WS_WOUT = 22 * MiB, WS_WFF1 = 30 * MiB, WS_WFF2 = 62 * MiB, WS_WPG = 94 * MiB, WS_WPP = 102 * MiB, WS_WPOOL = 103 * MiB;
constexpr size_t WS_GATES = 104 * MiB, WS_NLOC = 105 * MiB, WS_NPREV = 106 * MiB, WS_SCAL = 107 * MiB, WS_PB = 108 * MiB;
constexpr size_t WS_A0 = 116 * MiB;
constexpr size_t WS_Q = 180 * MiB, WS_K = 212 * MiB, WS_V = 244 * MiB, WS_O = 276 * MiB, WS_U = 308 * MiB;
constexpr size_t WS_CPREV = 180 * MiB;
constexpr size_t WS_QC = 340 * MiB, WS_KC = 372 * MiB;
constexpr size_t WS_HB = 180 * MiB;
constexpr size_t WS_E = 180 * MiB;
constexpr size_t WS_HN = 436 * MiB;
constexpr size_t WS_END = 500 * MiB;
constexpr size_t DO_MIX = 0, DO_POOLED = 64 * MiB, DO_VT = 96 * MiB;
constexpr size_t DO_H1B = 0;
constexpr size_t WS_H2B = 308 * MiB;
constexpr int LDS_BYTES = 147456;
constexpr int MISC_OFF = 131072 + 320;

typedef unsigned short bf16;
typedef short bf16x8 __attribute__((ext_vector_type(8)));
typedef float f32x4 __attribute__((ext_vector_type(4)));
typedef unsigned u32x4 __attribute__((ext_vector_type(4)));
typedef unsigned u32x2 __attribute__((ext_vector_type(2)));
#define LAS __attribute__((address_space(3)))
#define LDS_WAIT() asm volatile("s_waitcnt lgkmcnt(0)" ::: "memory")

__device__ __forceinline__ float bf2f(unsigned short b) { return __uint_as_float(((unsigned)b) << 16); }
__device__ __forceinline__ float bflo(unsigned w) { return __uint_as_float(w << 16); }
__device__ __forceinline__ float bfhi(unsigned w) { return __uint_as_float(w & 0xffff0000u); }
typedef __bf16 bf16v2_t __attribute__((ext_vector_type(2)));
typedef float f32v2_t __attribute__((ext_vector_type(2)));
__device__ __forceinline__ unsigned pk2(float lo, float hi) { const bf16v2_t r = __builtin_convertvector((f32v2_t){lo, hi}, bf16v2_t); return __builtin_bit_cast(unsigned, r); }
__device__ __forceinline__ float wave_sum(float v) {
#pragma unroll
    for (int o = 1; o < 64; o <<= 1) v += __shfl_xor(v, o);
    return v;
}
__device__ __forceinline__ float wave_max(float v) {
#pragma unroll
    for (int o = 1; o < 64; o <<= 1) v = fmaxf(v, __shfl_xor(v, o));
    return v;
}
__device__ __forceinline__ float sigm(float x) { return 1.0f / (1.0f + __expf(-x)); }
__device__ __forceinline__ float logsigm(float x) { return fminf(x, 0.f) - log1pf(__expf(-fabsf(x))); }

#define XB_TMO      128
#define XB_XCNT(j)  (256  + 64 * (j))
#define XB_XSUB(j)  (1280 + 64 * (j))
#define XB_XGEN(j)  (2304 + 64 * (j))
#define XB_TOP      3328
#define XB_TOPGEN   3392
#define XCD_BAR_WORDS 3456
#define XB_SPIN_CAP (1u << 18)
__device__ __forceinline__ unsigned xb_ld(unsigned* p)              { return __hip_atomic_load(p, __ATOMIC_RELAXED, __HIP_MEMORY_SCOPE_AGENT); }
__device__ __forceinline__ unsigned xb_add(unsigned* p, unsigned v) { return __hip_atomic_fetch_add(p, v, __ATOMIC_RELAXED, __HIP_MEMORY_SCOPE_AGENT); }
__device__ __forceinline__ unsigned xb_xcc_id() { return (unsigned)__builtin_amdgcn_s_getreg((3 << 11) | 20) & 0xFu; }
#define XB_SPIN(cond, bar) do { unsigned _sp = 0; while (cond) { __builtin_amdgcn_s_sleep(1); \
    if ((++_sp & 255u) == 0u) { if (xb_ld(&(bar)[XB_TMO])) break; if (_sp > XB_SPIN_CAP) { atomicAdd(&(bar)[XB_TMO], 1u); break; } } } } while (0)
struct XcdBarrier { unsigned* bar; unsigned x; volatile LAS unsigned* st; };
__device__ __forceinline__ XcdBarrier xcd_barrier_post(unsigned* bar, volatile LAS unsigned* st) {
    XcdBarrier b; b.bar = bar; b.x = xb_xcc_id(); b.st = st;
    if (threadIdx.x == 0) (void)xb_add(&bar[XB_XCNT(b.x)], 1u);
    return b;
}
__device__ __forceinline__ void xcd_barrier_complete(unsigned* bar, unsigned x, unsigned& nloc, unsigned& nx) {
    const unsigned G = gridDim.x * gridDim.y * gridDim.z;
    unsigned sum, cnt, mine, sp = 0u;
    for (;;) {
        sum = 0u; cnt = 0u; mine = 0u;
#pragma unroll
        for (unsigned j = 0; j < 16; ++j) { const unsigned c = xb_ld(&bar[XB_XCNT(j)]); sum += c; cnt += (c > 0u) ? 1u : 0u; mine = (j == x) ? c : mine; }
        if (sum == G) break;
        __builtin_amdgcn_s_sleep(1);
        if ((++sp & 255u) == 0u) { if (xb_ld(&bar[XB_TMO])) break; if (sp > XB_SPIN_CAP) { atomicAdd(&bar[XB_TMO], 1u); break; } }
    }
    nloc = mine > 0u ? mine : 1u; nx = cnt > 0u ? cnt : 1u;
}
__device__ __forceinline__ void xcd_barrier(const XcdBarrier& b) {
    asm volatile("s_waitcnt vmcnt(0)" ::: "memory");
    __syncthreads();
    if (threadIdx.x == 0) {
        unsigned* bar = b.bar;
        __builtin_amdgcn_s_waitcnt(0);
        unsigned nloc = b.st[0], nx = b.st[1];
        if (nloc == 0u) { xcd_barrier_complete(bar, b.x, nloc, nx); b.st[0] = nloc; b.st[1] = nx; }
        const unsigned old = xb_add(&bar[XB_XSUB(b.x)], 1u);
        const unsigned gen = old / nloc;
        if (old + 1u == (gen + 1u) * nloc) {
            __builtin_amdgcn_fence(__ATOMIC_RELEASE, "agent");
            asm volatile("s_waitcnt vmcnt(0)" ::: "memory");
            const unsigned og = xb_add(&bar[XB_TOP], 1u);
            const unsigned tg = og / nx;
            if (og + 1u == (tg + 1u) * nx) xb_add(&bar[XB_TOPGEN], 1u);
            else XB_SPIN(xb_ld(&bar[XB_TOPGEN]) == tg, bar);
            __builtin_amdgcn_fence(__ATOMIC_ACQUIRE, "agent");
            xb_add(&bar[XB_XGEN(b.x)], 1u);
            asm volatile("s_waitcnt vmcnt(0)" ::: "memory");
        } else {
            XB_SPIN(xb_ld(&bar[XB_XGEN(b.x)]) == gen, bar);
            __builtin_amdgcn_fence(__ATOMIC_ACQUIRE, "agent");
            asm volatile("s_waitcnt vmcnt(0)" ::: "memory");
        }
    }
    __syncthreads();
}

struct Args { const float* in[19]; float* out; unsigned char* ws; int ph_lo, ph_hi; };
struct Frame {
    LAS unsigned char* lds;
    int tid, lane, wave, G, bid;
    const float *x, *p, *w_in, *b_gates, *w_conv, *g_mlstm, *w_pool, *pool_scale, *w_out, *g_mix_pre, *g_mix_post, *w_ff1, *w_ff2, *g_ff_pre, *g_ff_post, *w_ple_proj, *w_ple_gate, *g_ple_gate, *g_ple_post;
    float* out; unsigned char* ws; unsigned char* ob;
};
#define MK_FRAME(F) Frame F; { int t_ = threadIdx.x; asm volatile("" : "+v"(t_)); F.lds = (LAS unsigned char*)lds_raw; F.tid = t_; F.lane = t_ & 63; F.wave = __builtin_amdgcn_readfirstlane(t_ >> 6); F.G = gridDim.x; F.bid = blockIdx.x; \
    F.out = args.out; F.ws = args.ws; F.ob = (unsigned char*)args.out; }

__device__ __forceinline__ void transpose_item(const float* W, int ldw, int ns0, bf16* WT, int ldt, int nd0, int kb, int nb, int lane) {
    const float* src = W + (size_t)(64 * kb) * ldw + ns0 + 64 * nb + lane;
    bf16* dst = WT + (size_t)(nd0 + 64 * nb + lane) * ldt + 64 * kb;
#pragma unroll
    for (int h = 0; h < 2; ++h) {
        float v[32];
#pragma unroll
        for (int i = 0; i < 32; ++i) v[i] = src[(size_t)(32 * h + i) * ldw];
#pragma unroll
        for (int j = 0; j < 4; ++j) { u32x4 o; o.x = pk2(v[8 * j], v[8 * j + 1]); o.y = pk2(v[8 * j + 2], v[8 * j + 3]); o.z = pk2(v[8 * j + 4], v[8 * j + 5]); o.w = pk2(v[8 * j + 6], v[8 * j + 7]);
            *(u32x4*)(dst + 32 * h + 8 * j) = o; }
    }
}

__device__ __forceinline__ void p0_prologue(Frame& F) {
    const int gw = F.bid * 8 + F.wave, NGW = F.G * 8;
    unsigned char* ws = F.ws;
    {
        constexpr int I0 = 32 * 64, I1 = 32 * 16, I2 = 32 * 32, I3 = 32 * 128, I4 = 128 * 32, I5 = 32 * 32, I6 = 4 * 32, I7 = 4 * 16;
        constexpr int NIT = I0 + I1 + I2 + I3 + I4 + I5 + I6 + I7;
        for (int rep_ = 0; rep_ < REP_P0A; ++rep_)
        for (int it = gw; it < NIT; it += NGW) {
            int r = it;
            if (r < I0) { transpose_item(F.w_in, INC, 0, (bf16*)(ws + WS_WIN), DM, 0, r / 64, r % 64, F.lane); continue; } r -= I0;
            if (r < I1) { transpose_item(F.w_in, INC, C_U, (bf16*)(ws + WS_WIN), DM, 4096, r / 16, r % 16, F.lane); continue; } r -= I1;
            if (r < I2) { transpose_item(F.w_out, DM, 0, (bf16*)(ws + WS_WOUT), DM, 0, r / 32, r % 32, F.lane); continue; } r -= I2;
            if (r < I3) { transpose_item(F.w_ff1, DFF, 0, (bf16*)(ws + WS_WFF1), DM, 0, r / 128, r % 128, F.lane); continue; } r -= I3;
            if (r < I4) { transpose_item(F.w_ff2, DM, 0, (bf16*)(ws + WS_WFF2), DFF, 0, r / 32, r % 32, F.lane); continue; } r -= I4;
            if (r < I5) { transpose_item(F.w_ple_gate, DM, 0, (bf16*)(ws + WS_WPG), DM, 0, r / 32, r % 32, F.lane); continue; } r -= I5;
            if (r < I6) { transpose_item(F.w_ple_proj, DM, 0, (bf16*)(ws + WS_WPP), PD, 0, r / 32, r % 32, F.lane); continue; } r -= I6;
            { const int g = r / 16, rr = r % 16; transpose_item(F.w_pool + (size_t)g * 256 * 256, 256, 0, (bf16*)(ws + WS_WPOOL), 256, g * 256, rr / 4, rr % 4, F.lane); }
        }
    }
    {
        const int gt = F.bid * 512 + F.tid, NGT = F.G * 512;
        for (int i = gt; i < M * PD / 8; i += NGT) { const f32x4 a = *(const f32x4*)(F.p + (size_t)i * 8), b = *(const f32x4*)(F.p + (size_t)i * 8 + 4);
            u32x4 o; o.x = pk2(a[0], a[1]); o.y = pk2(a[2], a[3]); o.z = pk2(b[0], b[1]); o.w = pk2(b[2], b[3]); *(u32x4*)(ws + WS_PB + (size_t)i * 16) = o; }
    }
    __syncthreads();
    {
        LAS f32x4* wg = (LAS f32x4*)F.lds;
        for (int idx = F.tid; idx < 8192; idx += 512) { const int ln = idx & 63, c4 = (idx >> 6) & 3, i = (idx >> 8) & 3, jj = idx >> 10; const int k = 256 * jj + 4 * ln + i;
            wg[idx] = *(const f32x4*)(F.w_in + (size_t)k * INC + C_GATE + 4 * c4); }
    }
    __syncthreads();
    {
        const LAS f32x4* wg = (const LAS f32x4*)F.lds;
        const int lane = F.lane;
        for (int rep_ = 0; rep_ < REP_P0D; ++rep_)
        for (int m = gw; m < M; m += NGW) {
            const float* xr = F.x + (size_t)m * DM;
            f32x4 v[8]; float s = 0.f;
#pragma unroll
            for (int jj = 0; jj < 8; ++jj) { v[jj] = *(const f32x4*)(xr + 256 * jj + 4 * lane); s += (v[jj][0] * v[jj][0] + v[jj][1] * v[jj][1]) + (v[jj][2] * v[jj][2] + v[jj][3] * v[jj][3]); }
            const float rs = rsqrtf(wave_sum(s) * (1.0f / DM) + EPS);
            f32x4 ga[4];
#pragma unroll
            for (int c4 = 0; c4 < 4; ++c4) ga[c4] = (f32x4){0.f, 0.f, 0.f, 0.f};
#pragma unroll
            for (int jj = 0; jj < 8; ++jj) { const f32x4 g = *(const f32x4*)(F.g_mix_pre + 256 * jj + 4 * lane); v[jj] = v[jj] * rs * g;
                u32x2 o; o.x = pk2(v[jj][0], v[jj][1]); o.y = pk2(v[jj][2], v[jj][3]); *(u32x2*)(ws + WS_A0 + ((size_t)m * DM + 256 * jj + 4 * lane) * 2) = o;
#pragma unroll
                for (int i = 0; i < 4; ++i)
#pragma unroll
                    for (int c4 = 0; c4 < 4; ++c4) ga[c4] += wg[((jj * 4 + i) * 4 + c4) * 64 + lane] * v[jj][i];
                asm volatile("" ::: "memory"); }
            float res = 0.f;
#pragma unroll
            for (int c4 = 0; c4 < 4; ++c4)
#pragma unroll
                for (int j = 0; j < 4; ++j) { const float t = wave_sum(ga[c4][j]); if (lane == c4 * 4 + j) res = t; }
            if (lane < 16) ((float*)(ws + WS_GATES))[(size_t)m * 16 + lane] = res + F.b_gates[lane];
        }
    }
}

constexpr int PA_KT = 0, PA_VW = 18432, PA_VT = 36864, PA_W = 53248;
__device__ __forceinline__ int vt_pos(int j) { return (j & 32) | (((j >> 2) & 3) << 3) | (((j >> 4) & 1) << 2) | (j & 3); }
__device__ __forceinline__ void p2_item(Frame& F, int item) {
    unsigned char* ws = F.ws;
    const int tid = F.tid, lane = F.lane, wave = F.wave;
    const int c = item & 31, bh = item >> 5, h = bh & 7, b = bh >> 3;
    const int m0 = b * SEQ + c * CH;
    LAS unsigned char* lds = F.lds;
    LAS float* wl = (LAS float*)(lds + PA_W);
    const float* gates = (const float*)(ws + WS_GATES);
    if (wave == 0) {
        const float li = gates[(size_t)(m0 + lane) * 16 + h], lf = logsigm(gates[(size_t)(m0 + lane) * 16 + 8 + h]);
        float bs = lf;
#pragma unroll
        for (int o = 1; o < 64; o <<= 1) { const float t = __shfl_up(bs, o); if (lane >= o) bs += t; }
        const float btot = __shfl(bs, 63);
        const float a = btot - bs + li, amax = wave_max(a);
        wl[lane] = __expf(a - amax);
        if (lane == 0) { ((float*)(ws + WS_SCAL))[item] = amax; ((float*)(ws + WS_SCAL))[NITEM + item] = btot; }
    }
    const int cg8 = tid & 15, rp = tid >> 4, l0 = 2 * rp, col = h * DH + cg8 * 8;
    u32x4 qr[5], kr[5], vr[2];
#pragma unroll
    for (int i = 0; i < 5; ++i) { const int r = l0 - 3 + i; const bool ok = (c > 0) || (r >= 0);
        const size_t off = ((size_t)(m0 + r) * MW + col) * 2;
        qr[i] = ok ? *(const u32x4*)(ws + WS_Q + off) : (u32x4){0u, 0u, 0u, 0u};
        kr[i] = ok ? *(const u32x4*)(ws + WS_K + off) : (u32x4){0u, 0u, 0u, 0u}; }
#pragma unroll
    for (int i = 0; i < 2; ++i) vr[i] = *(const u32x4*)(ws + WS_V + ((size_t)(m0 + l0 + i) * MW + col) * 2);
    float wq[4][8], wk[4][8];
#pragma unroll
    for (int kk = 0; kk < 4; ++kk) { const f32x4 a = *(const f32x4*)(F.w_conv + kk * 2048 + col), b2 = *(const f32x4*)(F.w_conv + kk * 2048 + col + 4);
        const f32x4 c2 = *(const f32x4*)(F.w_conv + kk * 2048 + 1024 + col), d2 = *(const f32x4*)(F.w_conv + kk * 2048 + 1024 + col + 4);
#pragma unroll
        for (int j = 0; j < 4; ++j) { wq[kk][j] = a[j]; wq[kk][4 + j] = b2[j]; wk[kk][j] = c2[j]; wk[kk][4 + j] = d2[j]; } }
    float qy[2][8], ky[2][8];
#pragma unroll
    for (int rr = 0; rr < 2; ++rr)
#pragma unroll
        for (int j = 0; j < 8; ++j) { float aq = 0.f, ak = 0.f;
#pragma unroll
            for (int kk = 0; kk < 4; ++kk) { const unsigned wqv = qr[rr + kk][j >> 1], wkv = kr[rr + kk][j >> 1];
                const float xq = (j & 1) ? bfhi(wqv) : bflo(wqv), xk = (j & 1) ? bfhi(wkv) : bflo(wkv);
                aq += wq[kk][j] * xq; ak += wk[kk][j] * xk; }
            qy[rr][j] = aq * sigm(aq); ky[rr][j] = ak * sigm(ak) * 0.08838834764831845f; }
#pragma unroll
    for (int rr = 0; rr < 2; ++rr) { const size_t off = ((size_t)(m0 + l0 + rr) * MW + col) * 2;
        u32x4 o; o.x = pk2(qy[rr][0], qy[rr][1]); o.y = pk2(qy[rr][2], qy[rr][3]); o.z = pk2(qy[rr][4], qy[rr][5]); o.w = pk2(qy[rr][6], qy[rr][7]); *(u32x4*)(ws + WS_QC + off) = o;
        u32x4 k2; k2.x = pk2(ky[rr][0], ky[rr][1]); k2.y = pk2(ky[rr][2], ky[rr][3]); k2.z = pk2(ky[rr][4], ky[rr][5]); k2.w = pk2(ky[rr][6], ky[rr][7]); *(u32x4*)(ws + WS_KC + off) = k2; }
    __syncthreads();
    {
        const float w0 = wl[l0], w1 = wl[l0 + 1];
        const int pv = vt_pos(l0);
#pragma unroll
        for (int j = 0; j < 8; ++j) { const int e = cg8 * 8 + j;
            const float v0 = (j & 1) ? bfhi(vr[0][j >> 1]) : bflo(vr[0][j >> 1]), v1 = (j & 1) ? bfhi(vr[1][j >> 1]) : bflo(vr[1][j >> 1]);
            *(LAS unsigned*)(lds + PA_KT + e * 144 + l0 * 2) = pk2(ky[0][j], ky[1][j]);
            *(LAS unsigned*)(lds + PA_VW + e * 144 + l0 * 2) = pk2(v0 * w0, v1 * w1);
            *(LAS unsigned*)(lds + PA_VT + e * 128 + pv * 2) = pk2(v0, v1); }
    }
    __syncthreads();
    {
        const int fr = lane & 15, fq = lane >> 4;
        f32x4 acc[8];
#pragma unroll
        for (int et = 0; et < 8; ++et) acc[et] = (f32x4){0.f, 0.f, 0.f, 0.f};
#pragma unroll
        for (int ks = 0; ks < 2; ++ks) { const bf16x8 bfr = *(const LAS bf16x8*)(lds + PA_VW + (16 * wave + fr) * 144 + (32 * ks + 8 * fq) * 2);
#pragma unroll
            for (int et = 0; et < 8; ++et) { const bf16x8 afr = *(const LAS bf16x8*)(lds + PA_KT + (16 * et + fr) * 144 + (32 * ks + 8 * fq) * 2);
                acc[et] = __builtin_amdgcn_mfma_f32_16x16x32_bf16(afr, bfr, acc[et], 0, 0, 0); } }
        const int d = 16 * wave + fr;
#pragma unroll
        for (int et = 0; et < 8; ++et) { u32x2 o; o.x = pk2(acc[et][0], acc[et][1]); o.y = pk2(acc[et][2], acc[et][3]);
            *(u32x2*)(ws + WS_A0 + (((size_t)item * 128 + d) * 128 + 16 * et + 4 * fq) * 2) = o; }
    }
    if (tid < 128) { float s = 0.f;
#pragma unroll 8
        for (int l = 0; l < 64; ++l) s += wl[l] * bf2f(*(const LAS unsigned short*)(lds + PA_KT + tid * 144 + l * 2));
        ((float*)(ws + WS_NLOC))[(size_t)item * 128 + tid] = s; }
#pragma unroll
    for (int i = 0; i < 2; ++i) { const int idx = tid + 512 * i, row = idx >> 3, chk = idx & 7;
        *(u32x4*)(F.ob + DO_VT + ((size_t)item * 128 + row) * 128 + chk * 16) = *(const LAS u32x4*)(lds + PA_VT + row * 128 + chk * 16); }
    __syncthreads();
}
template <int W> __device__ __forceinline__ void pooled_item(const unsigned char* U, unsigned char* P, int m4, int c8) {
    const int t0 = m4 & (SEQ - 1);
    u32x4 rows[W + 3];
#pragma unroll
    for (int i = 0; i < W + 3; ++i) { const int dt = i - (W - 1);
        rows[i] = (t0 + dt >= 0) ? *(const u32x4*)(U + ((size_t)(m4 + dt) * PW + c8 * 8) * 2) : (u32x4){0u, 0u, 0u, 0u}; }
#pragma unroll
    for (int r = 0; r < 4; ++r) { float s[8];
#pragma unroll
        for (int j = 0; j < 8; ++j) s[j] = 0.f;
#pragma unroll
        for (int i = 0; i < W; ++i) { const u32x4 v = rows[r + i];
#pragma unroll
            for (int j = 0; j < 4; ++j) { s[2 * j] += bflo(v[j]); s[2 * j + 1] += bfhi(v[j]); } }
        const int n = (t0 + r + 1 < W) ? (t0 + r + 1) : W; const float inv = 1.0f / (float)n;
        const u32x4 cur = rows[r + W - 1]; u32x4 o;
#pragma unroll
        for (int j = 0; j < 4; ++j) o[j] = pk2(s[2 * j] * inv - bflo(cur[j]), s[2 * j + 1] * inv - bfhi(cur[j]));
        *(u32x4*)(P + ((size_t)(m4 + r) * PW + c8 * 8) * 2) = o; }
}
__device__ __forceinline__ void p2_pooled(Frame& F) {
    const int gt = F.bid * 512 + F.tid, NGT = F.G * 512;
    const unsigned char* U = F.ws + WS_U; unsigned char* P = F.ob + DO_POOLED;
    for (int i = gt; i < (M / 4) * 128; i += NGT) { const int m4 = (i >> 7) * 4, c8 = i & 127, g = c8 >> 5;
        if (g == 0) pooled_item<2>(U, P, m4, c8); else if (g == 1) pooled_item<4>(U, P, m4, c8); else if (g == 2) pooled_item<8>(U, P, m4, c8); else pooled_item<16>(U, P, m4, c8); }
}

__device__ __forceinline__ void p3_scan(Frame& F) {
    unsigned char* ws = F.ws;
    const int gt = F.bid * 512 + F.tid;
    const float* amaxp = (const float*)(ws + WS_SCAL); const float* btotp = amaxp + NITEM; float* mprev = (float*)(ws + WS_SCAL) + 2 * NITEM;
    for (int id = gt; id < 64 * 128 * 16; id += F.G * 512) {
        const int bh = id >> 11, d = (id >> 4) & 127, e8 = id & 15;
        float acc[8], nacc[8];
#pragma unroll
        for (int j = 0; j < 8; ++j) { acc[j] = 0.f; nacc[j] = 0.f; }
        float m = 0.f;
        const bool do_n = (d == 0);
#pragma unroll 4
        for (int c = 0; c < NCH; ++c) { const int item = bh * 32 + c;
            const u32x4 cl = *(const u32x4*)(ws + WS_A0 + (((size_t)item * 128 + d) * 128 + e8 * 8) * 2);
            u32x4 o; o.x = pk2(acc[0], acc[1]); o.y = pk2(acc[2], acc[3]); o.z = pk2(acc[4], acc[5]); o.w = pk2(acc[6], acc[7]);
            *(u32x4*)(ws + WS_CPREV + (((size_t)item * 128 + d) * 128 + e8 * 8) * 2) = o;
            const float amax = amaxp[item], btot = btotp[item];
            const float mn = fmaxf(btot + m, amax), dec = __expf(btot + m - mn), sc = __expf(amax - mn);
            if (do_n) { float* np = (float*)(ws + WS_NPREV) + (size_t)item * 128 + e8 * 8; const float* nl = (const float*)(ws + WS_NLOC) + (size_t)item * 128 + e8 * 8;
                *(f32x4*)np = (f32x4){nacc[0], nacc[1], nacc[2], nacc[3]}; *(f32x4*)(np + 4) = (f32x4){nacc[4], nacc[5], nacc[6], nacc[7]};
                const f32x4 a = *(const f32x4*)nl, b2 = *(const f32x4*)(nl + 4);
#pragma unroll
                for (int j = 0; j < 4; ++j) { nacc[j] = dec * nacc[j] + sc * a[j]; nacc[4 + j] = dec * nacc[4 + j] + sc * b2[j]; }
                if (e8 == 0) mprev[item] = m; }
#pragma unroll
            for (int j = 0; j < 4; ++j) { acc[2 * j] = dec * acc[2 * j] + sc * bflo(cl[j]); acc[2 * j + 1] = dec * acc[2 * j + 1] + sc * bfhi(cl[j]); }
            m = mn; }
    }
}

__device__ __forceinline__ void p4_issue(const unsigned char* ws, const unsigned char* ob, int it0, int tid, u32x4 (&st)[16]) {
#pragma unroll
    for (int i = 0; i < 16; ++i) { const int item = it0 + (i >> 3), cid = (tid + 512 * i) & 4095;
        const int c = item & 31, bh = item >> 5, h = bh & 7, b = bh >> 3; const int m0 = b * SEQ + c * CH;
        const unsigned char* src;
        if ((i & 7) < 2) { const int r = cid >> 4, c16 = cid & 15; src = ws + WS_KC + ((size_t)(m0 + r) * MW + h * DH) * 2 + c16 * 16; }
        else if ((i & 7) < 6) { const int r = (cid - 1024) >> 4, c16 = cid & 15; src = ws + WS_CPREV + ((size_t)item * 128 + r) * 256 + c16 * 16; }
        else { const int r = (cid - 3072) >> 3, c8 = cid & 7; src = ob + DO_VT + ((size_t)item * 128 + r) * 128 + c8 * 16; }
        st[i] = *(const u32x4*)src; }
}
__device__ __forceinline__ void p4_write(LAS unsigned char* lds, int tid, const u32x4 (&st)[16]) {
#pragma unroll
    for (int i = 0; i < 16; ++i) { const int cid = (tid + 512 * i) & 4095; LAS unsigned char* base = lds + (i >> 3) * 65536; int off;
        if ((i & 7) < 2) { const int r = cid >> 4, c16 = cid & 15; off = r * 256 + ((c16 ^ (r & 15)) << 4); }
        else if ((i & 7) < 6) { const int r = (cid - 1024) >> 4, c16 = cid & 15; off = 16384 + r * 256 + ((c16 ^ (r & 15)) << 4); }
        else { const int r = (cid - 3072) >> 3, c8 = cid & 7; off = 49152 + r * 128 + ((c8 ^ ((r >> 1) & 7)) << 4); }
        *(LAS u32x4*)(base + off) = st[i]; }
}
__device__ __forceinline__ void p4_compute(Frame& F, int item, int rb, const LAS unsigned char* L) {
    unsigned char* ws = F.ws;
    const int lane = F.lane, fr = lane & 15, fq = lane >> 4;
    const int c = item & 31, bh = item >> 5, h = bh & 7, b = bh >> 3;
    const int m0 = b * SEQ + c * CH;
    const float* gates = (const float*)(ws + WS_GATES);
    const float li = gates[(size_t)(m0 + lane) * 16 + h], lf = logsigm(gates[(size_t)(m0 + lane) * 16 + 8 + h]);
    float bs = lf;
#pragma unroll
    for (int o = 1; o < 64; o <<= 1) { const float t = __shfl_up(bs, o); if (lane >= o) bs += t; }
    const float gg = li - bs;
    float pmx = gg;
#pragma unroll
    for (int o = 1; o < 64; o <<= 1) { const float t = __shfl_up(pmx, o); if (lane >= o) pmx = fmaxf(pmx, t); }
    const float m_prev = ((const float*)(ws + WS_SCAL))[2 * NITEM + item];
    const float pm = fmaxf(m_prev, pmx);
    const int l = 16 * rb + fr;
    const float b_l = __shfl(bs, l), pm_l = __shfl(pm, l);
    const float inter_w = __expf(m_prev - pm_l);
    bf16x8 qf[4];
#pragma unroll
    for (int ks = 0; ks < 4; ++ks) qf[ks] = *(const bf16x8*)(ws + WS_QC + ((size_t)(m0 + l) * MW + h * DH + 32 * ks + 8 * fq) * 2);
    f32x4 T[4];
#pragma unroll
    for (int jt = 0; jt < 4; ++jt) { T[jt] = (f32x4){0.f, 0.f, 0.f, 0.f};
        if (jt <= rb) {
#pragma unroll
            for (int ks = 0; ks < 4; ++ks) { const int r = 16 * jt + fr; const bf16x8 kf = *(const LAS bf16x8*)(L + r * 256 + (((4 * ks + fq) ^ (r & 15)) << 4));
                T[jt] = __builtin_amdgcn_mfma_f32_16x16x32_bf16(kf, qf[ks], T[jt], 0, 0, 0); } } }
    float rowsum = 0.f;
#pragma unroll
    for (int jt = 0; jt < 4; ++jt)
#pragma unroll
        for (int r = 0; r < 4; ++r) { const int j = 16 * jt + 4 * fq + r; const float gj = __shfl(gg, j);
            const float wgt = (j <= l) ? __expf(gj - pm_l) : 0.f; const float sv = T[jt][r] * wgt; T[jt][r] = sv; rowsum += sv; }
    bf16x8 pf[2];
#pragma unroll
    for (int s2 = 0; s2 < 2; ++s2) { u32x4 w; w.x = pk2(T[2 * s2][0], T[2 * s2][1]); w.y = pk2(T[2 * s2][2], T[2 * s2][3]); w.z = pk2(T[2 * s2 + 1][0], T[2 * s2 + 1][1]); w.w = pk2(T[2 * s2 + 1][2], T[2 * s2 + 1][3]);
        pf[s2] = __builtin_bit_cast(bf16x8, w); }
    float nq = 0.f;
#pragma unroll
    for (int ks = 0; ks < 4; ++ks) { const float* np = (const float*)(ws + WS_NPREV) + (size_t)item * 128 + 32 * ks + 8 * fq; const f32x4 a = *(const f32x4*)np, b2 = *(const f32x4*)(np + 4);
        const u32x4 qw = __builtin_bit_cast(u32x4, qf[ks]);
        nq += a[0] * bflo(qw[0]) + a[1] * bfhi(qw[0]) + a[2] * bflo(qw[1]) + a[3] * bfhi(qw[1]) + b2[0] * bflo(qw[2]) + b2[1] * bfhi(qw[2]) + b2[2] * bflo(qw[3]) + b2[3] * bfhi(qw[3]); }
    nq += __shfl_xor(nq, 16); nq += __shfl_xor(nq, 32);
    rowsum += __shfl_xor(rowsum, 16); rowsum += __shfl_xor(rowsum, 32);
    const float den = inter_w * nq + rowsum;
    const float inv = 1.0f / fmaxf(fabsf(den), __expf(-(b_l + pm_l)));
    f32x4 acc[8]; float ss = 0.f;
#pragma unroll
    for (int dt = 0; dt < 8; ++dt) { acc[dt] = (f32x4){0.f, 0.f, 0.f, 0.f}; const int r = 16 * dt + fr;
#pragma unroll
        for (int ks = 0; ks < 4; ++ks) { const bf16x8 cf = *(const LAS bf16x8*)(L + 16384 + r * 256 + (((4 * ks + fq) ^ (r & 15)) << 4));
            acc[dt] = __builtin_amdgcn_mfma_f32_16x16x32_bf16(cf, qf[ks], acc[dt], 0, 0, 0); }
        acc[dt] = acc[dt] * inter_w;
#pragma unroll
        for (int s2 = 0; s2 < 2; ++s2) { if (s2 == 0 || rb >= 2) { const bf16x8 vf = *(const LAS bf16x8*)(L + 49152 + r * 128 + (((4 * s2 + fq) ^ ((r >> 1) & 7)) << 4));
                acc[dt] = __builtin_amdgcn_mfma_f32_16x16x32_bf16(vf, pf[s2], acc[dt], 0, 0, 0); } }
        acc[dt] = acc[dt] * inv;
        ss += (acc[dt][0] * acc[dt][0] + acc[dt][1] * acc[dt][1]) + (acc[dt][2] * acc[dt][2] + acc[dt][3] * acc[dt][3]); }
    ss += __shfl_xor(ss, 16); ss += __shfl_xor(ss, 32);
    const float rn = rsqrtf(ss * (1.0f / DH) + EPS);
#pragma unroll
    for (int dt = 0; dt < 8; ++dt) { const int d0 = 16 * dt + 4 * fq;
        const u32x2 ow = *(const u32x2*)(ws + WS_O + ((size_t)(m0 + l) * MW + h * DH + d0) * 2);
        const f32x4 gm = *(const f32x4*)(F.g_mlstm + h * DH + d0);
        const float o0 = sigm(bflo(ow.x)) * acc[dt][0] * rn * gm[0], o1 = sigm(bfhi(ow.x)) * acc[dt][1] * rn * gm[1];
        const float o2 = sigm(bflo(ow.y)) * acc[dt][2] * rn * gm[2], o3 = sigm(bfhi(ow.y)) * acc[dt][3] * rn * gm[3];
        u32x2 o; o.x = pk2(o0, o1); o.y = pk2(o2, o3);
        *(u32x2*)(F.ob + DO_MIX + ((size_t)(m0 + l) * DM + h * DH + d0) * 2) = o; }
}
__device__ __forceinline__ void p4_phase(Frame& F) {
    const int npair = NITEM / 2;
    u32x4 st[16];
    int pr = F.bid * 4;
    for (int blk = F.bid; blk * 4 < npair; blk += F.G) {
        pr = blk * 4;
        p4_issue(F.ws, F.ob, 2 * pr, F.tid, st);
        for (int k = 0; k < 4; ++k) {
            __syncthreads();
            p4_write(F.lds, F.tid, st);
            if (k < 3) p4_issue(F.ws, F.ob, 2 * (pr + k + 1), F.tid, st);
            __syncthreads();
            p4_compute(F, 2 * (pr + k) + (F.wave >> 2), F.wave & 3, F.lds + (F.wave >> 2) * 65536);
        }
    }
    __syncthreads();
}

template <bool BASE_BF16>
__device__ __forceinline__ void row_resnorm(Frame& F, const void* base, const unsigned char* y, const float* g1, const float* g2, unsigned char* hout, unsigned char* nout) {
    const int gw = F.bid * 8 + F.wave, NGW = F.G * 8, lane = F.lane;
    for (int m = gw; m < M; m += NGW) {
        float v[32]; float s = 0.f;
#pragma unroll
        for (int j = 0; j < 4; ++j) { const u32x4 w = *(const u32x4*)(y + ((size_t)m * DM + 512 * j + 8 * lane) * 2);
#pragma unroll
            for (int q = 0; q < 4; ++q) { v[8 * j + 2 * q] = bflo(w[q]); v[8 * j + 2 * q + 1] = bfhi(w[q]); } }
#pragma unroll
        for (int i = 0; i < 32; ++i) s += v[i] * v[i];
        const float r1 = rsqrtf(wave_sum(s) * (1.0f / DM) + EPS);
        float s2 = 0.f;
#pragma unroll
        for (int j = 0; j < 4; ++j) { const size_t co = 512 * j + 8 * lane;
            float bv[8];
            if (BASE_BF16) { const u32x4 w = *(const u32x4*)((const unsigned char*)base + ((size_t)m * DM + co) * 2);
#pragma unroll
                for (int q = 0; q < 4; ++q) { bv[2 * q] = bflo(w[q]); bv[2 * q + 1] = bfhi(w[q]); } }
            else { const f32x4 b0 = *(const f32x4*)((const float*)base + (size_t)m * DM + co), b1 = *(const f32x4*)((const float*)base + (size_t)m * DM + co + 4);
#pragma unroll
                for (int q = 0; q < 4; ++q) { bv[q] = b0[q]; bv[4 + q] = b1[q]; } }
            const f32x4 ga = *(const f32x4*)(g1 + co), gb = *(const f32x4*)(g1 + co + 4);
#pragma unroll
            for (int q = 0; q < 4; ++q) { v[8 * j + q] = bv[q] + v[8 * j + q] * r1 * ga[q]; v[8 * j + 4 + q] = bv[4 + q] + v[8 * j + 4 + q] * r1 * gb[q]; }
            u32x4 o; o.x = pk2(v[8 * j], v[8 * j + 1]); o.y = pk2(v[8 * j + 2], v[8 * j + 3]); o.z = pk2(v[8 * j + 4], v[8 * j + 5]); o.w = pk2(v[8 * j + 6], v[8 * j + 7]);
            *(u32x4*)(hout + ((size_t)m * DM + co) * 2) = o; }
#pragma unroll
        for (int i = 0; i < 32; ++i) s2 += v[i] * v[i];
        const float r2 = rsqrtf(wave_sum(s2) * (1.0f / DM) + EPS);
#pragma unroll
        for (int j = 0; j < 4; ++j) { const size_t co = 512 * j + 8 * lane;
            const f32x4 ga = *(const f32x4*)(g2 + co), gb = *(const f32x4*)(g2 + co + 4);
            u32x4 o; o.x = pk2(v[8 * j] * r2 * ga[0], v[8 * j + 1] * r2 * ga[1]); o.y = pk2(v[8 * j + 2] * r2 * ga[2], v[8 * j + 3] * r2 * ga[3]);
            o.z = pk2(v[8 * j + 4] * r2 * gb[0], v[8 * j + 5] * r2 * gb[1]); o.w = pk2(v[8 * j + 6] * r2 * gb[2], v[8 * j + 7] * r2 * gb[3]);
            *(u32x4*)(nout + ((size_t)m * DM + co) * 2) = o; }
    }
}
__device__ __forceinline__ void row_final(Frame& F, const unsigned char* base, const unsigned char* y, const float* g, float* out) {
    const int gw = F.bid * 8 + F.wave, NGW = F.G * 8, lane = F.lane;
    for (int m = gw; m < M; m += NGW) {
        float v[32]; float s = 0.f;
#pragma unroll
        for (int j = 0; j < 4; ++j) { const u32x4 w = *(const u32x4*)(y + ((size_t)m * DM + 512 * j + 8 * lane) * 2);
#pragma unroll
            for (int q = 0; q < 4; ++q) { v[8 * j + 2 * q] = bflo(w[q]); v[8 * j + 2 * q + 1] = bfhi(w[q]); } }
#pragma unroll
        for (int i = 0; i < 32; ++i) s += v[i] * v[i];
        const float r1 = rsqrtf(wave_sum(s) * (1.0f / DM) + EPS);
#pragma unroll
        for (int j = 0; j < 4; ++j) { const size_t co = 512 * j + 8 * lane;
            const u32x4 w = *(const u32x4*)(base + ((size_t)m * DM + co) * 2);
            const f32x4 ga = *(const f32x4*)(g + co), gb = *(const f32x4*)(g + co + 4);
            f32x4 o0, o1;
            o0[0] = bflo(w[0]) + v[8 * j + 0] * r1 * ga[0]; o0[1] = bfhi(w[0]) + v[8 * j + 1] * r1 * ga[1]; o0[2] = bflo(w[1]) + v[8 * j + 2] * r1 * ga[2]; o0[3] = bfhi(w[1]) + v[8 * j + 3] * r1 * ga[3];
            o1[0] = bflo(w[2]) + v[8 * j + 4] * r1 * gb[0]; o1[1] = bfhi(w[2]) + v[8 * j + 5] * r1 * gb[1]; o1[2] = bflo(w[3]) + v[8 * j + 6] * r1 * gb[2]; o1[3] = bfhi(w[3]) + v[8 * j + 7] * r1 * gb[3];
            *(f32x4*)(out + (size_t)m * DM + co) = o0; *(f32x4*)(out + (size_t)m * DM + co + 4) = o1; }
    }
}

constexpr int NPHASE = 12;
__global__ void __launch_bounds__(512, 2) fwd_mega(const Args args) {
    extern __shared__ __attribute__((aligned(16))) unsigned char lds_raw[];
    {
        const int t0 = threadIdx.x;
        for (int u = t0; u < (LDS_BYTES - 131072) / 4; u += 512) ((LAS unsigned*)((LAS unsigned char*)lds_raw + 131072))[u] = 0u;
    }
    __syncthreads();
    const int lo = args.ph_lo, hi = args.ph_hi;
#define IN(k) (lo <= (k) && (k) < hi)
#define BARSETUP() XcdBarrier bar; bar.bar = (unsigned*)(args.ws + WS_CTL) + 4096; bar.x = xb_xcc_id(); bar.st = (volatile LAS unsigned*)((LAS unsigned char*)lds_raw + MISC_OFF) + 8;
#define SEAM(k) do { if (IN(k) && IN((k) + 1)) { BARSETUP(); xcd_barrier(bar); } } while (0)
    if (hi - lo > 1) { if (threadIdx.x == 0) (void)xb_add((unsigned*)(args.ws + WS_CTL) + 4096 + XB_XCNT(xb_xcc_id()), 1u); }

    if (IN(0)) { MK_FRAME(F); F.x = args.in[0]; F.p = args.in[1]; F.w_in = args.in[2]; F.b_gates = args.in[3]; F.w_pool = args.in[6]; F.w_out = args.in[8]; F.g_mix_pre = args.in[9];
        F.w_ff1 = args.in[11]; F.w_ff2 = args.in[12]; F.w_ple_proj = args.in[15]; F.w_ple_gate = args.in[16];
        for (int rep_ = 0; rep_ < REP_P0; ++rep_) { p0_prologue(F); __syncthreads(); } } SEAM(0);
    if (IN(1)) {
        unsigned char* ws = args.ws;
        pg8::Gemm g{(const bf16*)(ws + WS_A0), (const bf16*)(ws + WS_WIN), DM, DM, DM, 0}; pg8::StaticOrder S; S.init(M, NIN, gridDim.x, blockIdx.x);
        pg8::EpiBf16<0> E{(bf16*)(ws + WS_Q), MW, nullptr, 1024, (size_t)(WS_K - WS_Q) / 2};
        for (int rep_ = 0; rep_ < GEMM_REP; ++rep_) pg8::gemm_phase((LAS unsigned char*)lds_raw, g, S, E);
    } SEAM(1);
    if (IN(2)) { MK_FRAME(F); F.w_conv = args.in[4];
        for (int rep_ = 0; rep_ < REP_P2I; ++rep_)
        for (int it = F.bid; it < NITEM; it += F.G) p2_item(F, it);
        for (int rep_ = 0; rep_ < REP_MIX; ++rep_) p2_pooled(F);
    } SEAM(2);
    if (IN(3)) { for (int rep_ = 0; rep_ < REP_P3; ++rep_) {
        {
            unsigned char* ws = args.ws; unsigned char* ob = (unsigned char*)args.out;
            pg8::Gemm g{(const bf16*)(ob + DO_POOLED), (const bf16*)(ws + WS_WPOOL), PW, 256, 256, 256}; pg8::StaticOrder S; S.init(M, PW, gridDim.x, blockIdx.x);
            pg8::EpiBf16<0> E{(bf16*)(ob + DO_MIX) + 1024, DM, args.in[7], 0, 0};
            pg8::gemm_phase((LAS unsigned char*)lds_raw, g, S, E);
        }
        { MK_FRAME(F); p3_scan(F); } }
    } SEAM(3);
    if (IN(4)) { MK_FRAME(F); F.g_mlstm = args.in[5];
        for (int rep_ = 0; rep_ < REP_P4; ++rep_) p4_phase(F);
    } SEAM(4);
    if (IN(5)) {
        unsigned char* ws = args.ws; unsigned char* ob = (unsigned char*)args.out;
        pg8::Gemm g{(const bf16*)(ob + DO_MIX), (const bf16*)(ws + WS_WOUT), DM, DM, DM, 0}; pg8::StaticOrder S; S.init(M, DM, gridDim.x, blockIdx.x);
        pg8::EpiBf16<0> E{(bf16*)(ws + WS_A0), DM, nullptr, 0, 0};
        for (int rep_ = 0; rep_ < GEMM_REP; ++rep_) pg8::gemm_phase((LAS unsigned char*)lds_raw, g, S, E);
    } SEAM(5);
    if (IN(6)) { MK_FRAME(F); for (int rep_ = 0; rep_ < REP_ROW; ++rep_) row_resnorm<false>(F, args.in[0], F.ws + WS_A0, args.in[10], args.in[13], F.ob + DO_H1B, F.ws + WS_HN); } SEAM(6);
    if (IN(7)) {
        unsigned char* ws = args.ws;
        pg8::Gemm g{(const bf16*)(ws + WS_HN), (const bf16*)(ws + WS_WFF1), DM, DM, DM, 0}; pg8::StaticOrder S; S.init(M, DFF, gridDim.x, blockIdx.x);
        pg8::EpiBf16<1> E{(bf16*)(ws + WS_HB), DFF, nullptr, 0, 0};
        for (int rep_ = 0; rep_ < GEMM_REP; ++rep_) pg8::gemm_phase((LAS unsigned char*)lds_raw, g, S, E);
    } SEAM(7);
    if (IN(8)) {
        unsigned char* ws = args.ws;
        pg8::Gemm g{(const bf16*)(ws + WS_HB), (const bf16*)(ws + WS_WFF2), DFF, DFF, DFF, 0}; pg8::StaticOrder S; S.init(M, DM, gridDim.x, blockIdx.x);
        pg8::EpiBf16<0> E{(bf16*)(ws + WS_A0), DM, nullptr, 0, 0};
        for (int rep_ = 0; rep_ < GEMM_REP; ++rep_) pg8::gemm_phase((LAS unsigned char*)lds_raw, g, S, E);
    } SEAM(8);
    if (IN(9)) { MK_FRAME(F); row_resnorm<true>(F, F.ob + DO_H1B, F.ws + WS_A0, args.in[14], args.in[17], F.ws + WS_H2B, F.ws + WS_HN); } SEAM(9);
    if (IN(10)) {
        unsigned char* ws = args.ws;
        {   pg8::Gemm g{(const bf16*)(ws + WS_PB), (const bf16*)(ws + WS_WPP), PD, PD, PD, 0}; pg8::StaticOrder S; S.init(M, DM, gridDim.x, blockIdx.x);
            pg8::EpiF32 E{(float*)(ws + WS_E), DM};
            for (int rep_ = 0; rep_ < GEMM_REP; ++rep_) pg8::gemm_phase((LAS unsigned char*)lds_raw, g, S, E); }
        asm volatile("s_waitcnt vmcnt(0)" ::: "memory"); __syncthreads();
        {   pg8::Gemm g{(const bf16*)(ws + WS_HN), (const bf16*)(ws + WS_WPG), DM, DM, DM, 0}; pg8::StaticOrder S; S.init(M, DM, gridDim.x, blockIdx.x);
            pg8::EpiGateMul E{(const float*)(ws + WS_E), (bf16*)(ws + WS_A0), DM};
            for (int rep_ = 0; rep_ < GEMM_REP; ++rep_) pg8::gemm_phase((LAS unsigned char*)lds_raw, g, S, E); }
    } SEAM(10);
    if (IN(11)) { MK_FRAME(F); row_final(F, F.ws + WS_H2B, F.ws + WS_A0, args.in[18], F.out); }
    if (lo < 0) cg::this_grid().sync();
#undef IN
#undef SEAM
#undef BARSETUP
}


#ifdef DBG_STOP
struct DbgBuf { const void* p; size_t n; int is_f32; int bit; };
__global__ void __launch_bounds__(512) dbg_scan(DbgBuf b0, DbgBuf b1, DbgBuf b2, DbgBuf b3, DbgBuf b4, DbgBuf b5, unsigned* flag) {
    DbgBuf bs[6] = {b0, b1, b2, b3, b4, b5};
    unsigned mask = 0u;
    for (int k = 0; k < 6; ++k) { const DbgBuf b = bs[k]; if (!b.p) continue; bool bad = false;
        for (size_t i = (size_t)blockIdx.x * 512 + threadIdx.x; i < b.n; i += (size_t)gridDim.x * 512) {
            const float v = b.is_f32 ? ((const float*)b.p)[i] : __uint_as_float(((unsigned)((const unsigned short*)b.p)[i]) << 16);
            if (!(fabsf(v) < 1e30f)) bad = true; }
        if (bad) mask |= 1u << b.bit; }
    if (mask) atomicOr(flag, mask);
}
__global__ void __launch_bounds__(512) dbg_write(float* out, size_t n, const unsigned* flag) {
    for (size_t i = (size_t)blockIdx.x * 512 + threadIdx.x; i < n; i += (size_t)gridDim.x * 512) out[i] = (i == 0) ? 1000.0f * (float)(*flag) : 0.f;
}
#endif
extern "C" void kernel_launch(void* const* d_in, const int* in_sizes, int n_in, void* d_out, int out_size, void* d_ws, size_t ws_size, hipStream_t stream) {
    static int grid = 0;
    if (grid == 0) {
        if (n_in != 19 || out_size != M * DM || ws_size < WS_END) { fprintf(stderr, "kernel_launch: unexpected shapes (n_in %d, out %d, ws %zu)\n", n_in, out_size, ws_size); grid = -1; return; }
        int dev = 0, cus = 0, per_cu = 0;
        if (hipGetDevice(&dev) != hipSuccess || hipDeviceGetAttribute(&cus, hipDeviceAttributeMultiprocessorCount, dev) != hipSuccess) { grid = -1; return; }
        if (hipFuncSetAttribute((const void*)fwd_mega, hipFuncAttributeMaxDynamicSharedMemorySize, LDS_BYTES) != hipSuccess) { fprintf(stderr, "kernel_launch: hipFuncSetAttribute failed\n"); grid = -1; return; }
        if (hipOccupancyMaxActiveBlocksPerMultiprocessor(&per_cu, (const void*)fwd_mega, 512, LDS_BYTES) != hipSuccess || per_cu < 1) { fprintf(stderr, "kernel_launch: occupancy query failed (%d)\n", per_cu); (void)hipGetLastError(); per_cu = 1; }
        grid = cus * (per_cu < 1 ? 1 : per_cu);
        if (grid > 256) grid = 256;
        fprintf(stderr, "kernel_launch: %d CUs, %d blocks/CU by the occupancy query, grid %d\n", cus, per_cu, grid);
    }
    if (grid < 0) return;
    (void)hipMemsetAsync((char*)d_ws + WS_CTL, 0, CTL_BYTES, stream);
    Args a{};
    for (int i = 0; i < 19; ++i) a.in[i] = (const float*)d_in[i];
    a.out = (float*)d_out; a.ws = (unsigned char*)d_ws;
#if N_LAUNCH_MODE == 1
    a.ph_lo = 0; a.ph_hi = NPHASE;
    void* kargs[] = {&a};
    hipError_t e = hipLaunchCooperativeKernel((const void*)fwd_mega, dim3(grid), dim3(512), kargs, LDS_BYTES, stream);
    if (e != hipSuccess) fprintf(stderr, "kernel_launch: cooperative launch failed: %s (grid %d)\n", hipGetErrorString(e), grid);
#else
#ifdef DBG_STOP
    for (int ph = 0; ph < DBG_STOP; ++ph) { a.ph_lo = ph; a.ph_hi = ph + 1; hipLaunchKernelGGL(fwd_mega, dim3(grid), dim3(512), LDS_BYTES, stream, a); }
    { unsigned char* ws = (unsigned char*)d_ws; unsigned char* ob = (unsigned char*)d_out; unsigned* flag = (unsigned*)(ws + WS_CTL) + 100000;
      DBG_BUFS
      hipLaunchKernelGGL(dbg_scan, dim3(1024), dim3(512), 0, stream, B0, B1, B2, B3, B4, B5, flag);
      hipLaunchKernelGGL(dbg_write, dim3(1024), dim3(512), 0, stream, (float*)d_out, (size_t)M * DM, (const unsigned*)flag); }
#else
    for (int ph = 0; ph < NPHASE; ++ph) { a.ph_lo = ph; a.ph_hi = ph + 1; hipLaunchKernelGGL(fwd_mega, dim3(grid), dim3(512), LDS_BYTES, stream, a); }
#endif
#endif
}
```

```cpp
#include <hip/hip_runtime.h>
#include <hip/hip_cooperative_groups.h>
#include <cstdio>
#include <cstdint>
namespace cg = cooperative_groups;

#ifndef GEMM_REP
#define GEMM_REP 1
#endif
#ifndef REP_P0
#define REP_P0 1
#endif
#ifndef REP_P0A
#define REP_P0A 1
#endif
#ifndef REP_P0D
#define REP_P0D 1
#endif
#ifndef REP_P2I
#define REP_P2I 1
#endif
#ifndef REP_P3
#define REP_P3 1
#endif
#ifndef REP_P4
#define REP_P4 1
#endif
#ifndef REP_FF1
#define REP_FF1 1
#endif
#ifndef REP_FF2
#define REP_FF2 1
#endif
#ifndef REP_BAR
#define REP_BAR 1
#endif
#ifndef REP_MIX
#define REP_MIX 1
#endif
#ifndef REP_ROW
#define REP_ROW 1
#endif
#ifndef N_LAUNCH_MODE
#define N_LAUNCH_MODE 1
#endif

namespace pg8 {
#define PG8_LAS __attribute__((address_space(3)))
typedef unsigned short bf16_t;
typedef short bf16x8 __attribute__((ext_vector_type(8)));
typedef float f32x4 __attribute__((ext_vector_type(4)));
typedef unsigned u32x4 __attribute__((ext_vector_type(4)));
typedef unsigned u32x2 __attribute__((ext_vector_type(2)));
constexpr int BM = 256, BK = 64, HALF = 128, HTB = HALF * BK * 2, STAGE_BYTES = 8 * HTB, NXCD = 8, WGM = 8;

__host__ __device__ __forceinline__ int lds_byte(int r, int c) { const int st = (r >> 4) * 2 + (c >> 5), rr = r & 15, cc = c & 31, ob = rr * 64 + cc * 2; return st * 1024 + (ob ^ (((ob >> 9) & 1) << 5)); }
__host__ __device__ __forceinline__ void stage_rc(int b, int& R, int& C) { const int st = b / 1024, sb = b % 1024, swz = sb ^ (((sb >> 9) & 1) << 5); R = (st >> 1) * 16 + swz / 64; C = (st & 1) * 32 + (swz % 64) / 2; }
__host__ __device__ __forceinline__ int perm32(int rho) { const int n = rho >> 4, i = rho & 15; return 8 * (i >> 2) + 4 * n + (i & 3); }

struct Unit { int pm, pn; };
struct Gemm { const bf16_t* A; const bf16_t* Bt; int lda, ldb, K, a_pn_off; };

struct StaticOrder {
    int nM, nN, nwg, G, c;
    __host__ __device__ void init(int M, int N, int G_, int c_) { nM = M / BM; nN = N / BM; nwg = nM * nN; G = G_; c = c_; }
    __host__ __device__ bool next(int i, Unit& u) const {
        const long L = (long)i * G + c; if (L >= nwg) return false;
        int wgid = (int)L; { const int q = nwg / NXCD, r = nwg % NXCD, xcd = wgid % NXCD, off = wgid / NXCD; wgid = (xcd < r ? xcd * (q + 1) : r * (q + 1) + (xcd - r) * q) + off; }
        const int nig = WGM * nN, gid = wgid / nig, fm = gid * WGM, gsz = (nM - fm) < WGM ? (nM - fm) : WGM;
        u.pm = fm + ((wgid % nig) % gsz); u.pn = (wgid % nig) / gsz; return true;
    }
};

__device__ __forceinline__ unsigned cvt_pk_bf16(float lo, float hi) { unsigned r; asm volatile("v_cvt_pk_bf16_f32 %0, %1, %2" : "=v"(r) : "v"(lo), "v"(hi)); return r; }

template <int ACT  > struct EpiBf16 {
    static constexpr bool PERM = true;
    bf16_t* O; int ldc; const float* cscale; int split_cols; size_t split_stride;
    __device__ __forceinline__ void operator()(const f32x4 (&acc)[2][2][4][2], const Unit& u, int wr, int wc, int fr, int fq) const {
        const int row0 = u.pm * BM + wr * 64 + fr; int colt = u.pn * BM; bf16_t* base = O;
        if (split_cols) { const int t = colt / split_cols; base += (size_t)t * split_stride; colt -= t * split_cols; }
        const int col0 = colt + wc * 32 + 8 * fq, bcol0 = u.pn * BM + wc * 32 + 8 * fq;
        f32x4 sv[2][2];
#pragma unroll
        for (int bj = 0; bj < 2; ++bj)
#pragma unroll
            for (int n = 0; n < 2; ++n) sv[bj][n] = cscale ? *(const f32x4*)(cscale + bcol0 + bj * HALF + 4 * n) : (f32x4){1.f, 1.f, 1.f, 1.f};
#pragma unroll
        for (int ai = 0; ai < 2; ++ai)
#pragma unroll
            for (int m = 0; m < 4; ++m) { bf16_t* rowp = base + (size_t)(row0 + ai * HALF + m * 16) * ldc + col0;
#pragma unroll
                for (int bj = 0; bj < 2; ++bj) { f32x4 v0 = acc[ai][bj][m][0], v1 = acc[ai][bj][m][1];
                    if (ACT == 1) {
#pragma unroll
                        for (int j = 0; j < 4; ++j) { const float a = fmaxf(v0[j], 0.f), b = fmaxf(v1[j], 0.f); v0[j] = a * a; v1[j] = b * b; } }
                    v0 = v0 * sv[bj][0]; v1 = v1 * sv[bj][1];
                    u32x4 w; w.x = cvt_pk_bf16(v0[0], v0[1]); w.y = cvt_pk_bf16(v0[2], v0[3]); w.z = cvt_pk_bf16(v1[0], v1[1]); w.w = cvt_pk_bf16(v1[2], v1[3]);
                    *(u32x4*)(rowp + bj * HALF) = w; } }
    }
};
struct EpiF32 {
    static constexpr bool PERM = false;
    float* C; int ldc;
    __device__ __forceinline__ void operator()(const f32x4 (&acc)[2][2][4][2], const Unit& u, int wr, int wc, int fr, int fq) const {
        const int row0 = u.pm * BM + wr * 64 + fr, col0 = u.pn * BM + wc * 32 + 4 * fq;
#pragma unroll
        for (int ai = 0; ai < 2; ++ai)
#pragma unroll
            for (int m = 0; m < 4; ++m) { float* rowp = C + (size_t)(row0 + ai * HALF + m * 16) * ldc + col0;
#pragma unroll
                for (int bj = 0; bj < 2; ++bj)
#pragma unroll
                    for (int n = 0; n < 2; ++n) *(f32x4*)(rowp + bj * HALF + n * 16) = acc[ai][bj][m][n]; }
    }
};
struct EpiGateMul {
    static constexpr bool PERM = true;
    const bf16_t* E; bf16_t* O; int ldc;
    __device__ __forceinline__ void operator()(const f32x4 (&acc)[2][2][4][2], const Unit& u, int wr, int wc, int fr, int fq) const {
        const int row0 = u.pm * BM + wr * 64 + fr, col0 = u.pn * BM + wc * 32 + 8 * fq;
#pragma unroll
        for (int ai = 0; ai < 2; ++ai)
#pragma unroll
            for (int m = 0; m < 4; ++m) { const size_t ro = (size_t)(row0 + ai * HALF + m * 16) * ldc + col0;
#pragma unroll
                for (int bj = 0; bj < 2; ++bj) { const u32x4 e = *(const u32x4*)(E + ro + bj * HALF); const f32x4 a0 = acc[ai][bj][m][0], a1 = acc[ai][bj][m][1]; float o[8];
#pragma unroll
                    for (int j = 0; j < 2; ++j) { o[2 * j] = __uint_as_float(e[j] << 16) / (1.0f + __expf(-a0[2 * j])); o[2 * j + 1] = __uint_as_float(e[j] & 0xffff0000u) / (1.0f + __expf(-a0[2 * j + 1]));
                        o[4 + 2 * j] = __uint_as_float(e[2 + j] << 16) / (1.0f + __expf(-a1[2 * j])); o[4 + 2 * j + 1] = __uint_as_float(e[2 + j] & 0xffff0000u) / (1.0f + __expf(-a1[2 * j + 1])); }
                    u32x4 w; w.x = cvt_pk_bf16(o[0], o[1]); w.y = cvt_pk_bf16(o[2], o[3]); w.z = cvt_pk_bf16(o[4], o[5]); w.w = cvt_pk_bf16(o[6], o[7]);
                    *(u32x4*)(O + ro + bj * HALF) = w; } }
    }
};

template <class Epi, class Sched>
__device__ __forceinline__ void gemm_phase(PG8_LAS unsigned char* lds, const Gemm g, const Sched& S, const Epi& E) {
    int tid_ = threadIdx.x; asm volatile("" : "+v"(tid_));
    const int tid = tid_, wid = __builtin_amdgcn_readfirstlane(tid >> 6), lane = tid & 63, wr = wid >> 2, wc = wid & 3, fr = lane & 15, fq = lane >> 4;
    const int K = g.K, nt = K / BK;
    unsigned voffA[2], voffB[2];
#pragma unroll
    for (int i = 0; i < 2; ++i) { int R, C; stage_rc(tid * 16 + i * 8192, R, C); const int Rb = Epi::PERM ? ((R & ~31) + perm32(R & 31)) : R;
        voffA[i] = (unsigned)(R * g.lda + C) * 2u; voffB[i] = (unsigned)(Rb * g.ldb + C) * 2u; }
    const size_t kstep = (size_t)(BK * 2);
    const size_t hA = (size_t)HALF * g.lda * 2, hB = (size_t)HALF * g.ldb * 2;
    const size_t tA = 2 * hA, tB = 2 * hB;
    const size_t pnA = (size_t)g.a_pn_off * 2;
    const unsigned ldsw = (unsigned)wid * 1024u;
    const int aoff = lds_byte(wr * 64 + fr, fq * 8), boff = lds_byte(wc * 32 + fr, fq * 8);
#define PG8_SA(b, h) (((b) * 2 + (h)) * HTB)
#define PG8_SB(b, h) ((4 + (b) * 2 + (h)) * HTB)
#define PG8_STAGE(bufoff, gbase, voff) do { _Pragma("unroll") for (int _i = 0; _i < 2; ++_i) \
        __builtin_amdgcn_global_load_lds((const unsigned*)((const char*)(gbase) + (voff)[_i]), (PG8_LAS unsigned*)(lds + (bufoff) + ldsw + _i * 8192), 16, 0, 0); } while (0)
#define PG8_LDA(dst, b, h) do { _Pragma("unroll") for (int m = 0; m < 4; ++m) _Pragma("unroll") for (int k = 0; k < 2; ++k) dst[m][k] = *(const PG8_LAS bf16x8*)(lds + PG8_SA(b, h) + aoff + m * 2048 + k * 1024); } while (0)
#define PG8_LDB(dst, b, h) do { _Pragma("unroll") for (int n = 0; n < 2; ++n) _Pragma("unroll") for (int k = 0; k < 2; ++k) dst[n][k] = *(const PG8_LAS bf16x8*)(lds + PG8_SB(b, h) + boff + n * 2048 + k * 1024); } while (0)
#define PG8_MMA(ai, bj, At, Bt) do { __builtin_amdgcn_s_setprio(1); _Pragma("unroll") for (int m = 0; m < 4; ++m) _Pragma("unroll") for (int n = 0; n < 2; ++n) _Pragma("unroll") for (int k = 0; k < 2; ++k) \
        acc[ai][bj][m][n] = __builtin_amdgcn_mfma_f32_16x16x32_bf16(Bt[n][k], At[m][k], acc[ai][bj][m][n], 0, 0, 0); __builtin_amdgcn_s_setprio(0); } while (0)
#define PG8_WAIT_V(n) asm volatile("s_waitcnt vmcnt(" #n ")" ::: "memory")
#define PG8_WAIT_L(n) asm volatile("s_waitcnt lgkmcnt(" #n ")" ::: "memory")
#define PG8_BAR __builtin_amdgcn_s_barrier()
#define PG8_SCHED __builtin_amdgcn_sched_barrier(0)
    Unit cur, nxt; int ui = 0;
    if (!S.next(0, cur)) return;
    f32x4 acc[2][2][4][2];
#pragma unroll
    for (int a = 0; a < 2; ++a)
#pragma unroll
        for (int b = 0; b < 2; ++b)
#pragma unroll
            for (int m = 0; m < 4; ++m)
#pragma unroll
                for (int n = 0; n < 2; ++n) acc[a][b][m][n] = (f32x4){0.f, 0.f, 0.f, 0.f};
    bf16x8 At[4][2], B0[2][2], B1[2][2];
    const char* cA = (const char*)g.A + (size_t)cur.pm * tA + (size_t)cur.pn * pnA; const char* cB = (const char*)g.Bt + (size_t)cur.pn * tB;
    PG8_STAGE(PG8_SB(0, 0), cB, voffB); PG8_STAGE(PG8_SB(0, 1), cB + hB, voffB); PG8_STAGE(PG8_SA(0, 0), cA, voffA); PG8_STAGE(PG8_SA(0, 1), cA + hA, voffA);
    if (wr == 1) PG8_BAR;
    PG8_WAIT_V(2); PG8_BAR;
    PG8_STAGE(PG8_SB(1, 0), cB + kstep, voffB); PG8_STAGE(PG8_SA(1, 0), cA + kstep, voffA); PG8_STAGE(PG8_SB(1, 1), cB + hB + kstep, voffB);
    PG8_WAIT_V(6); PG8_BAR;
    for (;;) {
        const bool has_next = S.next(ui + 1, nxt);
        const char* nA = has_next ? (const char*)g.A + (size_t)nxt.pm * tA + (size_t)nxt.pn * pnA : cA; const char* nB = has_next ? (const char*)g.Bt + (size_t)nxt.pn * tB : cB;
        for (int t = 0; t < nt; t += 2) {
            const bool last = (t == nt - 2);
            const char* a1 = cA + (size_t)(t + 1) * kstep;
            const char* a2 = last ? nA : cA + (size_t)(t + 2) * kstep; const char* b2 = last ? nB : cB + (size_t)(t + 2) * kstep;
            const char* a3 = a2 + kstep; const char* b3 = b2 + kstep;
            PG8_LDB(B0, 0, 0); PG8_LDB(B1, 0, 1); PG8_SCHED; PG8_LDA(At, 0, 0); PG8_STAGE(PG8_SA(1, 1), a1 + hA, voffA);
            PG8_WAIT_V(8); PG8_WAIT_L(0); PG8_BAR; PG8_MMA(0, 0, At, B0); PG8_MMA(0, 1, At, B1); PG8_BAR; PG8_SCHED;
            PG8_LDA(At, 0, 1); PG8_STAGE(PG8_SB(0, 0), b2, voffB); PG8_STAGE(PG8_SB(0, 1), b2 + hB, voffB); PG8_STAGE(PG8_SA(0, 0), a2, voffA);
            PG8_WAIT_V(8); PG8_WAIT_L(0); PG8_BAR; PG8_MMA(1, 0, At, B0); PG8_MMA(1, 1, At, B1); PG8_BAR; PG8_SCHED;
            PG8_LDB(B0, 1, 0); PG8_LDB(B1, 1, 1); PG8_SCHED; PG8_LDA(At, 1, 0); PG8_STAGE(PG8_SA(0, 1), a2 + hA, voffA);
            PG8_WAIT_V(8); PG8_WAIT_L(0); PG8_BAR; PG8_MMA(0, 0, At, B0); PG8_MMA(0, 1, At, B1); PG8_BAR; PG8_SCHED;
            PG8_LDA(At, 1, 1); PG8_STAGE(PG8_SB(1, 0), b3, voffB); PG8_STAGE(PG8_SB(1, 1), b3 + hB, voffB); PG8_STAGE(PG8_SA(1, 0), a3, voffA);
            PG8_WAIT_V(8); PG8_WAIT_L(0); PG8_BAR; PG8_MMA(1, 0, At, B0); PG8_MMA(1, 1, At, B1); PG8_BAR; PG8_SCHED;
        }
        if (wr == 0) PG8_BAR;
        E(acc, cur, wr, wc, fr, fq);
        if (!has_next) break;
#pragma unroll
        for (int a = 0; a < 2; ++a)
#pragma unroll
            for (int b = 0; b < 2; ++b)
#pragma unroll
                for (int m = 0; m < 4; ++m)
#pragma unroll
                    for (int n = 0; n < 2; ++n) acc[a][b][m][n] = (f32x4){0.f, 0.f, 0.f, 0.f};
        cur = nxt; cA = nA; cB = nB; ++ui;
        if (wr == 1) PG8_BAR;
    }
    PG8_WAIT_V(0);
    PG8_BAR;
#undef PG8_SA
#undef PG8_SB
#undef PG8_STAGE
#undef PG8_LDA
#undef PG8_LDB
#undef PG8_MMA
#undef PG8_WAIT_V
#undef PG8_WAIT_L
#undef PG8_BAR
#undef PG8_SCHED
}
}

constexpr int NB = 8, SEQ = 2048, DM = 2048, PD = 256, NH = 8, DH = 128, MW = 1024, PW = 1024, DFF = 8192, CH = 64, NCH = 32;
constexpr int M = NB * SEQ;
constexpr int INC = 5136, NIN = 5120;
constexpr int C_GATE = 4096, C_U = 4112;
constexpr int NITEM = NB * NH * NCH;
constexpr float EPS = 1e-6f;
constexpr size_t MiB = 1u << 20;
constexpr size_t WS_CTL = 0, CTL_BYTES = 1 * MiB;
constexpr size_t WS_WIN = 2 * MiB, WS_WOUT = 22 * MiB, WS_WFF1 = 30 * MiB, WS_WFF2 = 62 * MiB, WS_WPG = 94 * MiB, WS_WPP = 102 * MiB, WS_WPOOL = 103 * MiB;
constexpr size_t WS_GATES = 104 * MiB, WS_NLOC = 105 * MiB, WS_NPREV = 106 * MiB, WS_SCAL = 107 * MiB, WS_PB = 108 * MiB;
constexpr size_t WS_A0 = 116 * MiB;
constexpr size_t WS_Q = 180 * MiB, WS_K = 212 * MiB, WS_V = 244 * MiB, WS_O = 276 * MiB, WS_U = 308 * MiB;
constexpr size_t WS_CPREV = 180 * MiB;
constexpr size_t WS_QC = 340 * MiB, WS_KC = 372 * MiB;
constexpr size_t WS_HB = 180 * MiB;
constexpr size_t WS_E = 180 * MiB;
constexpr size_t WS_HN = 436 * MiB;
constexpr size_t WS_END = 500 * MiB;
constexpr size_t DO_MIX = 0, DO_POOLED = 64 * MiB, DO_VT = 96 * MiB;
constexpr size_t DO_H1B = 0;
constexpr size_t WS_H2B = 308 * MiB;
constexpr int LDS_BYTES = 147456;
constexpr int MISC_OFF = 131072 + 320;

typedef unsigned short bf16;
typedef short bf16x8 __attribute__((ext_vector_type(8)));
typedef float f32x4 __attribute__((ext_vector_type(4)));
typedef unsigned u32x4 __attribute__((ext_vector_type(4)));
typedef unsigned u32x2 __attribute__((ext_vector_type(2)));
#define LAS __attribute__((address_space(3)))
#define LDS_WAIT() asm volatile("s_waitcnt lgkmcnt(0)" ::: "memory")

__device__ __forceinline__ float bf2f(unsigned short b) { return __uint_as_float(((unsigned)b) << 16); }
__device__ __forceinline__ float bflo(unsigned w) { return __uint_as_float(w << 16); }
__device__ __forceinline__ float bfhi(unsigned w) { return __uint_as_float(w & 0xffff0000u); }
typedef __bf16 bf16v2_t __attribute__((ext_vector_type(2)));
typedef float f32v2_t __attribute__((ext_vector_type(2)));
__device__ __forceinline__ unsigned pk2(float lo, float hi) { const bf16v2_t r = __builtin_convertvector((f32v2_t){lo, hi}, bf16v2_t); return __builtin_bit_cast(unsigned, r); }
__device__ __forceinline__ float wave_sum(float v) {
#pragma unroll
    for (int o = 1; o < 64; o <<= 1) v += __shfl_xor(v, o);
    return v;
}
__device__ __forceinline__ float wave_max(float v) {
#pragma unroll
    for (int o = 1; o < 64; o <<= 1) v = fmaxf(v, __shfl_xor(v, o));
    return v;
}
__device__ __forceinline__ float sigm(float x) { return 1.0f / (1.0f + __expf(-x)); }
__device__ __forceinline__ float logsigm(float x) { return fminf(x, 0.f) - log1pf(__expf(-fabsf(x))); }

#define XB_TMO      128
#define XB_XCNT(j)  (256  + 64 * (j))
#define XB_XSUB(j)  (1280 + 64 * (j))
#define XB_XGEN(j)  (2304 + 64 * (j))
#define XB_TOP      3328
#define XB_TOPGEN   3392
#define XCD_BAR_WORDS 3456
#define XB_SPIN_CAP (1u << 18)
__device__ __forceinline__ unsigned xb_ld(unsigned* p)              { return __hip_atomic_load(p, __ATOMIC_RELAXED, __HIP_MEMORY_SCOPE_AGENT); }
__device__ __forceinline__ unsigned xb_add(unsigned* p, unsigned v) { return __hip_atomic_fetch_add(p, v, __ATOMIC_RELAXED, __HIP_MEMORY_SCOPE_AGENT); }
__device__ __forceinline__ unsigned xb_xcc_id() { return (unsigned)__builtin_amdgcn_s_getreg((3 << 11) | 20) & 0xFu; }
#define XB_SPIN(cond, bar) do { unsigned _sp = 0; while (cond) { __builtin_amdgcn_s_sleep(1); \
    if ((++_sp & 255u) == 0u) { if (xb_ld(&(bar)[XB_TMO])) break; if (_sp > XB_SPIN_CAP) { atomicAdd(&(bar)[XB_TMO], 1u); break; } } } } while (0)
struct XcdBarrier { unsigned* bar; unsigned x; volatile LAS unsigned* st; };
__device__ __forceinline__ XcdBarrier xcd_barrier_post(unsigned* bar, volatile LAS unsigned* st) {
    XcdBarrier b; b.bar = bar; b.x = xb_xcc_id(); b.st = st;
    if (threadIdx.x == 0) (void)xb_add(&bar[XB_XCNT(b.x)], 1u);
    return b;
}
__device__ __forceinline__ void xcd_barrier_complete(unsigned* bar, unsigned x, unsigned& nloc, unsigned& nx) {
    const unsigned G = gridDim.x * gridDim.y * gridDim.z;
    unsigned sum, cnt, mine, sp = 0u;
    for (;;) {
        sum = 0u; cnt = 0u; mine = 0u;
#pragma unroll
        for (unsigned j = 0; j < 16; ++j) { const unsigned c = xb_ld(&bar[XB_XCNT(j)]); sum += c; cnt += (c > 0u) ? 1u : 0u; mine = (j == x) ? c : mine; }
        if (sum == G) break;
        __builtin_amdgcn_s_sleep(1);
        if ((++sp & 255u) == 0u) { if (xb_ld(&bar[XB_TMO])) break; if (sp > XB_SPIN_CAP) { atomicAdd(&bar[XB_TMO], 1u); break; } }
    }
    nloc = mine > 0u ? mine : 1u; nx = cnt > 0u ? cnt : 1u;
}
__device__ __forceinline__ void xcd_barrier(const XcdBarrier& b) {
    asm volatile("s_waitcnt vmcnt(0)" ::: "memory");
    __syncthreads();
    if (threadIdx.x == 0) {
        unsigned* bar = b.bar;
        __builtin_amdgcn_s_waitcnt(0);
        unsigned nloc = b.st[0], nx = b.st[1];
        if (nloc == 0u) { xcd_barrier_complete(bar, b.x, nloc, nx); b.st[0] = nloc; b.st[1] = nx; }
        const unsigned old = xb_add(&bar[XB_XSUB(b.x)], 1u);
        const unsigned gen = old / nloc;
        if (old + 1u == (gen + 1u) * nloc) {
            __builtin_amdgcn_fence(__ATOMIC_RELEASE, "agent");
            asm volatile("s_waitcnt vmcnt(0)" ::: "memory");
            const unsigned og = xb_add(&bar[XB_TOP], 1u);
            const unsigned tg = og / nx;
            if (og + 1u == (tg + 1u) * nx) xb_add(&bar[XB_TOPGEN], 1u);
            else XB_SPIN(xb_ld(&bar[XB_TOPGEN]) == tg, bar);
            __builtin_amdgcn_fence(__ATOMIC_ACQUIRE, "agent");
            xb_add(&bar[XB_XGEN(b.x)], 1u);
            asm volatile("s_waitcnt vmcnt(0)" ::: "memory");
        } else {
            XB_SPIN(xb_ld(&bar[XB_XGEN(b.x)]) == gen, bar);
            __builtin_amdgcn_fence(__ATOMIC_ACQUIRE, "agent");
            asm volatile("s_waitcnt vmcnt(0)" ::: "memory");
        }
    }
    __syncthreads();
}

struct Args { const float* in[19]; float* out; unsigned char* ws; int ph_lo, ph_hi; };
struct Frame {
    LAS unsigned char* lds;
    int tid, lane, wave, G, bid;
    const float *x, *p, *w_in, *b_gates, *w_conv, *g_mlstm, *w_pool, *pool_scale, *w_out, *g_mix_pre, *g_mix_post, *w_ff1, *w_ff2, *g_ff_pre, *g_ff_post, *w_ple_proj, *w_ple_gate, *g_ple_gate, *g_ple_post;
    float* out; unsigned char* ws; unsigned char* ob;
};
#define MK_FRAME(F) Frame F; { int t_ = threadIdx.x; asm volatile("" : "+v"(t_)); F.lds = (LAS unsigned char*)lds_raw; F.tid = t_; F.lane = t_ & 63; F.wave = __builtin_amdgcn_readfirstlane(t_ >> 6); F.G = gridDim.x; F.bid = blockIdx.x; \
    F.out = args.out; F.ws = args.ws; F.ob = (unsigned char*)args.out; }

struct TrItem { const float* src; bf16* dst; int ldw; };
__device__ __forceinline__ bool tr_decode(const Frame& F, int it, int lane, TrItem& t) {
    constexpr int I0 = 32 * 64, I1 = 32 * 16, I2 = 32 * 32, I3 = 32 * 128, I4 = 128 * 32, I5 = 32 * 32, I6 = 4 * 32, I7 = 4 * 16;
    constexpr int NIT = I0 + I1 + I2 + I3 + I4 + I5 + I6 + I7;
    if (it >= NIT) return false;
    unsigned char* ws = F.ws; int r = it; const float* W; int ldw, ns0, ldt, nd0, kb, nb; bf16* WT;
    if (r < I0) { W = F.w_in; ldw = INC; ns0 = 0; WT = (bf16*)(ws + WS_WIN); ldt = DM; nd0 = 0; kb = r / 64; nb = r % 64; }
    else if ((r -= I0) < I1) { W = F.w_in; ldw = INC; ns0 = C_U; WT = (bf16*)(ws + WS_WIN); ldt = DM; nd0 = 4096; kb = r / 16; nb = r % 16; }
    else if ((r -= I1) < I2) { W = F.w_out; ldw = DM; ns0 = 0; WT = (bf16*)(ws + WS_WOUT); ldt = DM; nd0 = 0; kb = r / 32; nb = r % 32; }
    else if ((r -= I2) < I3) { W = F.w_ff1; ldw = DFF; ns0 = 0; WT = (bf16*)(ws + WS_WFF1); ldt = DM; nd0 = 0; kb = r / 128; nb = r % 128; }
    else if ((r -= I3) < I4) { W = F.w_ff2; ldw = DM; ns0 = 0; WT = (bf16*)(ws + WS_WFF2); ldt = DFF; nd0 = 0; kb = r / 32; nb = r % 32; }
    else if ((r -= I4) < I5) { W = F.w_ple_gate; ldw = DM; ns0 = 0; WT = (bf16*)(ws + WS_WPG); ldt = DM; nd0 = 0; kb = r / 32; nb = r % 32; }
    else if ((r -= I5) < I6) { W = F.w_ple_proj; ldw = DM; ns0 = 0; WT = (bf16*)(ws + WS_WPP); ldt = PD; nd0 = 0; kb = r / 32; nb = r % 32; }
    else { r -= I6; const int g = r / 16, rr = r % 16; W = F.w_pool + (size_t)g * 256 * 256; ldw = 256; ns0 = 0; WT = (bf16*)(ws + WS_WPOOL); ldt = 256; nd0 = g * 256; kb = rr / 4; nb = rr % 4; }
    t.src = W + (size_t)(64 * kb) * ldw + ns0 + 64 * nb + lane; t.dst = WT + (size_t)(nd0 + 64 * nb + lane) * ldt + 64 * kb; t.ldw = ldw;
    return true;
}
__device__ __forceinline__ void tr_load(const TrItem& t, int h, float (&v)[32]) {
#pragma unroll
    for (int i = 0; i < 32; ++i) v[i] = t.src[(size_t)(32 * h + i) * t.ldw];
}
__device__ __forceinline__ void tr_store(const TrItem& t, int h, const float (&v)[32]) {
#pragma unroll
    for (int j = 0; j < 4; ++j) { u32x4 o; o.x = pk2(v[8 * j], v[8 * j + 1]); o.y = pk2(v[8 * j + 2], v[8 * j + 3]); o.z = pk2(v[8 * j + 4], v[8 * j + 5]); o.w = pk2(v[8 * j + 6], v[8 * j + 7]);
        *(u32x4*)(t.dst + 32 * h + 8 * j) = o; }
}
__device__ __forceinline__ void p0_transposes(Frame& F, int gw, int NGW) {
    TrItem cur, nxt; float va[32], vb[32];
    int it = gw;
    if (!tr_decode(F, it, F.lane, cur)) return;
    tr_load(cur, 0, va);
    for (;;) {
        tr_load(cur, 1, vb);
        tr_store(cur, 0, va);
        it += NGW;
        const bool more = tr_decode(F, it, F.lane, nxt);
        if (more) tr_load(nxt, 0, va);
        tr_store(cur, 1, vb);
        if (!more) break;
        cur = nxt;
    }
}

__device__ __forceinline__ void p0_prologue(Frame& F) {
    const int gw = F.bid * 8 + F.wave, NGW = F.G * 8;
    unsigned char* ws = F.ws;
    for (int rep_ = 0; rep_ < REP_P0A; ++rep_) p0_transposes(F, gw, NGW);
    {
        const int gt = F.bid * 512 + F.tid, NGT = F.G * 512;
        for (int i = gt; i < M * PD / 8; i += NGT) { const f32x4 a = *(const f32x4*)(F.p + (size_t)i * 8), b = *(const f32x4*)(F.p + (size_t)i * 8 + 4);
            u32x4 o; o.x = pk2(a[0], a[1]); o.y = pk2(a[2], a[3]); o.z = pk2(b[0], b[1]); o.w = pk2(b[2], b[3]); *(u32x4*)(ws + WS_PB + (size_t)i * 16) = o; }
    }
    __syncthreads();
    {
        LAS f32x4* wg = (LAS f32x4*)F.lds;
        for (int idx = F.tid; idx < 8192; idx += 512) { const int ln = idx & 63, c4 = (idx >> 6) & 3, i = (idx >> 8) & 3, jj = idx >> 10; const int k = 256 * jj + 4 * ln + i;
            wg[idx] = *(const f32x4*)(F.w_in + (size_t)k * INC + C_GATE + 4 * c4); }
    }
    __syncthreads();
    {
        const LAS f32x4* wg = (const LAS f32x4*)F.lds;
        const int lane = F.lane;
        f32x4 gq[8];
#pragma unroll
        for (int jj = 0; jj < 8; ++jj) gq[jj] = *(const f32x4*)(F.g_mix_pre + 256 * jj + 4 * lane);
        const float bgl = (lane < 16) ? F.b_gates[lane] : 0.f;
        for (int rep_ = 0; rep_ < REP_P0D; ++rep_) {
        f32x4 v[8], nx[8];
        int m = gw;
        if (m < M) {
#pragma unroll
            for (int jj = 0; jj < 8; ++jj) nx[jj] = *(const f32x4*)(F.x + (size_t)m * DM + 256 * jj + 4 * lane); }
        for (; m < M; m += NGW) {
#pragma unroll
            for (int jj = 0; jj < 8; ++jj) v[jj] = nx[jj];
            if (m + NGW < M) {
#pragma unroll
                for (int jj = 0; jj < 8; ++jj) nx[jj] = *(const f32x4*)(F.x + (size_t)(m + NGW) * DM + 256 * jj + 4 * lane); }
            float s = 0.f;
#pragma unroll
            for (int jj = 0; jj < 8; ++jj) s += (v[jj][0] * v[jj][0] + v[jj][1] * v[jj][1]) + (v[jj][2] * v[jj][2] + v[jj][3] * v[jj][3]);
            const float rs = rsqrtf(wave_sum(s) * (1.0f / DM) + EPS);
            f32x4 ga[4];
#pragma unroll
            for (int c4 = 0; c4 < 4; ++c4) ga[c4] = (f32x4){0.f, 0.f, 0.f, 0.f};
#pragma unroll
            for (int jj = 0; jj < 8; ++jj) { v[jj] = v[jj] * rs * gq[jj];
                u32x2 o; o.x = pk2(v[jj][0], v[jj][1]); o.y = pk2(v[jj][2], v[jj][3]); *(u32x2*)(ws + WS_A0 + ((size_t)m * DM + 256 * jj + 4 * lane) * 2) = o;
#pragma unroll
                for (int i = 0; i < 4; ++i)
#pragma unroll
                    for (int c4 = 0; c4 < 4; ++c4) ga[c4] += wg[((jj * 4 + i) * 4 + c4) * 64 + lane] * v[jj][i];
                asm volatile("" ::: "memory"); }
            float res = 0.f;
#pragma unroll
            for (int c4 = 0; c4 < 4; ++c4)
#pragma unroll
                for (int j = 0; j < 4; ++j) { const float t = wave_sum(ga[c4][j]); if (lane == c4 * 4 + j) res = t; }
            if (lane < 16) ((float*)(ws + WS_GATES))[(size_t)m * 16 + lane] = res + bgl;
        } }
    }
}

constexpr int PA_KT = 0, PA_VW = 18432, PA_VT = 36864, PA_W = 53248;
__device__ __forceinline__ int vt_pos(int j) { return (j & 32) | (((j >> 2) & 3) << 3) | (((j >> 4) & 1) << 2) | (j & 3); }
__device__ __forceinline__ void p2_item(Frame& F, int item) {
    unsigned char* ws = F.ws;
    const int tid = F.tid, lane = F.lane, wave = F.wave;
    const int c = item & 31, bh = item >> 5, h = bh & 7, b = bh >> 3;
    const int m0 = b * SEQ + c * CH;
    LAS unsigned char* lds = F.lds;
    LAS float* wl = (LAS float*)(lds + PA_W);
    const float* gates = (const float*)(ws + WS_GATES);
    if (wave == 0) {
        const float li = gates[(size_t)(m0 + lane) * 16 + h], lf = logsigm(gates[(size_t)(m0 + lane) * 16 + 8 + h]);
        float bs = lf;
#pragma unroll
        for (int o = 1; o < 64; o <<= 1) { const float t = __shfl_up(bs, o); if (lane >= o) bs += t; }
        const float btot = __shfl(bs, 63);
        const float a = btot - bs + li, amax = wave_max(a);
        wl[lane] = __expf(a - amax);
        if (lane == 0) { ((float*)(ws + WS_SCAL))[item] = amax; ((float*)(ws + WS_SCAL))[NITEM + item] = btot; }
    }
    const int cg8 = tid & 15, rp = tid >> 4, l0 = 2 * rp, col = h * DH + cg8 * 8;
    u32x4 qr[5], kr[5], vr[2];
#pragma unroll
    for (int i = 0; i < 5; ++i) { const int r = l0 - 3 + i; const bool ok = (c > 0) || (r >= 0);
        const size_t off = ((size_t)(m0 + r) * MW + col) * 2;
        qr[i] = ok ? *(const u32x4*)(ws + WS_Q + off) : (u32x4){0u, 0u, 0u, 0u};
        kr[i] = ok ? *(const u32x4*)(ws + WS_K + off) : (u32x4){0u, 0u, 0u, 0u}; }
#pragma unroll
    for (int i = 0; i < 2; ++i) vr[i] = *(const u32x4*)(ws + WS_V + ((size_t)(m0 + l0 + i) * MW + col) * 2);
    float wq[4][8], wk[4][8];
#pragma unroll
    for (int kk = 0; kk < 4; ++kk) { const f32x4 a = *(const f32x4*)(F.w_conv + kk * 2048 + col), b2 = *(const f32x4*)(F.w_conv + kk * 2048 + col + 4);
        const f32x4 c2 = *(const f32x4*)(F.w_conv + kk * 2048 + 1024 + col), d2 = *(const f32x4*)(F.w_conv + kk * 2048 + 1024 + col + 4);
#pragma unroll
        for (int j = 0; j < 4; ++j) { wq[kk][j] = a[j]; wq[kk][4 + j] = b2[j]; wk[kk][j] = c2[j]; wk[kk][4 + j] = d2[j]; } }
    float qy[2][8], ky[2][8];
#pragma unroll
    for (int rr = 0; rr < 2; ++rr)
#pragma unroll
        for (int j = 0; j < 8; ++j) { float aq = 0.f, ak = 0.f;
#pragma unroll
            for (int kk = 0; kk < 4; ++kk) { const unsigned wqv = qr[rr + kk][j >> 1], wkv = kr[rr + kk][j >> 1];
                const float xq = (j & 1) ? bfhi(wqv) : bflo(wqv), xk = (j & 1) ? bfhi(wkv) : bflo(wkv);
                aq += wq[kk][j] * xq; ak += wk[kk][j] * xk; }
            qy[rr][j] = aq * sigm(aq); ky[rr][j] = ak * sigm(ak) * 0.08838834764831845f; }
#pragma unroll
    for (int rr = 0; rr < 2; ++rr) { const size_t off = ((size_t)(m0 + l0 + rr) * MW + col) * 2;
        u32x4 o; o.x = pk2(qy[rr][0], qy[rr][1]); o.y = pk2(qy[rr][2], qy[rr][3]); o.z = pk2(qy[rr][4], qy[rr][5]); o.w = pk2(qy[rr][6], qy[rr][7]); *(u32x4*)(ws + WS_QC + off) = o;
        u32x4 k2; k2.x = pk2(ky[rr][0], ky[rr][1]); k2.y = pk2(ky[rr][2], ky[rr][3]); k2.z = pk2(ky[rr][4], ky[rr][5]); k2.w = pk2(ky[rr][6], ky[rr][7]); *(u32x4*)(ws + WS_KC + off) = k2; }
    __syncthreads();
    {
        const float w0 = wl[l0], w1 = wl[l0 + 1];
        const int pv = vt_pos(l0);
#pragma unroll
        for (int j = 0; j < 8; ++j) { const int e = cg8 * 8 + j;
            const float v0 = (j & 1) ? bfhi(vr[0][j >> 1]) : bflo(vr[0][j >> 1]), v1 = (j & 1) ? bfhi(vr[1][j >> 1]) : bflo(vr[1][j >> 1]);
            *(LAS unsigned*)(lds + PA_KT + e * 144 + l0 * 2) = pk2(ky[0][j], ky[1][j]);
            *(LAS unsigned*)(lds + PA_VW + e * 144 + l0 * 2) = pk2(v0 * w0, v1 * w1);
            *(LAS unsigned*)(lds + PA_VT + e * 128 + pv * 2) = pk2(v0, v1); }
    }
    __syncthreads();
    {
        const int fr = lane & 15, fq = lane >> 4;
        f32x4 acc[8];
#pragma unroll
        for (int et = 0; et < 8; ++et) acc[et] = (f32x4){0.f, 0.f, 0.f, 0.f};
#pragma unroll
        for (int ks = 0; ks < 2; ++ks) { const bf16x8 bfr = *(const LAS bf16x8*)(lds + PA_VW + (16 * wave + fr) * 144 + (32 * ks + 8 * fq) * 2);
#pragma unroll
            for (int et = 0; et < 8; ++et) { const bf16x8 afr = *(const LAS bf16x8*)(lds + PA_KT + (16 * et + fr) * 144 + (32 * ks + 8 * fq) * 2);
                acc[et] = __builtin_amdgcn_mfma_f32_16x16x32_bf16(afr, bfr, acc[et], 0, 0, 0); } }
        const int d = 16 * wave + fr;
#pragma unroll
        for (int et = 0; et < 8; ++et) { u32x2 o; o.x = pk2(acc[et][0], acc[et][1]); o.y = pk2(acc[et][2], acc[et][3]);
            *(u32x2*)(ws + WS_A0 + (((size_t)item * 128 + d) * 128 + 16 * et + 4 * fq) * 2) = o; }
    }
    if (tid < 128) { float s = 0.f;
#pragma unroll 8
        for (int l = 0; l < 64; ++l) s += wl[l] * bf2f(*(const LAS unsigned short*)(lds + PA_KT + tid * 144 + l * 2));
        ((float*)(ws + WS_NLOC))[(size_t)item * 128 + tid] = s; }
#pragma unroll
    for (int i = 0; i < 2; ++i) { const int idx = tid + 512 * i, row = idx >> 3, chk = idx & 7;
        *(u32x4*)(F.ob + DO_VT + ((size_t)item * 128 + row) * 128 + chk * 16) = *(const LAS u32x4*)(lds + PA_VT + row * 128 + chk * 16); }
    __syncthreads();
}
template <int W> __device__ __forceinline__ void pooled_item(const unsigned char* U, unsigned char* P, int m4, int c8) {
    const int t0 = m4 & (SEQ - 1);
    u32x4 rows[W + 3];
#pragma unroll
    for (int i = 0; i < W + 3; ++i) { const int dt = i - (W - 1);
        rows[i] = (t0 + dt >= 0) ? *(const u32x4*)(U + ((size_t)(m4 + dt) * PW + c8 * 8) * 2) : (u32x4){0u, 0u, 0u, 0u}; }
#pragma unroll
    for (int r = 0; r < 4; ++r) { float s[8];
#pragma unroll
        for (int j = 0; j < 8; ++j) s[j] = 0.f;
#pragma unroll
        for (int i = 0; i < W; ++i) { const u32x4 v = rows[r + i];
#pragma unroll
            for (int j = 0; j < 4; ++j) { s[2 * j] += bflo(v[j]); s[2 * j + 1] += bfhi(v[j]); } }
        const int n = (t0 + r + 1 < W) ? (t0 + r + 1) : W; const float inv = 1.0f / (float)n;
        const u32x4 cur = rows[r + W - 1]; u32x4 o;
#pragma unroll
        for (int j = 0; j < 4; ++j) o[j] = pk2(s[2 * j] * inv - bflo(cur[j]), s[2 * j + 1] * inv - bfhi(cur[j]));
        *(u32x4*)(P + ((size_t)(m4 + r) * PW + c8 * 8) * 2) = o; }
}
__device__ __forceinline__ void p2_pooled(Frame& F) {
    const int gt = F.bid * 512 + F.tid, NGT = F.G * 512;
    const unsigned char* U = F.ws + WS_U; unsigned char* P = F.ob + DO_POOLED;
    for (int i = gt; i < (M / 4) * 128; i += NGT) { const int m4 = (i >> 7) * 4, c8 = i & 127, g = c8 >> 5;
        if (g == 0) pooled_item<2>(U, P, m4, c8); else if (g == 1) pooled_item<4>(U, P, m4, c8); else if (g == 2) pooled_item<8>(U, P, m4, c8); else pooled_item<16>(U, P, m4, c8); }
}

__device__ __forceinline__ void p3_scan(Frame& F) {
    unsigned char* ws = F.ws;
    const int gt = F.bid * 512 + F.tid;
    const float* amaxp = (const float*)(ws + WS_SCAL); const float* btotp = amaxp + NITEM; float* mprev = (float*)(ws + WS_SCAL) + 2 * NITEM;
    for (int id = gt; id < 64 * 128 * 16; id += F.G * 512) {
        const int bh = id >> 11, d = (id >> 4) & 127, e8 = id & 15;
        float acc[8], nacc[8];
#pragma unroll
        for (int j = 0; j < 8; ++j) { acc[j] = 0.f; nacc[j] = 0.f; }
        float m = 0.f;
        const bool do_n = (d == 0);
        for (int cb = 0; cb < NCH; cb += 8) {
            u32x4 cl[8]; float am[8], bt[8]; f32x4 na[8], nb2[8];
#pragma unroll
            for (int k = 0; k < 8; ++k) { const int item = bh * 32 + cb + k;
                cl[k] = *(const u32x4*)(ws + WS_A0 + (((size_t)item * 128 + d) * 128 + e8 * 8) * 2); am[k] = amaxp[item]; bt[k] = btotp[item];
                if (do_n) { const float* nl = (const float*)(ws + WS_NLOC) + (size_t)item * 128 + e8 * 8; na[k] = *(const f32x4*)nl; nb2[k] = *(const f32x4*)(nl + 4); } }
#pragma unroll
            for (int k = 0; k < 8; ++k) { const int item = bh * 32 + cb + k;
                u32x4 o; o.x = pk2(acc[0], acc[1]); o.y = pk2(acc[2], acc[3]); o.z = pk2(acc[4], acc[5]); o.w = pk2(acc[6], acc[7]);
                *(u32x4*)(ws + WS_CPREV + (((size_t)item * 128 + d) * 128 + e8 * 8) * 2) = o;
                const float mn = fmaxf(bt[k] + m, am[k]), dec = __expf(bt[k] + m - mn), sc = __expf(am[k] - mn);
                if (do_n) { float* np = (float*)(ws + WS_NPREV) + (size_t)item * 128 + e8 * 8;
                    *(f32x4*)np = (f32x4){nacc[0], nacc[1], nacc[2], nacc[3]}; *(f32x4*)(np + 4) = (f32x4){nacc[4], nacc[5], nacc[6], nacc[7]};
#pragma unroll
                    for (int j = 0; j < 4; ++j) { nacc[j] = dec * nacc[j] + sc * na[k][j]; nacc[4 + j] = dec * nacc[4 + j] + sc * nb2[k][j]; }
                    if (e8 == 0) mprev[item] = m; }
#pragma unroll
                for (int j = 0; j < 4; ++j) { acc[2 * j] = dec * acc[2 * j] + sc * bflo(cl[k][j]); acc[2 * j + 1] = dec * acc[2 * j + 1] + sc * bfhi(cl[k][j]); }
                m = mn; }
        }
    }
}

__device__ __forceinline__ void p4_issue(const unsigned char* ws, const unsigned char* ob, int it0, int tid, u32x4 (&st)[16]) {
#pragma unroll
    for (int i = 0; i < 16; ++i) { const int item = it0 + (i >> 3), cid = (tid + 512 * i) & 4095;
        const int c = item & 31, bh = item >> 5, h = bh & 7, b = bh >> 3; const int m0 = b * SEQ + c * CH;
        const unsigned char* src;
        if ((i & 7) < 2) { const int r = cid >> 4, c16 = cid & 15; src = ws + WS_KC + ((size_t)(m0 + r) * MW + h * DH) * 2 + c16 * 16; }
        else if ((i & 7) < 6) { const int r = (cid - 1024) >> 4, c16 = cid & 15; src = ws + WS_CPREV + ((size_t)item * 128 + r) * 256 + c16 * 16; }
        else { const int r = (cid - 3072) >> 3, c8 = cid & 7; src = ob + DO_VT + ((size_t)item * 128 + r) * 128 + c8 * 16; }
        st[i] = *(const u32x4*)src; }
}
__device__ __forceinline__ void p4_write(LAS unsigned char* lds, int tid, const u32x4 (&st)[16]) {
#pragma unroll
    for (int i = 0; i < 16; ++i) { const int cid = (tid + 512 * i) & 4095; LAS unsigned char* base = lds + (i >> 3) * 65536; int off;
        if ((i & 7) < 2) { const int r = cid >> 4, c16 = cid & 15; off = r * 256 + ((c16 ^ (r & 15)) << 4); }
        else if ((i & 7) < 6) { const int r = (cid - 1024) >> 4, c16 = cid & 15; off = 16384 + r * 256 + ((c16 ^ (r & 15)) << 4); }
        else { const int r = (cid - 3072) >> 3, c8 = cid & 7; off = 49152 + r * 128 + ((c8 ^ ((r >> 1) & 7)) << 4); }
        *(LAS u32x4*)(base + off) = st[i]; }
}
__device__ __forceinline__ void p4_compute(Frame& F, int item, int rb, const LAS unsigned char* L) {
    unsigned char* ws = F.ws;
    const int lane = F.lane, fr = lane & 15, fq = lane >> 4;
    const int c = item & 31, bh = item >> 5, h = bh & 7, b = bh >> 3;
    const int m0 = b * SEQ + c * CH;
    const float* gates = (const float*)(ws + WS_GATES);
    const float li = gates[(size_t)(m0 + lane) * 16 + h], lf = logsigm(gates[(size_t)(m0 + lane) * 16 + 8 + h]);
    float bs = lf;
#pragma unroll
    for (int o = 1; o < 64; o <<= 1) { const float t = __shfl_up(bs, o); if (lane >= o) bs += t; }
    const float gg = li - bs;
    float pmx = gg;
#pragma unroll
    for (int o = 1; o < 64; o <<= 1) { const float t = __shfl_up(pmx, o); if (lane >= o) pmx = fmaxf(pmx, t); }
    const float m_prev = ((const float*)(ws + WS_SCAL))[2 * NITEM + item];
    const float pm = fmaxf(m_prev, pmx);
    const int l = 16 * rb + fr;
    const float b_l = __shfl(bs, l), pm_l = __shfl(pm, l);
    const float inter_w = __expf(m_prev - pm_l);
    bf16x8 qf[4];
#pragma unroll
    for (int ks = 0; ks < 4; ++ks) qf[ks] = *(const bf16x8*)(ws + WS_QC + ((size_t)(m0 + l) * MW + h * DH + 32 * ks + 8 * fq) * 2);
    f32x4 T[4];
#pragma unroll
    for (int jt = 0; jt < 4; ++jt) { T[jt] = (f32x4){0.f, 0.f, 0.f, 0.f};
        if (jt <= rb) {
#pragma unroll
            for (int ks = 0; ks < 4; ++ks) { const int r = 16 * jt + fr; const bf16x8 kf = *(const LAS bf16x8*)(L + r * 256 + (((4 * ks + fq) ^ (r & 15)) << 4));
                T[jt] = __builtin_amdgcn_mfma_f32_16x16x32_bf16(kf, qf[ks], T[jt], 0, 0, 0); } } }
    float rowsum = 0.f;
#pragma unroll
    for (int jt = 0; jt < 4; ++jt)
#pragma unroll
        for (int r = 0; r < 4; ++r) { const int j = 16 * jt + 4 * fq + r; const float gj = __shfl(gg, j);
            const float wgt = (j <= l) ? __expf(gj - pm_l) : 0.f; const float sv = T[jt][r] * wgt; T[jt][r] = sv; rowsum += sv; }
    bf16x8 pf[2];
#pragma unroll
    for (int s2 = 0; s2 < 2; ++s2) { u32x4 w; w.x = pk2(T[2 * s2][0], T[2 * s2][1]); w.y = pk2(T[2 * s2][2], T[2 * s2][3]); w.z = pk2(T[2 * s2 + 1][0], T[2 * s2 + 1][1]); w.w = pk2(T[2 * s2 + 1][2], T[2 * s2 + 1][3]);
        pf[s2] = __builtin_bit_cast(bf16x8, w); }
    float nq = 0.f;
#pragma unroll
    for (int ks = 0; ks < 4; ++ks) { const float* np = (const float*)(ws + WS_NPREV) + (size_t)item * 128 + 32 * ks + 8 * fq; const f32x4 a = *(const f32x4*)np, b2 = *(const f32x4*)(np + 4);
        const u32x4 qw = __builtin_bit_cast(u32x4, qf[ks]);
        nq += a[0] * bflo(qw[0]) + a[1] * bfhi(qw[0]) + a[2] * bflo(qw[1]) + a[3] * bfhi(qw[1]) + b2[0] * bflo(qw[2]) + b2[1] * bfhi(qw[2]) + b2[2] * bflo(qw[3]) + b2[3] * bfhi(qw[3]); }
    nq += __shfl_xor(nq, 16); nq += __shfl_xor(nq, 32);
    rowsum += __shfl_xor(rowsum, 16); rowsum += __shfl_xor(rowsum, 32);
    const float den = inter_w * nq + rowsum;
    const float inv = 1.0f / fmaxf(fabsf(den), __expf(-(b_l + pm_l)));
    f32x4 acc[8]; float ss = 0.f;
#pragma unroll
    for (int dt = 0; dt < 8; ++dt) { acc[dt] = (f32x4){0.f, 0.f, 0.f, 0.f}; const int r = 16 * dt + fr;
#pragma unroll
        for (int ks = 0; ks < 4; ++ks) { const bf16x8 cf = *(const LAS bf16x8*)(L + 16384 + r * 256 + (((4 * ks + fq) ^ (r & 15)) << 4));
            acc[dt] = __builtin_amdgcn_mfma_f32_16x16x32_bf16(cf, qf[ks], acc[dt], 0, 0, 0); }
        acc[dt] = acc[dt] * inter_w;
#pragma unroll
        for (int s2 = 0; s2 < 2; ++s2) { if (s2 == 0 || rb >= 2) { const bf16x8 vf = *(const LAS bf16x8*)(L + 49152 + r * 128 + (((4 * s2 + fq) ^ ((r >> 1) & 7)) << 4));
                acc[dt] = __builtin_amdgcn_mfma_f32_16x16x32_bf16(vf, pf[s2], acc[dt], 0, 0, 0); } }
        acc[dt] = acc[dt] * inv;
        ss += (acc[dt][0] * acc[dt][0] + acc[dt][1] * acc[dt][1]) + (acc[dt][2] * acc[dt][2] + acc[dt][3] * acc[dt][3]); }
    ss += __shfl_xor(ss, 16); ss += __shfl_xor(ss, 32);
    const float rn = rsqrtf(ss * (1.0f / DH) + EPS);
#pragma unroll
    for (int dt = 0; dt < 8; ++dt) { const int d0 = 16 * dt + 4 * fq;
        const u32x2 ow = *(const u32x2*)(ws + WS_O + ((size_t)(m0 + l) * MW + h * DH + d0) * 2);
        const f32x4 gm = *(const f32x4*)(F.g_mlstm + h * DH + d0);
        const float o0 = sigm(bflo(ow.x)) * acc[dt][0] * rn * gm[0], o1 = sigm(bfhi(ow.x)) * acc[dt][1] * rn * gm[1];
        const float o2 = sigm(bflo(ow.y)) * acc[dt][2] * rn * gm[2], o3 = sigm(bfhi(ow.y)) * acc[dt][3] * rn * gm[3];
        u32x2 o; o.x = pk2(o0, o1); o.y = pk2(o2, o3);
        *(u32x2*)(F.ob + DO_MIX + ((size_t)(m0 + l) * DM + h * DH + d0) * 2) = o; }
}
__device__ __forceinline__ void p4_phase(Frame& F) {
    const int npair = NITEM / 2;
    u32x4 st[16];
    int pr = F.bid * 4;
    for (int blk = F.bid; blk * 4 < npair; blk += F.G) {
        pr = blk * 4;
        p4_issue(F.ws, F.ob, 2 * pr, F.tid, st);
        for (int k = 0; k < 4; ++k) {
            __syncthreads();
            p4_write(F.lds, F.tid, st);
            if (k < 3) p4_issue(F.ws, F.ob, 2 * (pr + k + 1), F.tid, st);
            __syncthreads();
            p4_compute(F, 2 * (pr + k) + (F.wave >> 2), F.wave & 3, F.lds + (F.wave >> 2) * 65536);
        }
    }
    __syncthreads();
}

template <bool BASE_BF16>
__device__ __forceinline__ void row_resnorm(Frame& F, const void* base, const unsigned char* y, const float* g1, const float* g2, unsigned char* hout, unsigned char* nout) {
    const int gw = F.bid * 8 + F.wave, NGW = F.G * 8, lane = F.lane;
    constexpr int NB = BASE_BF16 ? 4 : 8;
    f32x4 ga[8], gb[8];
#pragma unroll
    for (int j = 0; j < 4; ++j) { const size_t co = 512 * j + 8 * lane; ga[2 * j] = *(const f32x4*)(g1 + co); ga[2 * j + 1] = *(const f32x4*)(g1 + co + 4); gb[2 * j] = *(const f32x4*)(g2 + co); gb[2 * j + 1] = *(const f32x4*)(g2 + co + 4); }
    u32x4 ny[4], nb[NB];
    int m = gw;
#define ROW_LOAD(mm) do { _Pragma("unroll") for (int j = 0; j < 4; ++j) { const size_t co = (size_t)(mm) * DM + 512 * j + 8 * lane; ny[j] = *(const u32x4*)(y + co * 2); \
        if (BASE_BF16) nb[j] = *(const u32x4*)((const unsigned char*)base + co * 2); \
        else { nb[(2 * j) % NB] = *(const u32x4*)((const unsigned char*)base + co * 4); nb[(2 * j + 1) % NB] = *(const u32x4*)((const unsigned char*)base + co * 4 + 16); } } } while (0)
    if (m < M) ROW_LOAD(m);
    for (; m < M; m += NGW) {
        float v[32], bv[32]; float s = 0.f;
#pragma unroll
        for (int j = 0; j < 4; ++j) {
#pragma unroll
            for (int q = 0; q < 4; ++q) { v[8 * j + 2 * q] = bflo(ny[j][q]); v[8 * j + 2 * q + 1] = bfhi(ny[j][q]); }
            if (BASE_BF16) {
#pragma unroll
                for (int q = 0; q < 4; ++q) { bv[8 * j + 2 * q] = bflo(nb[j][q]); bv[8 * j + 2 * q + 1] = bfhi(nb[j][q]); } }
            else {
#pragma unroll
                for (int q = 0; q < 4; ++q) { bv[8 * j + q] = __uint_as_float(nb[(2 * j) % NB][q]); bv[8 * j + 4 + q] = __uint_as_float(nb[(2 * j + 1) % NB][q]); } } }
        if (m + NGW < M) ROW_LOAD(m + NGW);
#pragma unroll
        for (int i = 0; i < 32; ++i) s += v[i] * v[i];
        const float r1 = rsqrtf(wave_sum(s) * (1.0f / DM) + EPS);
        float s2 = 0.f;
#pragma unroll
        for (int j = 0; j < 4; ++j) { const size_t co = 512 * j + 8 * lane;
#pragma unroll
            for (int q = 0; q < 4; ++q) { v[8 * j + q] = bv[8 * j + q] + v[8 * j + q] * r1 * ga[2 * j][q]; v[8 * j + 4 + q] = bv[8 * j + 4 + q] + v[8 * j + 4 + q] * r1 * ga[2 * j + 1][q]; }
            u32x4 o; o.x = pk2(v[8 * j], v[8 * j + 1]); o.y = pk2(v[8 * j + 2], v[8 * j + 3]); o.z = pk2(v[8 * j + 4], v[8 * j + 5]); o.w = pk2(v[8 * j + 6], v[8 * j + 7]);
            *(u32x4*)(hout + ((size_t)m * DM + co) * 2) = o; }
#pragma unroll
        for (int i = 0; i < 32; ++i) s2 += v[i] * v[i];
        const float r2 = rsqrtf(wave_sum(s2) * (1.0f / DM) + EPS);
#pragma unroll
        for (int j = 0; j < 4; ++j) { const size_t co = 512 * j + 8 * lane;
            u32x4 o; o.x = pk2(v[8 * j] * r2 * gb[2 * j][0], v[8 * j + 1] * r2 * gb[2 * j][1]); o.y = pk2(v[8 * j + 2] * r2 * gb[2 * j][2], v[8 * j + 3] * r2 * gb[2 * j][3]);
            o.z = pk2(v[8 * j + 4] * r2 * gb[2 * j + 1][0], v[8 * j + 5] * r2 * gb[2 * j + 1][1]); o.w = pk2(v[8 * j + 6] * r2 * gb[2 * j + 1][2], v[8 * j + 7] * r2 * gb[2 * j + 1][3]);
            *(u32x4*)(nout + ((size_t)m * DM + co) * 2) = o; }
    }
#undef ROW_LOAD
}
__device__ __forceinline__ void row_final(Frame& F, const unsigned char* base, const unsigned char* y, const float* g, float* out) {
    const int gw = F.bid * 8 + F.wave, NGW = F.G * 8, lane = F.lane;
    f32x4 ga[8];
#pragma unroll
    for (int j = 0; j < 4; ++j) { const size_t co = 512 * j + 8 * lane; ga[2 * j] = *(const f32x4*)(g + co); ga[2 * j + 1] = *(const f32x4*)(g + co + 4); }
    u32x4 ny[4], nb[4];
    int m = gw;
#define ROW_LOAD(mm) do { _Pragma("unroll") for (int j = 0; j < 4; ++j) { const size_t co = (size_t)(mm) * DM + 512 * j + 8 * lane; ny[j] = *(const u32x4*)(y + co * 2); nb[j] = *(const u32x4*)(base + co * 2); } } while (0)
    if (m < M) ROW_LOAD(m);
    for (; m < M; m += NGW) {
        float v[32], bv[32]; float s = 0.f;
#pragma unroll
        for (int j = 0; j < 4; ++j)
#pragma unroll
            for (int q = 0; q < 4; ++q) { v[8 * j + 2 * q] = bflo(ny[j][q]); v[8 * j + 2 * q + 1] = bfhi(ny[j][q]); bv[8 * j + 2 * q] = bflo(nb[j][q]); bv[8 * j + 2 * q + 1] = bfhi(nb[j][q]); }
        if (m + NGW < M) ROW_LOAD(m + NGW);
#pragma unroll
        for (int i = 0; i < 32; ++i) s += v[i] * v[i];
        const float r1 = rsqrtf(wave_sum(s) * (1.0f / DM) + EPS);
#pragma unroll
        for (int j = 0; j < 4; ++j) { const size_t co = 512 * j + 8 * lane; f32x4 o0, o1;
#pragma unroll
            for (int q = 0; q < 4; ++q) { o0[q] = bv[8 * j + q] + v[8 * j + q] * r1 * ga[2 * j][q]; o1[q] = bv[8 * j + 4 + q] + v[8 * j + 4 + q] * r1 * ga[2 * j + 1][q]; }
            *(f32x4*)(out + (size_t)m * DM + co) = o0; *(f32x4*)(out + (size_t)m * DM + co + 4) = o1; }
    }
#undef ROW_LOAD
}

constexpr int NPHASE = 12;
__global__ void __launch_bounds__(512, 2) fwd_mega(const Args args) {
    extern __shared__ __attribute__((aligned(16))) unsigned char lds_raw[];
    {
        const int t0 = threadIdx.x;
        for (int u = t0; u < (LDS_BYTES - 131072) / 4; u += 512) ((LAS unsigned*)((LAS unsigned char*)lds_raw + 131072))[u] = 0u;
    }
    __syncthreads();
    const int lo = args.ph_lo, hi = args.ph_hi;
#define IN(k) (lo <= (k) && (k) < hi)
#define BARSETUP() XcdBarrier bar; bar.bar = (unsigned*)(args.ws + WS_CTL) + 4096; bar.x = xb_xcc_id(); bar.st = (volatile LAS unsigned*)((LAS unsigned char*)lds_raw + MISC_OFF) + 8;
#define SEAM(k) do { if (IN(k) && IN((k) + 1)) { BARSETUP(); for (int rb_ = 0; rb_ < REP_BAR; ++rb_) xcd_barrier(bar); } } while (0)
    if (hi - lo > 1) { if (threadIdx.x == 0) (void)xb_add((unsigned*)(args.ws + WS_CTL) + 4096 + XB_XCNT(xb_xcc_id()), 1u); }

    if (IN(0)) { MK_FRAME(F); F.x = args.in[0]; F.p = args.in[1]; F.w_in = args.in[2]; F.b_gates = args.in[3]; F.w_pool = args.in[6]; F.w_out = args.in[8]; F.g_mix_pre = args.in[9];
        F.w_ff1 = args.in[11]; F.w_ff2 = args.in[12]; F.w_ple_proj = args.in[15]; F.w_ple_gate = args.in[16];
        for (int rep_ = 0; rep_ < REP_P0; ++rep_) { p0_prologue(F); __syncthreads(); } } SEAM(0);
    if (IN(1)) {
        unsigned char* ws = args.ws;
        pg8::Gemm g{(const bf16*)(ws + WS_A0), (const bf16*)(ws + WS_WIN), DM, DM, DM, 0}; pg8::StaticOrder S; S.init(M, NIN, gridDim.x, blockIdx.x);
        pg8::EpiBf16<0> E{(bf16*)(ws + WS_Q), MW, nullptr, 1024, (size_t)(WS_K - WS_Q) / 2};
        for (int rep_ = 0; rep_ < GEMM_REP; ++rep_) pg8::gemm_phase((LAS unsigned char*)lds_raw, g, S, E);
    } SEAM(1);
    if (IN(2)) { MK_FRAME(F); F.w_conv = args.in[4];
        for (int rep_ = 0; rep_ < REP_P2I; ++rep_)
        for (int it = F.bid; it < NITEM; it += F.G) p2_item(F, it);
        for (int rep_ = 0; rep_ < REP_MIX; ++rep_) p2_pooled(F);
    } SEAM(2);
    if (IN(3)) { for (int rep_ = 0; rep_ < REP_P3; ++rep_) {
        {
            unsigned char* ws = args.ws; unsigned char* ob = (unsigned char*)args.out;
            pg8::Gemm g{(const bf16*)(ob + DO_POOLED), (const bf16*)(ws + WS_WPOOL), PW, 256, 256, 256}; pg8::StaticOrder S; S.init(M, PW, gridDim.x, blockIdx.x);
            pg8::EpiBf16<0> E{(bf16*)(ob + DO_MIX) + 1024, DM, args.in[7], 0, 0};
            pg8::gemm_phase((LAS unsigned char*)lds_raw, g, S, E);
        }
        { MK_FRAME(F); p3_scan(F); } }
    } SEAM(3);
    if (IN(4)) { MK_FRAME(F); F.g_mlstm = args.in[5];
        for (int rep_ = 0; rep_ < REP_P4; ++rep_) p4_phase(F);
    } SEAM(4);
    if (IN(5)) {
        unsigned char* ws = args.ws; unsigned char* ob = (unsigned char*)args.out;
        pg8::Gemm g{(const bf16*)(ob + DO_MIX), (const bf16*)(ws + WS_WOUT), DM, DM, DM, 0}; pg8::StaticOrder S; S.init(M, DM, gridDim.x, blockIdx.x);
        pg8::EpiBf16<0> E{(bf16*)(ws + WS_A0), DM, nullptr, 0, 0};
        for (int rep_ = 0; rep_ < GEMM_REP; ++rep_) pg8::gemm_phase((LAS unsigned char*)lds_raw, g, S, E);
    } SEAM(5);
    if (IN(6)) { MK_FRAME(F); for (int rep_ = 0; rep_ < REP_ROW; ++rep_) row_resnorm<false>(F, args.in[0], F.ws + WS_A0, args.in[10], args.in[13], F.ob + DO_H1B, F.ws + WS_HN); } SEAM(6);
    if (IN(7)) {
        unsigned char* ws = args.ws;
        pg8::Gemm g{(const bf16*)(ws + WS_HN), (const bf16*)(ws + WS_WFF1), DM, DM, DM, 0}; pg8::StaticOrder S; S.init(M, DFF, gridDim.x, blockIdx.x);
        pg8::EpiBf16<1> E{(bf16*)(ws + WS_HB), DFF, nullptr, 0, 0};
        for (int rep_ = 0; rep_ < REP_FF1; ++rep_) pg8::gemm_phase((LAS unsigned char*)lds_raw, g, S, E);
    } SEAM(7);
    if (IN(8)) {
        unsigned char* ws = args.ws;
        pg8::Gemm g{(const bf16*)(ws + WS_HB), (const bf16*)(ws + WS_WFF2), DFF, DFF, DFF, 0}; pg8::StaticOrder S; S.init(M, DM, gridDim.x, blockIdx.x);
        pg8::EpiBf16<0> E{(bf16*)(ws + WS_A0), DM, nullptr, 0, 0};
        for (int rep_ = 0; rep_ < REP_FF2; ++rep_) pg8::gemm_phase((LAS unsigned char*)lds_raw, g, S, E);
    } SEAM(8);
    if (IN(9)) { MK_FRAME(F); row_resnorm<true>(F, F.ob + DO_H1B, F.ws + WS_A0, args.in[14], args.in[17], F.ws + WS_H2B, F.ws + WS_HN); } SEAM(9);
    if (IN(10)) {
        unsigned char* ws = args.ws;
        {   pg8::Gemm g{(const bf16*)(ws + WS_PB), (const bf16*)(ws + WS_WPP), PD, PD, PD, 0}; pg8::StaticOrder S; S.init(M, DM, gridDim.x, blockIdx.x);
            pg8::EpiBf16<0> E{(bf16*)(ws + WS_E), DM, nullptr, 0, 0};
            for (int rep_ = 0; rep_ < GEMM_REP; ++rep_) pg8::gemm_phase((LAS unsigned char*)lds_raw, g, S, E); }
        asm volatile("s_waitcnt vmcnt(0)" ::: "memory"); __syncthreads();
        {   pg8::Gemm g{(const bf16*)(ws + WS_HN), (const bf16*)(ws + WS_WPG), DM, DM, DM, 0}; pg8::StaticOrder S; S.init(M, DM, gridDim.x, blockIdx.x);
            pg8::EpiGateMul E{(const bf16*)(ws + WS_E), (bf16*)(ws + WS_A0), DM};
            for (int rep_ = 0; rep_ < GEMM_REP; ++rep_) pg8::gemm_phase((LAS unsigned char*)lds_raw, g, S, E); }
    } SEAM(10);
    if (IN(11)) { MK_FRAME(F); row_final(F, F.ws + WS_H2B, F.ws + WS_A0, args.in[18], F.out); }
    if (lo < 0) cg::this_grid().sync();
#undef IN
#undef SEAM
#undef BARSETUP
}


#ifdef DBG_STOP
struct DbgBuf { const void* p; size_t n; int is_f32; int bit; };
__global__ void __launch_bounds__(512) dbg_scan(DbgBuf b0, DbgBuf b1, DbgBuf b2, DbgBuf b3, DbgBuf b4, DbgBuf b5, unsigned* flag) {
    DbgBuf bs[6] = {b0, b1, b2, b3, b4, b5};
    unsigned mask = 0u;
    for (int k = 0; k < 6; ++k) { const DbgBuf b = bs[k]; if (!b.p) continue; bool bad = false;
        for (size_t i = (size_t)blockIdx.x * 512 + threadIdx.x; i < b.n; i += (size_t)gridDim.x * 512) {
            const float v = b.is_f32 ? ((const float*)b.p)[i] : __uint_as_float(((unsigned)((const unsigned short*)b.p)[i]) << 16);
            if (!(fabsf(v) < 1e30f)) bad = true; }
        if (bad) mask |= 1u << b.bit; }
    if (mask) atomicOr(flag, mask);
}
__global__ void __launch_bounds__(512) dbg_write(float* out, size_t n, const unsigned* flag) {
    for (size_t i = (size_t)blockIdx.x * 512 + threadIdx.x; i < n; i += (size_t)gridDim.x * 512) out[i] = (i == 0) ? 1000.0f * (float)(*flag) : 0.f;
}
#endif
extern "C" void kernel_launch(void* const* d_in, const int* in_sizes, int n_in, void* d_out, int out_size, void* d_ws, size_t ws_size, hipStream_t stream) {
    static int grid = 0;
    if (grid == 0) {
        if (n_in != 19 || out_size != M * DM || ws_size < WS_END) { fprintf(stderr, "kernel_launch: unexpected shapes (n_in %d, out %d, ws %zu)\n", n_in, out_size, ws_size); grid = -1; return; }
        int dev = 0, cus = 0, per_cu = 0;
        if (hipGetDevice(&dev) != hipSuccess || hipDeviceGetAttribute(&cus, hipDeviceAttributeMultiprocessorCount, dev) != hipSuccess) { grid = -1; return; }
        if (hipFuncSetAttribute((const void*)fwd_mega, hipFuncAttributeMaxDynamicSharedMemorySize, LDS_BYTES) != hipSuccess) { fprintf(stderr, "kernel_launch: hipFuncSetAttribute failed\n"); grid = -1; return; }
        if (hipOccupancyMaxActiveBlocksPerMultiprocessor(&per_cu, (const void*)fwd_mega, 512, LDS_BYTES) != hipSuccess || per_cu < 1) { fprintf(stderr, "kernel_launch: occupancy query failed (%d)\n", per_cu); (void)hipGetLastError(); per_cu = 1; }
        grid = cus * (per_cu < 1 ? 1 : per_cu);
        if (grid > 256) grid = 256;
        fprintf(stderr, "kernel_launch: %d CUs, %d blocks/CU by the occupancy query, grid %d\n", cus, per_cu, grid);
    }
    if (grid < 0) return;
    (void)hipMemsetAsync((char*)d_ws + WS_CTL, 0, CTL_BYTES, stream);
    Args a{};
    for (int i = 0; i < 19; ++i) a.in[i] = (const float*)d_in[i];
    a.out = (float*)d_out; a.ws = (unsigned char*)d_ws;
#if N_LAUNCH_MODE == 1
    a.ph_lo = 0; a.ph_hi = NPHASE;
    void* kargs[] = {&a};
    hipError_t e = hipLaunchCooperativeKernel((const void*)fwd_mega, dim3(grid), dim3(512), kargs, LDS_BYTES, stream);
    if (e != hipSuccess) fprintf(stderr, "kernel_launch: cooperative launch failed: %s (grid %d)\n", hipGetErrorString(e), grid);
#else
#ifdef DBG_STOP
    for (int ph = 0; ph < DBG_STOP; ++ph) { a.ph_lo = ph; a.ph_hi = ph + 1; hipLaunchKernelGGL(fwd_mega, dim3(grid), dim3(512), LDS_BYTES, stream, a); }
    { unsigned char* ws = (unsigned char*)d_ws; unsigned char* ob = (unsigned char*)d_out; unsigned* flag = (unsigned*)(ws + WS_CTL) + 100000;
      DBG_BUFS
      hipLaunchKernelGGL(dbg_scan, dim3(1024), dim3(512), 0, stream, B0, B1, B2, B3, B4, B5, flag);
      hipLaunchKernelGGL(dbg_write, dim3(1024), dim3(512), 0, stream, (float*)d_out, (size_t)M * DM, (const unsigned*)flag); }
#else
    for (int ph = 0; ph < NPHASE; ++ph) { a.ph_lo = ph; a.ph_hi = ph + 1; hipLaunchKernelGGL(fwd_mega, dim3(grid), dim3(512), LDS_BYTES, stream, a); }
#endif
#endif
}
```

```cpp
#include <hip/hip_runtime.h>
#include <hip/hip_cooperative_groups.h>
#include <cstdio>
#include <cstdint>
namespace cg = cooperative_groups;

#ifndef GEMM_REP
#define GEMM_REP 1
#endif
#ifndef REP_P0
#define REP_P0 1
#endif
#ifndef REP_P0A
#define REP_P0A 1
#endif
#ifndef REP_P0D
#define REP_P0D 1
#endif
#ifndef REP_P2I
#define REP_P2I 1
#endif
#ifndef REP_P3
#define REP_P3 1
#endif
#ifndef REP_P4
#define REP_P4 1
#endif
#ifndef REP_FF1
#define REP_FF1 1
#endif
#ifndef REP_FF2
#define REP_FF2 1
#endif
#ifndef REP_BAR
#define REP_BAR 1
#endif
#ifndef DBG_TS
#define DBG_TS -1
#endif
#ifndef DBG_SCALE
#define DBG_SCALE 2.5e-4f
#endif
#ifndef WGM_P1
#define WGM_P1 4
#endif
#ifndef WGM_P5
#define WGM_P5 4
#endif
#ifndef WGM_P7
#define WGM_P7 4
#endif
#ifndef WGM_P8
#define WGM_P8 4
#endif
#ifndef WGM_P10
#define WGM_P10 4
#endif
#ifndef STAG_NS
#define STAG_NS 0
#endif
#ifndef STAG_DIV
#define STAG_DIV 8
#endif
#ifndef NT_LOADS
#define NT_LOADS 1
#endif
#ifndef NT_MORE
#define NT_MORE 1
#endif
#ifndef REP_MIX
#define REP_MIX 1
#endif
#ifndef REP_ROW
#define REP_ROW 1
#endif
#ifndef NT_P2OUT
#define NT_P2OUT 0
#endif
#ifndef N_LAUNCH_MODE
#define N_LAUNCH_MODE 1
#endif

__device__ __forceinline__ int hw_tid(int wv) { return (wv << 6) | (int)__builtin_amdgcn_mbcnt_hi(~0u, __builtin_amdgcn_mbcnt_lo(~0u, 0u)); }

namespace pg8 {
#define PG8_LAS __attribute__((address_space(3)))
typedef unsigned short bf16_t;
typedef short bf16x8 __attribute__((ext_vector_type(8)));
typedef float f32x4 __attribute__((ext_vector_type(4)));
typedef unsigned u32x4 __attribute__((ext_vector_type(4)));
typedef unsigned u32x2 __attribute__((ext_vector_type(2)));
typedef int i32x4 __attribute__((ext_vector_type(4)));
template <bool I8> struct AccT { typedef f32x4 type; };
template <> struct AccT<true> { typedef i32x4 type; };
constexpr int BM = 256, BK = 64, HALF = 128, HTB = HALF * BK * 2, STAGE_BYTES = 8 * HTB, NXCD = 8;

__host__ __device__ __forceinline__ int lds_byte(int r, int c) { const int st = (r >> 4) * 2 + (c >> 5), rr = r & 15, cc = c & 31, ob = rr * 64 + cc * 2; return st * 1024 + (ob ^ (((ob >> 9) & 1) << 5)); }
__host__ __device__ __forceinline__ void stage_rc(int b, int& R, int& C) { const int st = b / 1024, sb = b % 1024, swz = sb ^ (((sb >> 9) & 1) << 5); R = (st >> 1) * 16 + swz / 64; C = (st & 1) * 32 + (swz % 64) / 2; }
__host__ __device__ __forceinline__ int perm32(int rho) { const int n = rho >> 4, i = rho & 15; return 8 * (i >> 2) + 4 * n + (i & 3); }

struct Unit { int pm, pn; };
struct Gemm { const void* A; const void* Bt; int lda, ldb, K, a_pn_off; };

struct StaticOrder {
    int nM, nN, nwg, G, c, WGM, rev;
    __host__ __device__ void init(int M, int N, int G_, int c_, int wgm = 4, int rev_ = 0) { nM = M / BM; nN = N / BM; nwg = nM * nN; G = G_; c = c_; WGM = wgm; rev = rev_; }
    __host__ __device__ bool next(int i, Unit& u) const {
        const long L = (long)i * G + c; if (L >= nwg) return false;
        int wgid = (int)L; { const int q = nwg / NXCD, r = nwg % NXCD, xcd = wgid % NXCD, off = wgid / NXCD; wgid = (xcd < r ? xcd * (q + 1) : r * (q + 1) + (xcd - r) * q) + off; }
        const int nig = WGM * nN, gid = wgid / nig, fm = gid * WGM, gsz = (nM - fm) < WGM ? (nM - fm) : WGM;
        u.pm = fm + ((wgid % nig) % gsz); u.pn = (wgid % nig) / gsz; if (rev) u.pm = nM - 1 - u.pm; return true;
    }
};

__device__ __forceinline__ unsigned cvt_pk_bf16(float lo, float hi) { unsigned r; asm volatile("v_cvt_pk_bf16_f32 %0, %1, %2" : "=v"(r) : "v"(lo), "v"(hi)); return r; }

template <int ACT  > struct EpiBf16 {
    static constexpr bool PERM = true;
    bf16_t* O; int ldc; const float* cscale; int split_cols; size_t split_stride; const float* rscale;
    __device__ __forceinline__ void operator()(const f32x4 (&acc)[2][2][4][2], const Unit& u, int wr, int wc, int fr, int fq) const {
        const int row0 = u.pm * BM + wr * 64 + fr; int colt = u.pn * BM; bf16_t* base = O;
        if (split_cols) { const int t = colt / split_cols; base += (size_t)t * split_stride; colt -= t * split_cols; }
        const int col0 = colt + wc * 32 + 8 * fq, bcol0 = u.pn * BM + wc * 32 + 8 * fq;
        f32x4 sv[2][2];
#pragma unroll
        for (int bj = 0; bj < 2; ++bj)
#pragma unroll
            for (int n = 0; n < 2; ++n) sv[bj][n] = cscale ? *(const f32x4*)(cscale + bcol0 + bj * HALF + 4 * n) : (f32x4){1.f, 1.f, 1.f, 1.f};
#pragma unroll
        for (int ai = 0; ai < 2; ++ai)
#pragma unroll
            for (int m = 0; m < 4; ++m) { bf16_t* rowp = base + (size_t)(row0 + ai * HALF + m * 16) * ldc + col0; const float rs = rscale ? rscale[row0 + ai * HALF + m * 16] : 1.0f;
#pragma unroll
                for (int bj = 0; bj < 2; ++bj) { f32x4 v0 = acc[ai][bj][m][0] * rs, v1 = acc[ai][bj][m][1] * rs;
                    if (ACT == 1) {
#pragma unroll
                        for (int j = 0; j < 4; ++j) { const float a = fmaxf(v0[j], 0.f), b = fmaxf(v1[j], 0.f); v0[j] = a * a; v1[j] = b * b; } }
                    v0 = v0 * sv[bj][0]; v1 = v1 * sv[bj][1];
                    u32x4 w; w.x = cvt_pk_bf16(v0[0], v0[1]); w.y = cvt_pk_bf16(v0[2], v0[3]); w.z = cvt_pk_bf16(v1[0], v1[1]); w.w = cvt_pk_bf16(v1[2], v1[3]);
                    *(u32x4*)(rowp + bj * HALF) = w; } }
    }
};
struct EpiF32 {
    static constexpr bool PERM = false;
    float* C; int ldc;
    __device__ __forceinline__ void operator()(const f32x4 (&acc)[2][2][4][2], const Unit& u, int wr, int wc, int fr, int fq) const {
        const int row0 = u.pm * BM + wr * 64 + fr, col0 = u.pn * BM + wc * 32 + 4 * fq;
#pragma unroll
        for (int ai = 0; ai < 2; ++ai)
#pragma unroll
            for (int m = 0; m < 4; ++m) { float* rowp = C + (size_t)(row0 + ai * HALF + m * 16) * ldc + col0;
#pragma unroll
                for (int bj = 0; bj < 2; ++bj)
#pragma unroll
                    for (int n = 0; n < 2; ++n) *(f32x4*)(rowp + bj * HALF + n * 16) = acc[ai][bj][m][n]; }
    }
};
struct EpiGateMul {
    static constexpr bool PERM = true;
    const bf16_t* E; bf16_t* O; int ldc; const float* rscale;
    __device__ __forceinline__ void operator()(const f32x4 (&acc)[2][2][4][2], const Unit& u, int wr, int wc, int fr, int fq) const {
        const int row0 = u.pm * BM + wr * 64 + fr, col0 = u.pn * BM + wc * 32 + 8 * fq;
#pragma unroll
        for (int ai = 0; ai < 2; ++ai)
#pragma unroll
            for (int m = 0; m < 4; ++m) { const size_t ro = (size_t)(row0 + ai * HALF + m * 16) * ldc + col0; const float rs = rscale[row0 + ai * HALF + m * 16];
#pragma unroll
                for (int bj = 0; bj < 2; ++bj) { const u32x4 e = *(const u32x4*)(E + ro + bj * HALF); const f32x4 a0 = acc[ai][bj][m][0] * rs, a1 = acc[ai][bj][m][1] * rs; float o[8];
#pragma unroll
                    for (int j = 0; j < 2; ++j) { o[2 * j] = __uint_as_float(e[j] << 16) * __builtin_amdgcn_rcpf(1.0f + __expf(-a0[2 * j])); o[2 * j + 1] = __uint_as_float(e[j] & 0xffff0000u) * __builtin_amdgcn_rcpf(1.0f + __expf(-a0[2 * j + 1]));
                        o[4 + 2 * j] = __uint_as_float(e[2 + j] << 16) * __builtin_amdgcn_rcpf(1.0f + __expf(-a1[2 * j])); o[4 + 2 * j + 1] = __uint_as_float(e[2 + j] & 0xffff0000u) * __builtin_amdgcn_rcpf(1.0f + __expf(-a1[2 * j + 1])); }
                    u32x4 w; w.x = cvt_pk_bf16(o[0], o[1]); w.y = cvt_pk_bf16(o[2], o[3]); w.z = cvt_pk_bf16(o[4], o[5]); w.w = cvt_pk_bf16(o[6], o[7]);
                    *(u32x4*)(O + ro + bj * HALF) = w; } }
    }
};

struct EpiI8Relu2 {
    static constexpr bool PERM = true;
    bf16_t* O; int ldc; const float* rowf; const float* colmax;
    __device__ __forceinline__ void operator()(const i32x4 (&acc)[2][2][4][2], const Unit& u, int wr, int wc, int fr, int fq) const {
        const int row0 = u.pm * BM + wr * 64 + fr, col0 = u.pn * BM + wc * 32 + 8 * fq;
        f32x4 cf[2][2];
#pragma unroll
        for (int bj = 0; bj < 2; ++bj)
#pragma unroll
            for (int n = 0; n < 2; ++n) cf[bj][n] = *(const f32x4*)(colmax + col0 + bj * HALF + 4 * n) * (1.0f / 127.0f);
#pragma unroll
        for (int ai = 0; ai < 2; ++ai)
#pragma unroll
            for (int m = 0; m < 4; ++m) { bf16_t* rowp = O + (size_t)(row0 + ai * HALF + m * 16) * ldc + col0; const float rs = rowf[row0 + ai * HALF + m * 16];
#pragma unroll
                for (int bj = 0; bj < 2; ++bj) { float o[8];
#pragma unroll
                    for (int j = 0; j < 4; ++j) { const float a = fmaxf((float)acc[ai][bj][m][0][j] * rs * cf[bj][0][j], 0.f), b = fmaxf((float)acc[ai][bj][m][1][j] * rs * cf[bj][1][j], 0.f); o[j] = a * a; o[4 + j] = b * b; }
                    u32x4 w; w.x = cvt_pk_bf16(o[0], o[1]); w.y = cvt_pk_bf16(o[2], o[3]); w.z = cvt_pk_bf16(o[4], o[5]); w.w = cvt_pk_bf16(o[6], o[7]);
                    *(u32x4*)(rowp + bj * HALF) = w; } }
    }
};

struct EpiI8GateMul {
    static constexpr bool PERM = true;
    const bf16_t* E; bf16_t* O; int ldc; const float* rowf; const float* colmax;
    __device__ __forceinline__ void operator()(const i32x4 (&acc)[2][2][4][2], const Unit& u, int wr, int wc, int fr, int fq) const {
        const int row0 = u.pm * BM + wr * 64 + fr, col0 = u.pn * BM + wc * 32 + 8 * fq;
        f32x4 cf[2][2];
#pragma unroll
        for (int bj = 0; bj < 2; ++bj)
#pragma unroll
            for (int n = 0; n < 2; ++n) cf[bj][n] = *(const f32x4*)(colmax + col0 + bj * HALF + 4 * n) * (1.0f / 127.0f);
#pragma unroll
        for (int ai = 0; ai < 2; ++ai)
#pragma unroll
            for (int m = 0; m < 4; ++m) { const size_t ro = (size_t)(row0 + ai * HALF + m * 16) * ldc + col0; const float rs = rowf[row0 + ai * HALF + m * 16];
#pragma unroll
                for (int bj = 0; bj < 2; ++bj) { const u32x4 e = *(const u32x4*)(E + ro + bj * HALF); float o[8];
#pragma unroll
                    for (int j = 0; j < 2; ++j) {
                        const float g0 = (float)acc[ai][bj][m][0][2 * j] * rs * cf[bj][0][2 * j], g1 = (float)acc[ai][bj][m][0][2 * j + 1] * rs * cf[bj][0][2 * j + 1];
                        const float g2 = (float)acc[ai][bj][m][1][2 * j] * rs * cf[bj][1][2 * j], g3 = (float)acc[ai][bj][m][1][2 * j + 1] * rs * cf[bj][1][2 * j + 1];
                        o[2 * j] = __uint_as_float(e[j] << 16) * __builtin_amdgcn_rcpf(1.0f + __expf(-g0)); o[2 * j + 1] = __uint_as_float(e[j] & 0xffff0000u) * __builtin_amdgcn_rcpf(1.0f + __expf(-g1));
                        o[4 + 2 * j] = __uint_as_float(e[2 + j] << 16) * __builtin_amdgcn_rcpf(1.0f + __expf(-g2)); o[4 + 2 * j + 1] = __uint_as_float(e[2 + j] & 0xffff0000u) * __builtin_amdgcn_rcpf(1.0f + __expf(-g3)); }
                    u32x4 w; w.x = cvt_pk_bf16(o[0], o[1]); w.y = cvt_pk_bf16(o[2], o[3]); w.z = cvt_pk_bf16(o[4], o[5]); w.w = cvt_pk_bf16(o[6], o[7]);
                    *(u32x4*)(O + ro + bj * HALF) = w; } }
    }
};

template <class Epi, class Sched, bool I8 = false>
__device__ __forceinline__ void gemm_phase(PG8_LAS unsigned char* lds, const Gemm g, const Sched& S, const Epi& E, int wv) {
    constexpr int ES = I8 ? 1 : 2; typedef typename AccT<I8>::type acc_t;
    int tid_ = hw_tid(wv); asm volatile("" : "+v"(tid_));
    const int tid = tid_, wid = __builtin_amdgcn_readfirstlane(tid >> 6), lane = tid & 63, wr = wid >> 2, wc = wid & 3, fr = lane & 15, fq = lane >> 4;
    const int nt = g.K * ES / (BK * 2);
    unsigned voffA[2], voffB[2];
#pragma unroll
    for (int i = 0; i < 2; ++i) { int R, C; stage_rc(tid * 16 + i * 8192, R, C); const int Rb = Epi::PERM ? ((R & ~31) + perm32(R & 31)) : R;
        voffA[i] = (unsigned)(R * g.lda * ES + C * 2); voffB[i] = (unsigned)(Rb * g.ldb * ES + C * 2); }
    const size_t kstep = (size_t)(BK * 2);
    const size_t hA = (size_t)HALF * g.lda * ES, hB = (size_t)HALF * g.ldb * ES;
    const size_t tA = 2 * hA, tB = 2 * hB;
    const size_t pnA = (size_t)g.a_pn_off * ES;
    const unsigned ldsw = (unsigned)wid * 1024u;
    const int aoff = lds_byte(wr * 64 + fr, fq * 8), boff = lds_byte(wc * 32 + fr, fq * 8);
#define PG8_SA(b, h) (((b) * 2 + (h)) * HTB)
#define PG8_SB(b, h) ((4 + (b) * 2 + (h)) * HTB)
#define PG8_STAGE(bufoff, gbase, voff) do { _Pragma("unroll") for (int _i = 0; _i < 2; ++_i) \
        __builtin_amdgcn_global_load_lds((const unsigned*)((const char*)(gbase) + (voff)[_i]), (PG8_LAS unsigned*)(lds + (bufoff) + ldsw + _i * 8192), 16, 0, 0); } while (0)
#define PG8_LDA(dst, b, h) do { _Pragma("unroll") for (int m = 0; m < 4; ++m) _Pragma("unroll") for (int k = 0; k < 2; ++k) dst[m][k] = *(const PG8_LAS bf16x8*)(lds + PG8_SA(b, h) + aoff + m * 2048 + k * 1024); } while (0)
#define PG8_LDB(dst, b, h) do { _Pragma("unroll") for (int n = 0; n < 2; ++n) _Pragma("unroll") for (int k = 0; k < 2; ++k) dst[n][k] = *(const PG8_LAS bf16x8*)(lds + PG8_SB(b, h) + boff + n * 2048 + k * 1024); } while (0)
#define PG8_MMA(ai, bj, At, Bt) do { __builtin_amdgcn_s_setprio(1); _Pragma("unroll") for (int m = 0; m < 4; ++m) _Pragma("unroll") for (int n = 0; n < 2; ++n) _Pragma("unroll") for (int k = 0; k < 2; ++k) \
        { if constexpr (I8) acc[ai][bj][m][n] = __builtin_amdgcn_mfma_i32_16x16x64_i8(__builtin_bit_cast(i32x4, Bt[n][k]), __builtin_bit_cast(i32x4, At[m][k]), acc[ai][bj][m][n], 0, 0, 0); \
          else acc[ai][bj][m][n] = __builtin_amdgcn_mfma_f32_16x16x32_bf16(Bt[n][k], At[m][k], acc[ai][bj][m][n], 0, 0, 0); } __builtin_amdgcn_s_setprio(0); } while (0)
#define PG8_WAIT_V(n) asm volatile("s_waitcnt vmcnt(" #n ")" ::: "memory")
#define PG8_WAIT_L(n) asm volatile("s_waitcnt lgkmcnt(" #n ")" ::: "memory")
#define PG8_BAR __builtin_amdgcn_s_barrier()
#define PG8_SCHED __builtin_amdgcn_sched_barrier(0)
    Unit cur, nxt; int ui = 0;
    if (!S.next(0, cur)) return;
    if (STAG_NS > 0) { const unsigned long long t0 = __builtin_amdgcn_s_memrealtime(); const unsigned long long dl = (unsigned long long)((blockIdx.x / STAG_DIV) % 8) * STAG_NS / 10;
        while (__builtin_amdgcn_s_memrealtime() - t0 < dl) __builtin_amdgcn_s_sleep(2); }
    acc_t acc[2][2][4][2];
#pragma unroll
    for (int a = 0; a < 2; ++a)
#pragma unroll
        for (int b = 0; b < 2; ++b)
#pragma unroll
            for (int m = 0; m < 4; ++m)
#pragma unroll
                for (int n = 0; n < 2; ++n) acc[a][b][m][n] = (acc_t){0, 0, 0, 0};
    bf16x8 At[4][2], B0[2][2], B1[2][2];
    const char* cA = (const char*)g.A + (size_t)cur.pm * tA + (size_t)cur.pn * pnA; const char* cB = (const char*)g.Bt + (size_t)cur.pn * tB;
    PG8_STAGE(PG8_SB(0, 0), cB, voffB); PG8_STAGE(PG8_SB(0, 1), cB + hB, voffB); PG8_STAGE(PG8_SA(0, 0), cA, voffA); PG8_STAGE(PG8_SA(0, 1), cA + hA, voffA);
    if (wr == 1) PG8_BAR;
    PG8_WAIT_V(2); PG8_BAR;
    PG8_STAGE(PG8_SB(1, 0), cB + kstep, voffB); PG8_STAGE(PG8_SA(1, 0), cA + kstep, voffA); PG8_STAGE(PG8_SB(1, 1), cB + hB + kstep, voffB);
    PG8_WAIT_V(6); PG8_BAR;
    for (;;) {
        const bool has_next = S.next(ui + 1, nxt);
        const char* nA = has_next ? (const char*)g.A + (size_t)nxt.pm * tA + (size_t)nxt.pn * pnA : cA; const char* nB = has_next ? (const char*)g.Bt + (size_t)nxt.pn * tB : cB;
        for (int t = 0; t < nt; t += 2) {
            const bool last = (t == nt - 2);
            const char* a1 = cA + (size_t)(t + 1) * kstep;
            const char* a2 = last ? nA : cA + (size_t)(t + 2) * kstep; const char* b2 = last ? nB : cB + (size_t)(t + 2) * kstep;
            const char* a3 = a2 + kstep; const char* b3 = b2 + kstep;
            PG8_LDB(B0, 0, 0); PG8_LDB(B1, 0, 1); PG8_SCHED; PG8_LDA(At, 0, 0); PG8_STAGE(PG8_SA(1, 1), a1 + hA, voffA);
            PG8_WAIT_V(8); PG8_WAIT_L(0); PG8_BAR; PG8_MMA(0, 0, At, B0); PG8_MMA(0, 1, At, B1); PG8_BAR; PG8_SCHED;
            PG8_LDA(At, 0, 1); PG8_STAGE(PG8_SB(0, 0), b2, voffB); PG8_STAGE(PG8_SB(0, 1), b2 + hB, voffB); PG8_STAGE(PG8_SA(0, 0), a2, voffA);
            PG8_WAIT_V(8); PG8_WAIT_L(0); PG8_BAR; PG8_MMA(1, 0, At, B0); PG8_MMA(1, 1, At, B1); PG8_BAR; PG8_SCHED;
            PG8_LDB(B0, 1, 0); PG8_LDB(B1, 1, 1); PG8_SCHED; PG8_LDA(At, 1, 0); PG8_STAGE(PG8_SA(0, 1), a2 + hA, voffA);
            PG8_WAIT_V(8); PG8_WAIT_L(0); PG8_BAR; PG8_MMA(0, 0, At, B0); PG8_MMA(0, 1, At, B1); PG8_BAR; PG8_SCHED;
            PG8_LDA(At, 1, 1); PG8_STAGE(PG8_SB(1, 0), b3, voffB); PG8_STAGE(PG8_SB(1, 1), b3 + hB, voffB); PG8_STAGE(PG8_SA(1, 0), a3, voffA);
            PG8_WAIT_V(8); PG8_WAIT_L(0); PG8_BAR; PG8_MMA(1, 0, At, B0); PG8_MMA(1, 1, At, B1); PG8_BAR; PG8_SCHED;
        }
        if (wr == 0) PG8_BAR;
        E(acc, cur, wr, wc, fr, fq);
        if (!has_next) break;
#pragma unroll
        for (int a = 0; a < 2; ++a)
#pragma unroll
            for (int b = 0; b < 2; ++b)
#pragma unroll
                for (int m = 0; m < 4; ++m)
#pragma unroll
                    for (int n = 0; n < 2; ++n) acc[a][b][m][n] = (acc_t){0, 0, 0, 0};
        cur = nxt; cA = nA; cB = nB; ++ui;
        if (wr == 1) PG8_BAR;
    }
    PG8_WAIT_V(0);
    PG8_BAR;
#undef PG8_SA
#undef PG8_SB
#undef PG8_STAGE
#undef PG8_LDA
#undef PG8_LDB
#undef PG8_MMA
#undef PG8_WAIT_V
#undef PG8_WAIT_L
#undef PG8_BAR
#undef PG8_SCHED
}
}

constexpr int NB = 8, SEQ = 2048, DM = 2048, PD = 256, NH = 8, DH = 128, MW = 1024, PW = 1024, DFF = 8192, CH = 64, NCH = 32;
constexpr int M = NB * SEQ;
constexpr int INC = 5136, NIN = 5120;
constexpr int C_GATE = 4096, C_U = 4112;
constexpr int NITEM = NB * NH * NCH;
constexpr float EPS = 1e-6f;
constexpr size_t MiB = 1u << 20;
constexpr size_t WS_CTL = 0, CTL_BYTES = 256 * 1024;
constexpr size_t WS_WIN = 2 * MiB, WS_WOUT = 22 * MiB, WS_WFF1 = 30 * MiB, WS_WFF2 = 62 * MiB, WS_WPG = 94 * MiB, WS_WPP = 102 * MiB, WS_WPOOL = 103 * MiB;
constexpr size_t WS_GATES = 104 * MiB, WS_NLOC = 105 * MiB, WS_NPREV = 106 * MiB, WS_SCAL = 107 * MiB, WS_PB = 108 * MiB;
constexpr size_t WS_QK0 = 107 * MiB + 896 * 1024;
constexpr size_t WS_RS0 = 107 * MiB + 768 * 1024;
constexpr size_t WS_XB = 436 * MiB;
constexpr size_t WS_RS1 = 107 * MiB + 256 * 1024, WS_RS2 = 107 * MiB + 512 * 1024;
constexpr size_t WS_A0 = 116 * MiB;
constexpr size_t WS_Q = 180 * MiB, WS_K = 212 * MiB, WS_V = 244 * MiB, WS_O = 276 * MiB, WS_U = 308 * MiB;
constexpr size_t WS_CPREV = 180 * MiB;
constexpr size_t WS_QC = 340 * MiB, WS_KC = 372 * MiB;
constexpr size_t WS_HB = 180 * MiB;
constexpr size_t WS_E = 180 * MiB;
constexpr size_t WS_HN = 436 * MiB;
constexpr size_t WS_END = 500 * MiB;
constexpr size_t DO_MIX = 0, DO_POOLED = 64 * MiB, DO_VT = 96 * MiB;
constexpr size_t WS_H2Q = 372 * MiB;
constexpr size_t DO_H1Q = 64 * MiB;
constexpr size_t CTL_CM1 = 131072, CTL_CM2 = 196608;
constexpr size_t DO_H1B = 0;
constexpr size_t WS_H2B = 308 * MiB;
constexpr size_t WS_TOT = 404 * MiB;
constexpr size_t WS_NTOT = WS_TOT + 8 * MiB;
constexpr size_t WS_GB = WS_TOT + 9 * MiB;
constexpr int P4X_N = 131072 + 4096, P4X_M = P4X_N + 4096, P4X_A = P4X_M + 32, P4X_B = P4X_M + 64;
constexpr int LDS_BYTES = 147456;
constexpr int MISC_OFF = 131072 + 320;

typedef unsigned short bf16;
typedef short bf16x8 __attribute__((ext_vector_type(8)));
typedef float f32x4 __attribute__((ext_vector_type(4)));
typedef unsigned u32x4 __attribute__((ext_vector_type(4)));
typedef unsigned u32x2 __attribute__((ext_vector_type(2)));
#define LAS __attribute__((address_space(3)))
#define LDS_WAIT() asm volatile("s_waitcnt lgkmcnt(0)" ::: "memory")

template <class T> __device__ __forceinline__ T ld_once(const T* p) {
#if NT_MORE
    return __builtin_nontemporal_load(p);
#else
    return *p;
#endif
}
template <class T> __device__ __forceinline__ T ld_stream(const T* p) {
#if NT_LOADS
    return __builtin_nontemporal_load(p);
#else
    return *p;
#endif
}
__device__ __forceinline__ float bf2f(unsigned short b) { return __uint_as_float(((unsigned)b) << 16); }
__device__ __forceinline__ float bflo(unsigned w) { return __uint_as_float(w << 16); }
__device__ __forceinline__ float bfhi(unsigned w) { return __uint_as_float(w & 0xffff0000u); }
typedef __bf16 bf16v2_t __attribute__((ext_vector_type(2)));
typedef float f32v2_t __attribute__((ext_vector_type(2)));
__device__ __forceinline__ unsigned pk2(float lo, float hi) { const bf16v2_t r = __builtin_convertvector((f32v2_t){lo, hi}, bf16v2_t); return __builtin_bit_cast(unsigned, r); }
__device__ __forceinline__ float wave_sum(float v) {
#pragma unroll
    for (int o = 1; o < 64; o <<= 1) v += __shfl_xor(v, o);
    return v;
}
__device__ __forceinline__ float wave_max(float v) {
#pragma unroll
    for (int o = 1; o < 64; o <<= 1) v = fmaxf(v, __shfl_xor(v, o));
    return v;
}
__device__ __forceinline__ float frcp(float x) { return __builtin_amdgcn_rcpf(x); }
__device__ __forceinline__ float sigm(float x) { return frcp(1.0f + __expf(-x)); }
__device__ __forceinline__ float logsigm(float x) { return fminf(x, 0.f) - log1pf(__expf(-fabsf(x))); }

#define XB_TMO      128
#define XB_XCNT(j)  (256  + 64 * (j))
#define XB_XSUB(j)  (1280 + 64 * (j))
#define XB_XGEN(j)  (2304 + 64 * (j))
#define XB_TOP      3328
#define XB_TOPGEN   3392
#define XCD_BAR_WORDS 3456
#define XB_SPIN_CAP (1u << 18)
__device__ __forceinline__ unsigned xb_ld(unsigned* p)              { return __hip_atomic_load(p, __ATOMIC_RELAXED, __HIP_MEMORY_SCOPE_AGENT); }
__device__ __forceinline__ unsigned xb_add(unsigned* p, unsigned v) { return __hip_atomic_fetch_add(p, v, __ATOMIC_RELAXED, __HIP_MEMORY_SCOPE_AGENT); }
__device__ __forceinline__ unsigned xb_xcc_id() { return (unsigned)__builtin_amdgcn_s_getreg((3 << 11) | 20) & 0xFu; }
#define XB_SPIN(cond, bar) do { unsigned _sp = 0; while (cond) { __builtin_amdgcn_s_sleep(1); \
    if ((++_sp & 255u) == 0u) { if (xb_ld(&(bar)[XB_TMO])) break; if (_sp > XB_SPIN_CAP) { atomicAdd(&(bar)[XB_TMO], 1u); break; } } } } while (0)
struct XcdBarrier { unsigned* bar; unsigned x; volatile LAS unsigned* st; int wv; };
__device__ __forceinline__ XcdBarrier xcd_barrier_post(unsigned* bar, volatile LAS unsigned* st) {
    XcdBarrier b; b.bar = bar; b.x = xb_xcc_id(); b.st = st;
    if (threadIdx.x == 0) (void)xb_add(&bar[XB_XCNT(b.x)], 1u);
    return b;
}
__device__ __forceinline__ void xcd_barrier_complete(unsigned* bar, unsigned x, unsigned& nloc, unsigned& nx) {
    const unsigned G = gridDim.x * gridDim.y * gridDim.z;
    unsigned sum, cnt, mine, sp = 0u;
    for (;;) {
        sum = 0u; cnt = 0u; mine = 0u;
#pragma unroll
        for (unsigned j = 0; j < 16; ++j) { const unsigned c = xb_ld(&bar[XB_XCNT(j)]); sum += c; cnt += (c > 0u) ? 1u : 0u; mine = (j == x) ? c : mine; }
        if (sum == G) break;
        __builtin_amdgcn_s_sleep(1);
        if ((++sp & 255u) == 0u) { if (xb_ld(&bar[XB_TMO])) break; if (sp > XB_SPIN_CAP) { atomicAdd(&bar[XB_TMO], 1u); break; } }
    }
    nloc = mine > 0u ? mine : 1u; nx = cnt > 0u ? cnt : 1u;
}
__device__ __forceinline__ void xcd_barrier(const XcdBarrier& b) {
    asm volatile("s_waitcnt vmcnt(0)" ::: "memory");
    __syncthreads();
    if (hw_tid(b.wv) == 0) {
        unsigned* bar = b.bar;
        __builtin_amdgcn_s_waitcnt(0);
        unsigned nloc = b.st[0], nx = b.st[1];
        if (nloc == 0u) { xcd_barrier_complete(bar, b.x, nloc, nx); b.st[0] = nloc; b.st[1] = nx; }
        const unsigned old = xb_add(&bar[XB_XSUB(b.x)], 1u);
        const unsigned gen = old / nloc;
        if (old + 1u == (gen + 1u) * nloc) {
            __builtin_amdgcn_fence(__ATOMIC_RELEASE, "agent");
            asm volatile("s_waitcnt vmcnt(0)" ::: "memory");
            const unsigned og = xb_add(&bar[XB_TOP], 1u);
            const unsigned tg = og / nx;
            if (og + 1u == (tg + 1u) * nx) xb_add(&bar[XB_TOPGEN], 1u);
            else XB_SPIN(xb_ld(&bar[XB_TOPGEN]) == tg, bar);
            __builtin_amdgcn_fence(__ATOMIC_ACQUIRE, "agent");
            xb_add(&bar[XB_XGEN(b.x)], 1u);
            asm volatile("s_waitcnt vmcnt(0)" ::: "memory");
        } else {
            XB_SPIN(xb_ld(&bar[XB_XGEN(b.x)]) == gen, bar);
            __builtin_amdgcn_fence(__ATOMIC_ACQUIRE, "agent");
            asm volatile("s_waitcnt vmcnt(0)" ::: "memory");
        }
    }
    __syncthreads();
}

struct Args { const float* in[19]; float* out; unsigned char* ws; int ph_lo, ph_hi; };
struct Frame {
    LAS unsigned char* lds;
    int tid, lane, wave, G, bid;
    const float *x, *p, *w_in, *b_gates, *w_conv, *g_mlstm, *w_pool, *pool_scale, *w_out, *g_mix_pre, *g_mix_post, *w_ff1, *w_ff2, *g_ff_pre, *g_ff_post, *w_ple_proj, *w_ple_gate, *g_ple_gate, *g_ple_post;
    float* out; unsigned char* ws; unsigned char* ob;
};
#define MK_FRAME(F) Frame F; { int t_ = hw_tid(wv_); asm volatile("" : "+v"(t_)); F.lds = (LAS unsigned char*)lds_raw; F.tid = t_; F.lane = t_ & 63; F.wave = __builtin_amdgcn_readfirstlane(t_ >> 6); F.G = gridDim.x; F.bid = blockIdx.x; \
    F.out = args.out; F.ws = args.ws; F.ob = (unsigned char*)args.out; }

struct TrItem { const float* src; bf16* dst; const float* gk; int ldw, ldt; unsigned* cm; };
__device__ __forceinline__ bool tr_decode(const Frame& F, int hi, int lane, TrItem& t) {
    constexpr int I0 = 32 * 64, I1 = 32 * 16, I2 = 32 * 32, I3 = 0  , I4 = 128 * 32, I5 = 32 * 32, I6 = 4 * 32, I7 = 0  ;
    constexpr int NIT = I0 + I1 + I2 + I3 + I4 + I5 + I6 + I7;
    const int it = hi >> 1, half = hi & 1;
    if (it >= NIT) return false;
    unsigned char* ws = F.ws; int r = it; const float* W; int ldw, ns0, ldt, nd0, kb, nb; bf16* WT; const float* gk = nullptr; unsigned* cmb = nullptr;
    if (r < I0) { W = F.w_in; ldw = INC; ns0 = 0; WT = (bf16*)(ws + WS_WIN); ldt = DM; nd0 = 0; kb = r / 64; nb = r % 64; gk = F.g_mix_pre; }
    else if ((r -= I0) < I1) { W = F.w_in; ldw = INC; ns0 = C_U; WT = (bf16*)(ws + WS_WIN); ldt = DM; nd0 = 4096; kb = r / 16; nb = r % 16; gk = F.g_mix_pre; }
    else if ((r -= I1) < I2) { W = F.w_out; ldw = DM; ns0 = 0; WT = (bf16*)(ws + WS_WOUT); ldt = DM; nd0 = 0; kb = r / 32; nb = r % 32; }
    else if ((r -= I2) < I3) { W = F.w_ff1; ldw = DFF; ns0 = 0; WT = (bf16*)(ws + WS_WFF1); ldt = DM; nd0 = 0; kb = r / 128; nb = r % 128; gk = F.g_ff_pre; cmb = (unsigned*)(ws + WS_CTL + CTL_CM1); }
    else if ((r -= I3) < I4) { W = F.w_ff2; ldw = DM; ns0 = 0; WT = (bf16*)(ws + WS_WFF2); ldt = DFF; nd0 = 0; kb = r / 32; nb = r % 32; }
    else if ((r -= I4) < I5) { W = F.w_ple_gate; ldw = DM; ns0 = 0; WT = (bf16*)(ws + WS_WPG); ldt = DM; nd0 = 0; kb = r / 32; nb = r % 32; gk = F.g_ple_gate; cmb = (unsigned*)(ws + WS_CTL + CTL_CM2); }
    else if ((r -= I5) < I6) { W = F.w_ple_proj; ldw = DM; ns0 = 0; WT = (bf16*)(ws + WS_WPP); ldt = PD; nd0 = 0; kb = r / 32; nb = r % 32; }
    else { r -= I6; const int g = r / 16, rr = r % 16; W = F.w_pool + (size_t)g * 256 * 256; ldw = 256; ns0 = 0; WT = (bf16*)(ws + WS_WPOOL); ldt = 256; nd0 = g * 256; kb = rr / 4; nb = rr % 4; }
    const int k0 = 64 * kb, n4 = lane & 7, lr = lane >> 3, nh = 64 * nb + 32 * half;
    t.src = W + (size_t)(k0 + 8 * lr) * ldw + ns0 + nh + 4 * n4; t.dst = WT + (size_t)(nd0 + nh + lr) * ldt + k0 + 8 * n4; t.ldw = ldw; t.ldt = ldt; t.gk = gk ? gk + k0 + 8 * lr : nullptr; t.cm = cmb ? cmb + nh + 4 * n4 : nullptr;
    return true;
}
__device__ __forceinline__ void tr_load(const TrItem& t, f32x4 (&v)[8]) {
#pragma unroll
    for (int i = 0; i < 8; ++i) v[i] = ld_stream((const f32x4*)(t.src + (size_t)i * t.ldw));
}
__device__ __forceinline__ void tr_store(const Frame& F, const TrItem& t, f32x4 (&v)[8]) {
    const int lane = F.lane;
    if (t.gk) { const f32x4 g0 = *(const f32x4*)t.gk, g1 = *(const f32x4*)(t.gk + 4);
#pragma unroll
        for (int i = 0; i < 4; ++i) { v[i] = v[i] * g0[i]; v[4 + i] = v[4 + i] * g1[i]; } }
    if (t.cm) { f32x4 m = (f32x4){0.f, 0.f, 0.f, 0.f};
#pragma unroll
        for (int i = 0; i < 8; ++i)
#pragma unroll
            for (int j = 0; j < 4; ++j) m[j] = fmaxf(m[j], fabsf(v[i][j]));
#pragma unroll
        for (int j = 0; j < 4; ++j) { m[j] = fmaxf(m[j], __shfl_xor(m[j], 8)); m[j] = fmaxf(m[j], __shfl_xor(m[j], 16)); m[j] = fmaxf(m[j], __shfl_xor(m[j], 32)); }
        if (lane < 8) {
#pragma unroll
            for (int j = 0; j < 4; ++j) atomicMax(t.cm + j, __float_as_uint(m[j])); }
        return; }
    LAS unsigned char* T = F.lds + F.wave * 4096;
    const int n4 = lane & 7, r = lane >> 3;
#pragma unroll
    for (int j = 0; j < 4; ++j) { u32x4 o; o.x = pk2(v[0][j], v[1][j]); o.y = pk2(v[2][j], v[3][j]); o.z = pk2(v[4][j], v[5][j]); o.w = pk2(v[6][j], v[7][j]);
        *(LAS u32x4*)(T + (4 * n4 + j) * 128 + ((r ^ n4) << 4)) = o; }
#pragma unroll
    for (int s2 = 0; s2 < 4; ++s2) { const int nl = 8 * s2 + r; const u32x4 o = *(const LAS u32x4*)(T + nl * 128 + ((n4 ^ ((nl >> 2) & 7)) << 4));
        *(u32x4*)(t.dst + (size_t)(8 * s2) * t.ldt) = o; }
}
__device__ __forceinline__ void p0_transposes(Frame& F, int gw, int NGW) {
    TrItem t0, t1, t2; f32x4 v0[8], v1[8], v2[8];
    int hi = gw;
    bool m0 = tr_decode(F, hi, F.lane, t0);
    if (!m0) return;
    tr_load(t0, v0);
    hi += NGW; bool m1 = tr_decode(F, hi, F.lane, t1);
    if (m1) tr_load(t1, v1);
    for (;;) {
        hi += NGW; bool m2 = tr_decode(F, hi, F.lane, t2);
        if (m2) tr_load(t2, v2);
        tr_store(F, t0, v0);
        if (!m1) break;
        hi += NGW; m0 = tr_decode(F, hi, F.lane, t0);
        if (m0) tr_load(t0, v0);
        tr_store(F, t1, v1);
        if (!m2) break;
        hi += NGW; m1 = tr_decode(F, hi, F.lane, t1);
        if (m1) tr_load(t1, v1);
        tr_store(F, t2, v2);
        if (!m0) break;
    }
}

__device__ __forceinline__ unsigned pack4_i8(float a, float b, float c, float d) {
    const int ia = (int)rintf(a), ib = (int)rintf(b), ic = (int)rintf(c), id = (int)rintf(d);
    return (unsigned)(ia & 255) | ((unsigned)(ib & 255) << 8) | ((unsigned)(ic & 255) << 16) | ((unsigned)(id & 255) << 24);
}
__device__ __forceinline__ void quant_weight(Frame& F, const float* W, int ldw, int K, int N, const float* gk, const float* cm, signed char* WQ) {
    const int gw = F.bid * 8 + F.wave, NGW = F.G * 8, lane = F.lane, nnb = N / 64, nit = (K / 32) * nnb;
    for (int it = gw; it < nit; it += NGW) { const int kb = it / nnb, nb = it % nnb, k0 = 32 * kb, n = 64 * nb + lane;
        const float cmax = cm[n], q = cmax > 0.f ? 127.0f / cmax : 0.f;
        float v[32];
#pragma unroll
        for (int i = 0; i < 32; ++i) v[i] = ld_stream(W + (size_t)(k0 + i) * ldw + n);
#pragma unroll
        for (int i = 0; i < 32; ++i) v[i] = v[i] * gk[k0 + i] * q;
#pragma unroll
        for (int j = 0; j < 2; ++j) { u32x4 o;
#pragma unroll
            for (int w = 0; w < 4; ++w) o[w] = pack4_i8(v[16 * j + 4 * w], v[16 * j + 4 * w + 1], v[16 * j + 4 * w + 2], v[16 * j + 4 * w + 3]);
            *(u32x4*)(WQ + (size_t)n * K + k0 + 16 * j) = o; } }
}

constexpr int QL_PM = 131072 + 1024, QL_CM = 131072 + 2048;
__device__ __forceinline__ void quant_ff1_local(Frame& F, const float* W, const float* gk, float* cmout, signed char* WQ) {
    const int lane = F.lane, wave = F.wave, n4 = lane & 7, r = lane >> 3;
    LAS unsigned char* T = F.lds;
    for (int cb = F.bid; cb < DFF / 32; cb += F.G) {
        const float* src = W + (size_t)(256 * wave + 8 * r) * DFF + 32 * cb + 4 * n4;
        const float* gp = gk + 256 * wave + 8 * r;
        f32x4 va[8], vb[8]; f32x4 mx = (f32x4){0.f, 0.f, 0.f, 0.f};
#define QL_LOAD(v, hk) do { _Pragma("unroll") for (int i = 0; i < 8; ++i) v[i] = ld_stream((const f32x4*)(src + (size_t)(64 * (hk) + i) * DFF)); } while (0)
#define QL_PUT(v, hk) do { const f32x4 g0 = *(const f32x4*)(gp + 64 * (hk)), g1 = *(const f32x4*)(gp + 64 * (hk) + 4); \
        _Pragma("unroll") for (int i = 0; i < 4; ++i) { v[i] = v[i] * g0[i]; v[4 + i] = v[4 + i] * g1[i]; } \
        _Pragma("unroll") for (int i = 0; i < 8; ++i) { _Pragma("unroll") for (int j = 0; j < 4; ++j) mx[j] = fmaxf(mx[j], fabsf(v[i][j])); } \
        const int ck = 32 * wave + 8 * (hk) + r; \
        _Pragma("unroll") for (int j = 0; j < 4; ++j) { u32x4 o; o.x = pk2(v[0][j], v[1][j]); o.y = pk2(v[2][j], v[3][j]); o.z = pk2(v[4][j], v[5][j]); o.w = pk2(v[6][j], v[7][j]); \
            *(LAS u32x4*)(T + (4 * n4 + j) * 4096 + ((ck ^ n4) << 4)) = o; } } while (0)
        QL_LOAD(va, 0); QL_LOAD(vb, 1);
        QL_PUT(va, 0); QL_LOAD(va, 2);
        QL_PUT(vb, 1); QL_LOAD(vb, 3);
        QL_PUT(va, 2); QL_PUT(vb, 3);
#undef QL_LOAD
#undef QL_PUT
#pragma unroll
        for (int j = 0; j < 4; ++j) { mx[j] = fmaxf(mx[j], __shfl_xor(mx[j], 8)); mx[j] = fmaxf(mx[j], __shfl_xor(mx[j], 16)); mx[j] = fmaxf(mx[j], __shfl_xor(mx[j], 32)); }
        if (lane < 8) *(LAS f32x4*)(T + QL_PM + (wave * 32 + 4 * n4) * 4) = mx;
        __syncthreads();
        if (F.tid < 32) { float m = 0.f;
#pragma unroll
            for (int w = 0; w < 8; ++w) m = fmaxf(m, *(const LAS float*)(T + QL_PM + (w * 32 + F.tid) * 4));
            cmout[32 * cb + F.tid] = m; *(LAS float*)(T + QL_CM + F.tid * 4) = m > 0.f ? 127.0f / m : 0.f; }
        __syncthreads();
#pragma unroll
        for (int jj = 0; jj < 4; ++jj) { const int n = 4 * wave + jj; const float q = *(const LAS float*)(T + QL_CM + n * 4);
#pragma unroll
            for (int it = 0; it < 2; ++it) { const int c0 = 128 * it + 2 * lane;
                const u32x4 a = *(const LAS u32x4*)(T + n * 4096 + ((c0 ^ (wave & 7)) << 4)), b = *(const LAS u32x4*)(T + n * 4096 + (((c0 + 1) ^ (wave & 7)) << 4));
                u32x4 o;
                o.x = pack4_i8(bflo(a.x) * q, bfhi(a.x) * q, bflo(a.y) * q, bfhi(a.y) * q); o.y = pack4_i8(bflo(a.z) * q, bfhi(a.z) * q, bflo(a.w) * q, bfhi(a.w) * q);
                o.z = pack4_i8(bflo(b.x) * q, bfhi(b.x) * q, bflo(b.y) * q, bfhi(b.y) * q); o.w = pack4_i8(bflo(b.z) * q, bfhi(b.z) * q, bflo(b.w) * q, bfhi(b.w) * q);
                *(u32x4*)(WQ + (size_t)(32 * cb + n) * DM + 8 * c0) = o; } }
        __syncthreads();
    }
}

__device__ __forceinline__ void p0_prologue(Frame& F) {
    const int gw = F.bid * 8 + F.wave, NGW = F.G * 8;
    unsigned char* ws = F.ws;
    for (int rep_ = 0; rep_ < REP_P0A; ++rep_) p0_transposes(F, gw, NGW);
    {
        const int gt = F.bid * 512 + F.tid, NGT = F.G * 512;
        for (int i = gt; i < M * PD / 8; i += NGT) { const f32x4 a = ld_stream((const f32x4*)(F.p + (size_t)i * 8)), b = ld_stream((const f32x4*)(F.p + (size_t)i * 8 + 4));
            u32x4 o; o.x = pk2(a[0], a[1]); o.y = pk2(a[2], a[3]); o.z = pk2(b[0], b[1]); o.w = pk2(b[2], b[3]); *(u32x4*)(ws + WS_PB + (size_t)i * 16) = o; }
    }
    {
        const int gt = F.bid * 512 + F.tid, NGT = F.G * 512;
        for (int i = gt; i < 4 * 256 * 256 / 8; i += NGT) { const int d8 = (i & 31) * 8, g = i >> 13;
            const f32x4 a = *(const f32x4*)(F.w_pool + (size_t)i * 8), b = *(const f32x4*)(F.w_pool + (size_t)i * 8 + 4);
            const f32x4 sa = *(const f32x4*)(F.pool_scale + 256 * g + d8), sb = *(const f32x4*)(F.pool_scale + 256 * g + d8 + 4);
            u32x4 o; o.x = pk2(a[0] * sa[0], a[1] * sa[1]); o.y = pk2(a[2] * sa[2], a[3] * sa[3]); o.z = pk2(b[0] * sb[0], b[1] * sb[1]); o.w = pk2(b[2] * sb[2], b[3] * sb[3]);
            *(u32x4*)(ws + WS_WPOOL + (size_t)i * 16) = o; }
    }
    __syncthreads();
    {
        LAS f32x4* wg = (LAS f32x4*)F.lds;
        for (int idx = F.tid; idx < 8192; idx += 512) { const int ln = idx & 63, c4 = (idx >> 6) & 3, i = (idx >> 8) & 3, jj = idx >> 10; const int k = 256 * jj + 4 * ln + i;
            wg[idx] = *(const f32x4*)(F.w_in + (size_t)k * INC + C_GATE + 4 * c4); }
    }
    __syncthreads();
    {
        const LAS f32x4* wg = (const LAS f32x4*)F.lds;
        const int lane = F.lane;
        f32x4 gq[8];
#pragma unroll
        for (int jj = 0; jj < 8; ++jj) gq[jj] = *(const f32x4*)(F.g_mix_pre + 256 * jj + 4 * lane);
        const float bgl = (lane < 16) ? F.b_gates[lane] : 0.f;
        for (int rep_ = 0; rep_ < REP_P0D; ++rep_) {
        f32x4 v[8], nx[8];
        int m = gw;
        if (m < M) {
#pragma unroll
            for (int jj = 0; jj < 8; ++jj) nx[jj] = ld_stream((const f32x4*)(F.x + (size_t)m * DM + 256 * jj + 4 * lane)); }
        for (; m < M; m += NGW) {
#pragma unroll
            for (int jj = 0; jj < 8; ++jj) v[jj] = nx[jj];
            if (m + NGW < M) {
#pragma unroll
                for (int jj = 0; jj < 8; ++jj) nx[jj] = ld_stream((const f32x4*)(F.x + (size_t)(m + NGW) * DM + 256 * jj + 4 * lane)); }
            float s = 0.f;
#pragma unroll
            for (int jj = 0; jj < 8; ++jj) s += (v[jj][0] * v[jj][0] + v[jj][1] * v[jj][1]) + (v[jj][2] * v[jj][2] + v[jj][3] * v[jj][3]);
            const float rs = rsqrtf(wave_sum(s) * (1.0f / DM) + EPS);
            f32x4 ga[4];
#pragma unroll
            for (int c4 = 0; c4 < 4; ++c4) ga[c4] = (f32x4){0.f, 0.f, 0.f, 0.f};
#pragma unroll
            for (int jj = 0; jj < 8; ++jj) {
                u32x2 o; o.x = pk2(v[jj][0], v[jj][1]); o.y = pk2(v[jj][2], v[jj][3]); *(u32x2*)(ws + WS_XB + ((size_t)m * DM + 256 * jj + 4 * lane) * 2) = o;
                v[jj] = v[jj] * rs * gq[jj];
#pragma unroll
                for (int i = 0; i < 4; ++i)
#pragma unroll
                    for (int c4 = 0; c4 < 4; ++c4) ga[c4] += wg[((jj * 4 + i) * 4 + c4) * 64 + lane] * v[jj][i];
                asm volatile("" ::: "memory"); }
            float res = 0.f;
#pragma unroll
            for (int c4 = 0; c4 < 4; ++c4)
#pragma unroll
                for (int j = 0; j < 4; ++j) { const float t = wave_sum(ga[c4][j]); if (lane == c4 * 4 + j) res = t; }
            if (lane < 16) ((float*)(ws + WS_GATES))[(size_t)m * 16 + lane] = res + bgl;
            if (lane == 0) ((float*)(ws + WS_RS0))[m] = rs;
        } }
    }
}

__device__ __forceinline__ void p0_first_tokens(Frame& F) {
    LAS float* red = (LAS float*)F.lds;
    const int tid = F.tid, colq = tid & 7, part = tid >> 3;
    for (int cb = F.bid; cb < 256; cb += F.G) {
        float acc[8];
#pragma unroll
        for (int r = 0; r < 8; ++r) acc[r] = 0.f;
#pragma unroll 4
        for (int k4 = 0; k4 < 8; ++k4) { const int k = 32 * part + 4 * k4;
            const f32x4 g = *(const f32x4*)(F.g_mix_pre + k);
            float w[4];
#pragma unroll
            for (int i = 0; i < 4; ++i) w[i] = F.w_in[(size_t)(k + i) * INC + 8 * cb + colq] * g[i];
#pragma unroll
            for (int r = 0; r < 8; ++r) { const f32x4 xv = *(const f32x4*)(F.x + (size_t)r * SEQ * DM + k); acc[r] += (xv[0] * w[0] + xv[1] * w[1]) + (xv[2] * w[2] + xv[3] * w[3]); } }
        __syncthreads();
#pragma unroll
        for (int r = 0; r < 8; ++r) red[(part * 8 + r) * 8 + colq] = acc[r];
        __syncthreads();
        if (tid < 64) { float s = 0.f;
#pragma unroll 8
            for (int p = 0; p < 64; ++p) s += red[p * 64 + tid];
            ((float*)(F.ws + WS_QK0))[(tid >> 3) * 2048 + 8 * cb + (tid & 7)] = s; }
    }
    __syncthreads();
}

constexpr int PA_KT = 0, PA_VW = 18432, PA_VT = 36864, PA_W = 53248;
__device__ __forceinline__ int p2swz(int row, int byteoff) { return (((byteoff >> 4) ^ ((row >> 3) & 7)) << 4) | (byteoff & 15); }
__device__ __forceinline__ int vt_pos(int j) { return (j & 32) | (((j >> 2) & 3) << 3) | (((j >> 4) & 1) << 2) | (j & 3); }
struct P2Regs { u32x4 qr[5], kr[5], vr[2]; float gi, gf; };
__device__ __forceinline__ void p2_issue(const unsigned char* ws, int item, int tid, int lane, int wave, P2Regs& R) {
    const int c = item & 31, bh = item >> 5, h = bh & 7, b = bh >> 3; const int m0 = b * SEQ + c * CH;
    const int cg8 = tid & 15, rp = tid >> 4, l0 = 2 * rp, col = h * DH + cg8 * 8;
#pragma unroll
    for (int i = 0; i < 5; ++i) { const int r = l0 - 3 + i; const bool ok = (c > 0) || (r >= 0);
        const unsigned off = (unsigned)(((m0 + r) * MW + col) * 2);
        R.qr[i] = ok ? *(const u32x4*)(ws + WS_Q + off) : (u32x4){0u, 0u, 0u, 0u};
        R.kr[i] = ok ? *(const u32x4*)(ws + WS_K + off) : (u32x4){0u, 0u, 0u, 0u}; }
#pragma unroll
    for (int i = 0; i < 2; ++i) R.vr[i] = *(const u32x4*)(ws + WS_V + (unsigned)(((m0 + l0 + i) * MW + col) * 2));
    if (wave == 0) { const float* gates = (const float*)(ws + WS_GATES); R.gi = gates[(size_t)(m0 + lane) * 16 + h]; R.gf = gates[(size_t)(m0 + lane) * 16 + 8 + h]; }
}
__device__ __forceinline__ void p2_items(Frame& F) {
    unsigned char* ws = F.ws;
    const int tid = F.tid, lane = F.lane, wave = F.wave;
    LAS unsigned char* lds = F.lds;
    LAS float* wl = (LAS float*)(lds + PA_W);
    const int cg8 = tid & 15, rp = tid >> 4, l0 = 2 * rp;
    for (int blk = F.bid; blk * 8 < NITEM; blk += F.G) {
        const int it0 = blk * 8, h = (it0 >> 5) & 7, col = h * DH + cg8 * 8;
        float wq[4][8], wk[4][8];
#pragma unroll
        for (int kk = 0; kk < 4; ++kk) { const f32x4 a = *(const f32x4*)(F.w_conv + kk * 2048 + col), b2 = *(const f32x4*)(F.w_conv + kk * 2048 + col + 4);
            const f32x4 c2 = *(const f32x4*)(F.w_conv + kk * 2048 + 1024 + col), d2 = *(const f32x4*)(F.w_conv + kk * 2048 + 1024 + col + 4);
#pragma unroll
            for (int j = 0; j < 4; ++j) { wq[kk][j] = a[j]; wq[kk][4 + j] = b2[j]; wk[kk][j] = c2[j]; wk[kk][4 + j] = d2[j]; } }
        P2Regs R;
        p2_issue(ws, it0, tid, lane, wave, R);
        LAS f32x4* run = (LAS f32x4*)(lds + 65536) + tid;
#pragma unroll
        for (int et = 0; et < 8; ++et) { float zf = 0.f; asm volatile("" : "+v"(zf)); run[et * 512] = (f32x4){zf, zf, zf, zf}; }
        LAS float* nrun = wl + 128 + tid;
        { float zf = 0.f; asm volatile("" : "+v"(zf)); if (tid < 128) *nrun = zf; if (tid == 0) { wl[66] = zf; wl[67] = zf; } }
        for (int k = 0; k < 8; ++k) {
            const int item = it0 + k, c = item & 31, b = item >> 8; const int m0 = b * SEQ + c * CH;
            if (wave == 0) {
                const float li = R.gi, lf = logsigm(R.gf);
                float bs = lf;
#pragma unroll
                for (int o = 1; o < 64; o <<= 1) { const float t = __shfl_up(bs, o); if (lane >= o) bs += t; }
                const float btot = __shfl(bs, 63);
                const float a = btot - bs + li, amax = wave_max(a);
                wl[lane] = __expf(a - amax);
                if (lane == 0) { ((float*)(ws + WS_SCAL))[item] = amax; ((float*)(ws + WS_SCAL))[NITEM + item] = btot;
                    const float mL = wl[66], Bc = wl[67], mn = fmaxf(btot + mL, amax);
                    ((float*)(ws + WS_SCAL))[2 * NITEM + item] = mL; ((float*)(ws + WS_SCAL))[3 * NITEM + item] = Bc;
                    wl[64] = __expf(btot + mL - mn); wl[65] = __expf(amax - mn); wl[66] = mn; wl[67] = Bc + btot; }
            }
            float qy[2][8], ky[2][8], vv[2][8];
            {
                float xq[5][8], xk[5][8];
#pragma unroll
                for (int i = 0; i < 5; ++i)
#pragma unroll
                    for (int p = 0; p < 4; ++p) { xq[i][2 * p] = bflo(R.qr[i][p]); xq[i][2 * p + 1] = bfhi(R.qr[i][p]); xk[i][2 * p] = bflo(R.kr[i][p]); xk[i][2 * p + 1] = bfhi(R.kr[i][p]); }
#pragma unroll
                for (int rr = 0; rr < 2; ++rr)
#pragma unroll
                    for (int j = 0; j < 8; ++j) { float aq = 0.f, ak = 0.f;
#pragma unroll
                        for (int kk = 0; kk < 4; ++kk) { aq += wq[kk][j] * xq[rr + kk][j]; ak += wk[kk][j] * xk[rr + kk][j]; }
                        qy[rr][j] = aq * sigm(aq); ky[rr][j] = ak * sigm(ak) * 0.08838834764831845f;
                        vv[rr][j] = (j & 1) ? bfhi(R.vr[rr][j >> 1]) : bflo(R.vr[rr][j >> 1]); }
            }
            if (k < 7) p2_issue(ws, item + 1, tid, lane, wave, R);
#pragma unroll
            for (int rr = 0; rr < 2; ++rr) { const unsigned off = (unsigned)(((m0 + l0 + rr) * MW + col) * 2);
                u32x4 o; o.x = pk2(qy[rr][0], qy[rr][1]); o.y = pk2(qy[rr][2], qy[rr][3]); o.z = pk2(qy[rr][4], qy[rr][5]); o.w = pk2(qy[rr][6], qy[rr][7]); if (NT_P2OUT) __builtin_nontemporal_store(o, (u32x4*)(ws + WS_QC + off)); else *(u32x4*)(ws + WS_QC + off) = o;
                u32x4 k2; k2.x = pk2(ky[rr][0], ky[rr][1]); k2.y = pk2(ky[rr][2], ky[rr][3]); k2.z = pk2(ky[rr][4], ky[rr][5]); k2.w = pk2(ky[rr][6], ky[rr][7]); if (NT_P2OUT) __builtin_nontemporal_store(k2, (u32x4*)(ws + WS_KC + off)); else *(u32x4*)(ws + WS_KC + off) = k2; }
            __syncthreads();
            {
                const float w0 = wl[l0], w1 = wl[l0 + 1];
                const int pv = vt_pos(l0);
#pragma unroll
                for (int j = 0; j < 8; ++j) { const int e = cg8 * 8 + j;
                    *(LAS unsigned*)(lds + PA_KT + e * 144 + p2swz(e, l0 * 2)) = pk2(ky[0][j], ky[1][j]);
                    *(LAS unsigned*)(lds + PA_VW + e * 144 + p2swz(e, l0 * 2)) = pk2(vv[0][j] * w0, vv[1][j] * w1);
                    *(LAS unsigned*)(lds + PA_VT + e * 128 + p2swz(e, pv * 2)) = pk2(vv[0][j], vv[1][j]); }
            }
            __syncthreads();
            {
                const int fr = lane & 15, fq = lane >> 4;
                f32x4 acc[8];
#pragma unroll
                for (int et = 0; et < 8; ++et) acc[et] = (f32x4){0.f, 0.f, 0.f, 0.f};
#pragma unroll
                for (int ks = 0; ks < 2; ++ks) { const bf16x8 bfr = *(const LAS bf16x8*)(lds + PA_VW + (16 * wave + fr) * 144 + p2swz(16 * wave + fr, (32 * ks + 8 * fq) * 2));
#pragma unroll
                    for (int et = 0; et < 8; ++et) { const bf16x8 afr = *(const LAS bf16x8*)(lds + PA_KT + (16 * et + fr) * 144 + p2swz(16 * et + fr, (32 * ks + 8 * fq) * 2));
                        acc[et] = __builtin_amdgcn_mfma_f32_16x16x32_bf16(afr, bfr, acc[et], 0, 0, 0); } }
                const int d = 16 * wave + fr;
                const float dec = wl[64], sc = wl[65];
#pragma unroll
                for (int et = 0; et < 8; ++et) { const f32x4 rv = run[et * 512]; u32x2 o; o.x = pk2(rv[0], rv[1]); o.y = pk2(rv[2], rv[3]);
                    if (k > 0) *(u32x2*)(ws + WS_A0 + (unsigned)(((item * 128 + d) * 128 + 16 * et + 4 * fq) * 2)) = o;
                    run[et * 512] = rv * dec + acc[et] * sc; }
                if (tid < 128) { float s = 0.f;
#pragma unroll 8
                    for (int l = 0; l < 64; ++l) s += wl[l] * bf2f(*(const LAS unsigned short*)(lds + PA_KT + tid * 144 + p2swz(tid, l * 2)));
                    const float nr = *nrun; ((float*)(ws + WS_NLOC))[(unsigned)(item * 128 + tid)] = nr; *nrun = nr * dec + s * sc; }
            }
#pragma unroll
            for (int i = 0; i < 2; ++i) { int t4 = tid; asm volatile("" : "+v"(t4)); const int idx = t4 + 512 * i, row = idx >> 3, chk = idx & 7;
                const u32x4 vt4 = *(const LAS u32x4*)(lds + PA_VT + row * 128 + p2swz(row, chk * 16));
                if (NT_P2OUT) __builtin_nontemporal_store(vt4, (u32x4*)(F.ob + DO_VT + (unsigned)((item * 128 + row) * 128 + chk * 16))); else *(u32x4*)(F.ob + DO_VT + (unsigned)((item * 128 + row) * 128 + chk * 16)) = vt4; }
            __syncthreads();
        }
        {
            int t3 = tid; asm volatile("" : "+v"(t3));
            const int fr = t3 & 15, fq = (t3 >> 4) & 3, d = 16 * wave + fr;
#pragma unroll
            for (int et = 0; et < 8; ++et) { const f32x4 rv = ((LAS f32x4*)(lds + 65536) + t3)[et * 512]; u32x2 o; o.x = pk2(rv[0], rv[1]); o.y = pk2(rv[2], rv[3]);
                *(u32x2*)(ws + WS_TOT + (unsigned)(((blk * 128 + d) * 128 + 16 * et + 4 * fq) * 2)) = o; }
            if (t3 < 128) ((float*)(ws + WS_NTOT))[(unsigned)(blk * 128 + t3)] = wl[128 + t3];
            if (t3 == 0) { ((float*)(ws + WS_SCAL))[4 * NITEM + blk] = wl[66]; ((float*)(ws + WS_SCAL))[4 * NITEM + 256 + blk] = wl[67]; }
        }
    }
}
template <int W> __device__ __forceinline__ void pooled_item(const unsigned char* U, unsigned char* P, int m4, int c8) {
    const int t0 = m4 & (SEQ - 1);
    u32x4 rows[W + 3];
#pragma unroll
    for (int i = 0; i < W + 3; ++i) { const int dt = i - (W - 1);
        rows[i] = (t0 + dt >= 0) ? *(const u32x4*)(U + ((size_t)(m4 + dt) * PW + c8 * 8) * 2) : (u32x4){0u, 0u, 0u, 0u}; }
#pragma unroll
    for (int r = 0; r < 4; ++r) { float s[8];
#pragma unroll
        for (int j = 0; j < 8; ++j) s[j] = 0.f;
#pragma unroll
        for (int i = 0; i < W; ++i) { const u32x4 v = rows[r + i];
#pragma unroll
            for (int j = 0; j < 4; ++j) { s[2 * j] += bflo(v[j]); s[2 * j + 1] += bfhi(v[j]); } }
        const int n = (t0 + r + 1 < W) ? (t0 + r + 1) : W; const float inv = 1.0f / (float)n;
        const u32x4 cur = rows[r + W - 1]; u32x4 o;
#pragma unroll
        for (int j = 0; j < 4; ++j) o[j] = pk2(s[2 * j] * inv - bflo(cur[j]), s[2 * j + 1] * inv - bfhi(cur[j]));
        *(u32x4*)(P + ((size_t)(m4 + r) * DM + c8 * 8) * 2) = o; }
}
__device__ __forceinline__ void p2_pooled(Frame& F) {
    const int gt = F.bid * 512 + F.tid, NGT = F.G * 512;
    const unsigned char* U = F.ws + WS_U; unsigned char* P = F.ob + DO_MIX + 1024 * 2;
    for (int i = gt; i < (M / 4) * 128; i += NGT) { const int m4 = (i >> 7) * 4, c8 = i & 127, g = c8 >> 5;
        if (g == 0) pooled_item<2>(U, P, m4, c8); else if (g == 1) pooled_item<4>(U, P, m4, c8); else if (g == 2) pooled_item<8>(U, P, m4, c8); else pooled_item<16>(U, P, m4, c8); }
}

__device__ __forceinline__ void fold_pool(Frame& F) {
    const int lane = F.lane, wave = F.wave, fr = lane & 15, fq = lane >> 4;
    bf16* WO = (bf16*)(F.ws + WS_WOUT); const bf16* WP = (const bf16*)(F.ws + WS_WPOOL);
    for (int t = F.bid; t < 256; t += F.G) { const int g = t & 3, nb = t >> 2;
        f32x4 acc[2][2];
#pragma unroll
        for (int ct = 0; ct < 2; ++ct)
#pragma unroll
            for (int nt = 0; nt < 2; ++nt) acc[ct][nt] = (f32x4){0.f, 0.f, 0.f, 0.f};
        const bf16* ap = WP + (size_t)(256 * g + 32 * wave + fr) * 256 + 8 * fq;
        const bf16* bp = WO + (size_t)(32 * nb + fr) * DM + 1024 + 256 * g + 8 * fq;
#pragma unroll
        for (int h = 0; h < 2; ++h) { bf16x8 a[4][2], b[4][2];
#pragma unroll
            for (int d4 = 0; d4 < 4; ++d4)
#pragma unroll
                for (int q = 0; q < 2; ++q) { a[d4][q] = *(const bf16x8*)(ap + (size_t)(16 * q) * 256 + 32 * (4 * h + d4)); b[d4][q] = *(const bf16x8*)(bp + (size_t)(16 * q) * DM + 32 * (4 * h + d4)); }
#pragma unroll
            for (int d4 = 0; d4 < 4; ++d4)
#pragma unroll
                for (int ct = 0; ct < 2; ++ct)
#pragma unroll
                    for (int nt = 0; nt < 2; ++nt) acc[ct][nt] = __builtin_amdgcn_mfma_f32_16x16x32_bf16(a[d4][ct], b[d4][nt], acc[ct][nt], 0, 0, 0); }
        __syncthreads();
#pragma unroll
        for (int ct = 0; ct < 2; ++ct)
#pragma unroll
            for (int nt = 0; nt < 2; ++nt) { u32x2 o; o.x = pk2(acc[ct][nt][0], acc[ct][nt][1]); o.y = pk2(acc[ct][nt][2], acc[ct][nt][3]);
                *(u32x2*)(WO + (size_t)(32 * nb + 16 * nt + fr) * DM + 1024 + 256 * g + 32 * wave + 16 * ct + 4 * fq) = o; }
        __syncthreads();
    }
}

__device__ __forceinline__ void p3_scan(Frame& F) {
    unsigned char* ws = F.ws;
    const int gt = F.bid * 512 + F.tid;
    const float* amaxp = (const float*)(ws + WS_SCAL); const float* btotp = amaxp + NITEM; float* mprev = (float*)(ws + WS_SCAL) + 2 * NITEM;
    for (int id = gt; id < 64 * 128 * 16; id += F.G * 512) {
        const int bh = id >> 11, d = (id >> 4) & 127, e8 = id & 15;
        float acc[8], nacc[8];
#pragma unroll
        for (int j = 0; j < 8; ++j) { acc[j] = 0.f; nacc[j] = 0.f; }
        float m = 0.f;
        const bool do_n = (d == 0);
        for (int cb = 0; cb < NCH; cb += 8) {
            u32x4 cl[8]; float am[8], bt[8]; f32x4 na[8], nb2[8];
#pragma unroll
            for (int k = 0; k < 8; ++k) { const int item = bh * 32 + cb + k;
                cl[k] = ld_once((const u32x4*)(ws + WS_A0 + (((size_t)item * 128 + d) * 128 + e8 * 8) * 2)); am[k] = amaxp[item]; bt[k] = btotp[item];
                if (do_n) { const float* nl = (const float*)(ws + WS_NLOC) + (size_t)item * 128 + e8 * 8; na[k] = *(const f32x4*)nl; nb2[k] = *(const f32x4*)(nl + 4); } }
#pragma unroll
            for (int k = 0; k < 8; ++k) { const int item = bh * 32 + cb + k;
                u32x4 o; o.x = pk2(acc[0], acc[1]); o.y = pk2(acc[2], acc[3]); o.z = pk2(acc[4], acc[5]); o.w = pk2(acc[6], acc[7]);
                *(u32x4*)(ws + WS_CPREV + (((size_t)item * 128 + d) * 128 + e8 * 8) * 2) = o;
                const float mn = fmaxf(bt[k] + m, am[k]), dec = __expf(bt[k] + m - mn), sc = __expf(am[k] - mn);
                if (do_n) { float* np = (float*)(ws + WS_NPREV) + (size_t)item * 128 + e8 * 8;
                    *(f32x4*)np = (f32x4){nacc[0], nacc[1], nacc[2], nacc[3]}; *(f32x4*)(np + 4) = (f32x4){nacc[4], nacc[5], nacc[6], nacc[7]};
#pragma unroll
                    for (int j = 0; j < 4; ++j) { nacc[j] = dec * nacc[j] + sc * na[k][j]; nacc[4 + j] = dec * nacc[4 + j] + sc * nb2[k][j]; }
                    if (e8 == 0) mprev[item] = m; }
#pragma unroll
                for (int j = 0; j < 4; ++j) { acc[2 * j] = dec * acc[2 * j] + sc * bflo(cl[k][j]); acc[2 * j + 1] = dec * acc[2 * j + 1] + sc * bfhi(cl[k][j]); }
                m = mn; }
        }
    }
}

__device__ __forceinline__ void p4_issue(const unsigned char* ws, const unsigned char* ob, int it0, int tid, u32x4 (&st)[16]) {
#pragma unroll
    for (int i = 0; i < 16; ++i) { const int item = it0 + (i >> 3), cid = (tid + 512 * i) & 4095;
        const int c = item & 31, bh = item >> 5, h = bh & 7, b = bh >> 3; const int m0 = b * SEQ + c * CH;
        const unsigned char* src;
        if ((i & 7) < 2) { const int r = cid >> 4, c16 = cid & 15; src = ws + WS_KC + (unsigned)(((m0 + r) * MW + h * DH) * 2 + c16 * 16); }
        else if ((i & 7) < 6) { const int r = (cid - 1024) >> 4, c16 = cid & 15; src = ws + WS_A0 + (unsigned)((item * 128 + r) * 256 + c16 * 16); }
        else { const int r = (cid - 3072) >> 3, c8 = cid & 7; src = ob + DO_VT + (unsigned)((item * 128 + r) * 128 + c8 * 16); }
        st[i] = (((i & 7) >= 2) && ((i & 7) < 6) && ((item & 7) == 0)) ? (u32x4){0u, 0u, 0u, 0u} : ld_once((const u32x4*)src); }
}
__device__ __forceinline__ void p4_write(LAS unsigned char* lds, int tid, const u32x4 (&st)[16], int it0, const unsigned char* gb) {
#pragma unroll
    for (int i = 0; i < 16; ++i) { const int cid = (tid + 512 * i) & 4095; LAS unsigned char* base = lds + (i >> 3) * 65536; int off;
        u32x4 v = st[i];
        if ((i & 7) < 2) { const int r = cid >> 4, c16 = cid & 15; off = r * 256 + ((c16 ^ (r & 15)) << 4); }
        else if ((i & 7) < 6) { const int r = (cid - 1024) >> 4, c16 = cid & 15; off = 16384 + r * 256 + ((c16 ^ (r & 15)) << 4);
            const int kk = (it0 + (i >> 3)) & 7; const float al = *(const LAS float*)(lds + P4X_A + kk * 4), be = *(const LAS float*)(lds + P4X_B + kk * 4);
            int t5 = tid; asm volatile("" : "+v"(t5));
            const u32x4 g = *(const u32x4*)(gb + (unsigned)(((((i & 7) - 2) * 512) + t5) * 16));
#pragma unroll
            for (int q = 0; q < 4; ++q) v[q] = pk2(al * bflo(v[q]) + be * bflo(g[q]), al * bfhi(v[q]) + be * bfhi(g[q])); }
        else { const int r = (cid - 3072) >> 3, c8 = cid & 7; off = 49152 + r * 128 + ((c8 ^ ((r >> 1) & 7)) << 4); }
        *(LAS u32x4*)(base + off) = v; }
}
__device__ __forceinline__ void p4_compute(Frame& F, int item, int rb, const LAS unsigned char* L) {
    unsigned char* ws = F.ws;
    const int lane = F.lane, fr = lane & 15, fq = lane >> 4;
    const int c = item & 31, bh = item >> 5, h = bh & 7, b = bh >> 3;
    const int m0 = b * SEQ + c * CH;
    const float* gates = (const float*)(ws + WS_GATES);
    const float li = gates[(unsigned)((m0 + lane) * 16 + h)], lf = logsigm(gates[(unsigned)((m0 + lane) * 16 + 8 + h)]);
    float bs = lf;
#pragma unroll
    for (int o = 1; o < 64; o <<= 1) { const float t = __shfl_up(bs, o); if (lane >= o) bs += t; }
    const float gg = li - bs;
    float pmx = gg;
#pragma unroll
    for (int o = 1; o < 64; o <<= 1) { const float t = __shfl_up(pmx, o); if (lane >= o) pmx = fmaxf(pmx, t); }
    const float m_prev = *(const LAS float*)(F.lds + P4X_M + (item & 7) * 4);
    const float pm = fmaxf(m_prev, pmx);
    const int l = 16 * rb + fr;
    const float b_l = __shfl(bs, l), pm_l = __shfl(pm, l);
    const float inter_w = __expf(m_prev - pm_l);
    bf16x8 qf[4];
#pragma unroll
    for (int ks = 0; ks < 4; ++ks) qf[ks] = *(const bf16x8*)(ws + WS_QC + (unsigned)(((m0 + l) * MW + h * DH + 32 * ks + 8 * fq) * 2));
    f32x4 T[4];
#pragma unroll
    for (int jt = 0; jt < 4; ++jt) { T[jt] = (f32x4){0.f, 0.f, 0.f, 0.f};
        if (jt <= rb) {
#pragma unroll
            for (int ks = 0; ks < 4; ++ks) { const int r = 16 * jt + fr; const bf16x8 kf = *(const LAS bf16x8*)(L + r * 256 + (((4 * ks + fq) ^ (r & 15)) << 4));
                T[jt] = __builtin_amdgcn_mfma_f32_16x16x32_bf16(kf, qf[ks], T[jt], 0, 0, 0); } } }
    if (c == 0 && rb == 0) {
        const float* qk0 = (const float*)(ws + WS_QK0) + b * 2048; float part = 0.f; const float rs0 = ((const float*)(ws + WS_RS0))[b * SEQ];
#pragma unroll
        for (int i = 0; i < 2; ++i) { const int e = h * DH + lane + 64 * i;
            const float yq = F.w_conv[3 * 2048 + e] * qk0[e] * rs0, yk = F.w_conv[3 * 2048 + 1024 + e] * qk0[1024 + e] * rs0;
            part += (yq * sigm(yq)) * (yk * sigm(yk)); }
        const float s00 = wave_sum(part) * 0.08838834764831845f;
        if (lane == 0) T[0][0] = s00;
    }
    float rowsum = 0.f;
#pragma unroll
    for (int jt = 0; jt < 4; ++jt)
#pragma unroll
        for (int r = 0; r < 4; ++r) { const int j = 16 * jt + 4 * fq + r; const float gj = __shfl(gg, j);
            const float wgt = (j <= l) ? __expf(gj - pm_l) : 0.f; const float sv = T[jt][r] * wgt; T[jt][r] = sv; rowsum += sv; }
    bf16x8 pf[2];
#pragma unroll
    for (int s2 = 0; s2 < 2; ++s2) { u32x4 w; w.x = pk2(T[2 * s2][0], T[2 * s2][1]); w.y = pk2(T[2 * s2][2], T[2 * s2][3]); w.z = pk2(T[2 * s2 + 1][0], T[2 * s2 + 1][1]); w.w = pk2(T[2 * s2 + 1][2], T[2 * s2 + 1][3]);
        pf[s2] = __builtin_bit_cast(bf16x8, w); }
    float nq = 0.f;
#pragma unroll
    for (int ks = 0; ks < 4; ++ks) { const LAS float* np = (const LAS float*)(F.lds + P4X_N) + (item & 7) * 128 + 32 * ks + 8 * fq; const f32x4 a = *(const LAS f32x4*)np, b2 = *(const LAS f32x4*)(np + 4);
        const u32x4 qw = __builtin_bit_cast(u32x4, qf[ks]);
        nq += a[0] * bflo(qw[0]) + a[1] * bfhi(qw[0]) + a[2] * bflo(qw[1]) + a[3] * bfhi(qw[1]) + b2[0] * bflo(qw[2]) + b2[1] * bfhi(qw[2]) + b2[2] * bflo(qw[3]) + b2[3] * bfhi(qw[3]); }
    nq += __shfl_xor(nq, 16); nq += __shfl_xor(nq, 32);
    rowsum += __shfl_xor(rowsum, 16); rowsum += __shfl_xor(rowsum, 32);
    const float den = inter_w * nq + rowsum;
    const float inv = frcp(fmaxf(fabsf(den), __expf(-(b_l + pm_l))));
    f32x4 acc[8]; float ss = 0.f;
#pragma unroll
    for (int dt = 0; dt < 8; ++dt) { acc[dt] = (f32x4){0.f, 0.f, 0.f, 0.f}; const int r = 16 * dt + fr;
#pragma unroll
        for (int ks = 0; ks < 4; ++ks) { const bf16x8 cf = *(const LAS bf16x8*)(L + 16384 + r * 256 + (((4 * ks + fq) ^ (r & 15)) << 4));
            acc[dt] = __builtin_amdgcn_mfma_f32_16x16x32_bf16(cf, qf[ks], acc[dt], 0, 0, 0); }
        acc[dt] = acc[dt] * inter_w;
#pragma unroll
        for (int s2 = 0; s2 < 2; ++s2) { if (s2 == 0 || rb >= 2) { const bf16x8 vf = *(const LAS bf16x8*)(L + 49152 + r * 128 + (((4 * s2 + fq) ^ ((r >> 1) & 7)) << 4));
                acc[dt] = __builtin_amdgcn_mfma_f32_16x16x32_bf16(vf, pf[s2], acc[dt], 0, 0, 0); } }
        acc[dt] = acc[dt] * inv;
        ss += (acc[dt][0] * acc[dt][0] + acc[dt][1] * acc[dt][1]) + (acc[dt][2] * acc[dt][2] + acc[dt][3] * acc[dt][3]); }
    ss += __shfl_xor(ss, 16); ss += __shfl_xor(ss, 32);
    const float rn = rsqrtf(ss * (1.0f / DH) + EPS);
#pragma unroll
    for (int dt = 0; dt < 8; ++dt) { const int d0 = 16 * dt + 4 * fq;
        const u32x2 ow = *(const u32x2*)(ws + WS_O + (unsigned)(((m0 + l) * MW + h * DH + d0) * 2));
        const f32x4 gm = *(const f32x4*)(F.g_mlstm + h * DH + d0);
        const float o0 = sigm(bflo(ow.x)) * acc[dt][0] * rn * gm[0], o1 = sigm(bfhi(ow.x)) * acc[dt][1] * rn * gm[1];
        const float o2 = sigm(bflo(ow.y)) * acc[dt][2] * rn * gm[2], o3 = sigm(bfhi(ow.y)) * acc[dt][3] * rn * gm[3];
        u32x2 o; o.x = pk2(o0, o1); o.y = pk2(o2, o3);
        *(u32x2*)(F.ob + DO_MIX + (unsigned)(((m0 + l) * DM + h * DH + d0) * 2)) = o; }
}
__device__ __forceinline__ void p4_phase(Frame& F) {
    const int npair = NITEM / 2;
    u32x4 st[16];
    int pr = F.bid * 4;
    for (int blk = F.bid; blk * 4 < npair; blk += F.G) {
        pr = blk * 4;
        const unsigned char* gb = F.ws + WS_GB + (size_t)blk * 32768;
        {
            const float* scal = (const float*)(F.ws + WS_SCAL);
            const int grp = blk & 3; int tid = F.tid; asm volatile("" : "+v"(tid));
            float S[4][8]; float nS = 0.f, mS = 0.f;
#pragma unroll
            for (int q = 0; q < 4; ++q)
#pragma unroll
                for (int j = 0; j < 8; ++j) S[q][j] = 0.f;
            for (int i = 0; i < grp; ++i) { const int bi = blk - grp + i;
                const float mT = scal[4 * NITEM + bi], BT = scal[4 * NITEM + 256 + bi];
                const float mn = fmaxf(BT + mS, mT), dec = __expf(BT + mS - mn), sc = __expf(mT - mn);
#pragma unroll
                for (int q = 0; q < 4; ++q) { const int cid = (tid + 512 * (2 + q)) & 4095, r = (cid - 1024) >> 4, c16 = cid & 15;
                    const u32x4 t = *(const u32x4*)(F.ws + WS_TOT + (unsigned)((bi * 128 + r) * 256 + c16 * 16));
#pragma unroll
                    for (int j = 0; j < 4; ++j) { S[q][2 * j] = dec * S[q][2 * j] + sc * bflo(t[j]); S[q][2 * j + 1] = dec * S[q][2 * j + 1] + sc * bfhi(t[j]); } }
                if (tid < 128) nS = dec * nS + sc * ((const float*)(F.ws + WS_NTOT))[(unsigned)(bi * 128 + tid)];
                mS = mn; }
#pragma unroll
            for (int q = 0; q < 4; ++q) { u32x4 g4;
#pragma unroll
                for (int j = 0; j < 4; ++j) g4[j] = pk2(S[q][2 * j], S[q][2 * j + 1]);
                *(u32x4*)(F.ws + WS_GB + (size_t)blk * 32768 + (unsigned)((q * 512 + tid) * 16)) = g4; }
            asm volatile("s_waitcnt vmcnt(0)" ::: "memory");
            __syncthreads();
#pragma unroll 1
            for (int kk = 0; kk < 8; ++kk) { const int item = 8 * blk + kk; const float mL = scal[2 * NITEM + item], Bc = scal[3 * NITEM + item];
                const float mp = fmaxf(mL, mS + Bc), al = __expf(mL - mp), be = __expf(mS + Bc - mp);
                if (tid < 128) *(LAS float*)(F.lds + P4X_N + (kk * 128 + tid) * 4) = al * ((const float*)(F.ws + WS_NLOC))[(unsigned)(item * 128 + tid)] + be * nS;
                if (tid == 0) { *(LAS float*)(F.lds + P4X_M + kk * 4) = mp; *(LAS float*)(F.lds + P4X_A + kk * 4) = al; *(LAS float*)(F.lds + P4X_B + kk * 4) = be; } }
        }
        p4_issue(F.ws, F.ob, 2 * (pr + 3), F.tid, st);
        for (int k = 3; k >= 0; --k) {
            __syncthreads();
            p4_write(F.lds, F.tid, st, 2 * (pr + k), gb);
            if (k > 0) p4_issue(F.ws, F.ob, 2 * (pr + k - 1), F.tid, st);
            __syncthreads();
            p4_compute(F, 2 * (pr + k) + (F.wave >> 2), F.wave & 3, F.lds + (F.wave >> 2) * 65536);
        }
    }
    __syncthreads();
}

template <bool BASE_BF16, bool NTH = false>
__device__ __forceinline__ void row_resnorm(Frame& F, const void* base, const unsigned char* y, const float* g1, unsigned char* hout, float* rsout, signed char* qout) {
    const int gw = F.bid * 8 + F.wave, NGW = F.G * 8, lane = F.lane;
    constexpr int NB = BASE_BF16 ? 4 : 8;
    f32x4 ga[8];
#pragma unroll
    for (int j = 0; j < 4; ++j) { const size_t co = 512 * j + 8 * lane; ga[2 * j] = *(const f32x4*)(g1 + co); ga[2 * j + 1] = *(const f32x4*)(g1 + co + 4); }
    u32x4 ny[4], nb[NB];
    int m = gw;
#define ROW_LOAD(mm) do { _Pragma("unroll") for (int j = 0; j < 4; ++j) { const size_t co = (size_t)(mm) * DM + 512 * j + 8 * lane; ny[j] = ld_once((const u32x4*)(y + co * 2)); \
        if (BASE_BF16) nb[j] = ld_once((const u32x4*)((const unsigned char*)base + co * 2)); \
        else { nb[(2 * j) % NB] = *(const u32x4*)((const unsigned char*)base + co * 4); nb[(2 * j + 1) % NB] = *(const u32x4*)((const unsigned char*)base + co * 4 + 16); } } } while (0)
    if (m < M) ROW_LOAD(m);
    for (; m < M; m += NGW) {
        float v[32], bv[32]; float s = 0.f;
#pragma unroll
        for (int j = 0; j < 4; ++j) {
#pragma unroll
            for (int q = 0; q < 4; ++q) { v[8 * j + 2 * q] = bflo(ny[j][q]); v[8 * j + 2 * q + 1] = bfhi(ny[j][q]); }
            if (BASE_BF16) {
#pragma unroll
                for (int q = 0; q < 4; ++q) { bv[8 * j + 2 * q] = bflo(nb[j][q]); bv[8 * j + 2 * q + 1] = bfhi(nb[j][q]); } }
            else {
#pragma unroll
                for (int q = 0; q < 4; ++q) { bv[8 * j + q] = __uint_as_float(nb[(2 * j) % NB][q]); bv[8 * j + 4 + q] = __uint_as_float(nb[(2 * j + 1) % NB][q]); } } }
        if (m + NGW < M) ROW_LOAD(m + NGW);
#pragma unroll
        for (int i = 0; i < 32; ++i) s += v[i] * v[i];
        const float r1 = rsqrtf(wave_sum(s) * (1.0f / DM) + EPS);
        float s2 = 0.f;
#pragma unroll
        for (int j = 0; j < 4; ++j) { const size_t co = 512 * j + 8 * lane;
#pragma unroll
            for (int q = 0; q < 4; ++q) { v[8 * j + q] = bv[8 * j + q] + v[8 * j + q] * r1 * ga[2 * j][q]; v[8 * j + 4 + q] = bv[8 * j + 4 + q] + v[8 * j + 4 + q] * r1 * ga[2 * j + 1][q]; }
            u32x4 o; o.x = pk2(v[8 * j], v[8 * j + 1]); o.y = pk2(v[8 * j + 2], v[8 * j + 3]); o.z = pk2(v[8 * j + 4], v[8 * j + 5]); o.w = pk2(v[8 * j + 6], v[8 * j + 7]);
            if (NTH) __builtin_nontemporal_store(o, (u32x4*)(hout + ((size_t)m * DM + co) * 2)); else *(u32x4*)(hout + ((size_t)m * DM + co) * 2) = o; }
#pragma unroll
        for (int i = 0; i < 32; ++i) s2 += v[i] * v[i];
        const float r2 = rsqrtf(wave_sum(s2) * (1.0f / DM) + EPS);
        float mx = 0.f;
#pragma unroll
        for (int i = 0; i < 32; ++i) mx = fmaxf(mx, fabsf(v[i]));
        mx = wave_max(mx);
        const float qa = mx > 0.f ? 127.0f / mx : 0.f;
#pragma unroll
        for (int j = 0; j < 4; ++j) { u32x2 o; o.x = pack4_i8(v[8 * j] * qa, v[8 * j + 1] * qa, v[8 * j + 2] * qa, v[8 * j + 3] * qa); o.y = pack4_i8(v[8 * j + 4] * qa, v[8 * j + 5] * qa, v[8 * j + 6] * qa, v[8 * j + 7] * qa);
            *(u32x2*)(qout + (size_t)m * DM + 512 * j + 8 * lane) = o; }
        if (lane == 0) rsout[m] = r2 * mx * (1.0f / 127.0f);
    }
#undef ROW_LOAD
}
__device__ __forceinline__ void row_final(Frame& F, const unsigned char* base, const unsigned char* y, const float* g, float* out) {
    const int gw = F.bid * 8 + F.wave, NGW = F.G * 8, lane = F.lane;
    f32x4 ga[8];
#pragma unroll
    for (int j = 0; j < 4; ++j) { const size_t co = 512 * j + 8 * lane; ga[2 * j] = *(const f32x4*)(g + co); ga[2 * j + 1] = *(const f32x4*)(g + co + 4); }
    u32x4 ny[4], nb[4];
    int m = gw;
#define ROW_LOAD(mm) do { _Pragma("unroll") for (int j = 0; j < 4; ++j) { const size_t co = (size_t)(mm) * DM + 512 * j + 8 * lane; ny[j] = ld_once((const u32x4*)(y + co * 2)); nb[j] = ld_once((const u32x4*)(base + co * 2)); } } while (0)
    if (m < M) ROW_LOAD(m);
    for (; m < M; m += NGW) {
        float v[32], bv[32]; float s = 0.f;
#pragma unroll
        for (int j = 0; j < 4; ++j)
#pragma unroll
            for (int q = 0; q < 4; ++q) { v[8 * j + 2 * q] = bflo(ny[j][q]); v[8 * j + 2 * q + 1] = bfhi(ny[j][q]); bv[8 * j + 2 * q] = bflo(nb[j][q]); bv[8 * j + 2 * q + 1] = bfhi(nb[j][q]); }
        if (m + NGW < M) ROW_LOAD(m + NGW);
#pragma unroll
        for (int i = 0; i < 32; ++i) s += v[i] * v[i];
        const float r1 = rsqrtf(wave_sum(s) * (1.0f / DM) + EPS);
#pragma unroll
        for (int j = 0; j < 4; ++j) { const size_t co = 512 * j + 8 * lane; f32x4 o0, o1;
#pragma unroll
            for (int q = 0; q < 4; ++q) { o0[q] = bv[8 * j + q] + v[8 * j + q] * r1 * ga[2 * j][q]; o1[q] = bv[8 * j + 4 + q] + v[8 * j + 4 + q] * r1 * ga[2 * j + 1][q]; }
            __builtin_nontemporal_store(o0, (f32x4*)(out + (size_t)m * DM + co)); __builtin_nontemporal_store(o1, (f32x4*)(out + (size_t)m * DM + co + 4)); }
    }
#undef ROW_LOAD
}

constexpr int NPHASE = 12;
__global__ void __launch_bounds__(512, 2) fwd_mega(const Args args) {
    extern __shared__ __attribute__((aligned(16))) unsigned char lds_raw[];
    const int wv_ = __builtin_amdgcn_readfirstlane((int)threadIdx.x >> 6);
    {
        const int t0 = threadIdx.x;
        for (int u = t0; u < (LDS_BYTES - 131072) / 4; u += 512) ((LAS unsigned*)((LAS unsigned char*)lds_raw + 131072))[u] = 0u;
    }
    __syncthreads();
    const int lo = args.ph_lo, hi = args.ph_hi;
    if (lo < 0) cg::this_grid().sync();
#define IN(k) (lo <= (k) && (k) < hi)
#define BARSETUP() XcdBarrier bar; bar.wv = wv_; bar.bar = (unsigned*)(args.ws + WS_CTL) + 4096; bar.x = xb_xcc_id(); bar.st = (volatile LAS unsigned*)((LAS unsigned char*)lds_raw + MISC_OFF) + 8;
#define SEAM(k) do { if (IN(k) && IN((k) + 1)) { BARSETUP(); for (int rb_ = 0; rb_ < REP_BAR; ++rb_) xcd_barrier(bar); } if (DBG_TS >= 0 && blockIdx.x == 0 && threadIdx.x == 0) ((unsigned long long*)(args.ws + WS_CTL + 65536))[(k) + 1] = __builtin_amdgcn_s_memrealtime(); } while (0)
    if (DBG_TS >= 0 && blockIdx.x == 0 && threadIdx.x == 0) ((unsigned long long*)(args.ws + WS_CTL + 65536))[0] = __builtin_amdgcn_s_memrealtime();
    if (hi - lo > 1) { if (threadIdx.x == 0) (void)xb_add((unsigned*)(args.ws + WS_CTL) + 4096 + XB_XCNT(xb_xcc_id()), 1u); }

    if (IN(0)) { MK_FRAME(F); F.x = args.in[0]; F.p = args.in[1]; F.w_in = args.in[2]; F.b_gates = args.in[3]; F.w_pool = args.in[6]; F.pool_scale = args.in[7]; F.w_out = args.in[8]; F.g_mix_pre = args.in[9];
        F.w_ff1 = args.in[11]; F.w_ff2 = args.in[12]; F.w_ple_proj = args.in[15]; F.w_ple_gate = args.in[16]; F.g_ff_pre = args.in[13]; F.g_ple_gate = args.in[17];
        for (int rep_ = 0; rep_ < REP_P0; ++rep_) { p0_prologue(F); __syncthreads(); }
        p0_first_tokens(F); } SEAM(0);
    if (IN(1)) {
        unsigned char* ws = args.ws;
        pg8::Gemm g{(const bf16*)(ws + WS_XB), (const bf16*)(ws + WS_WIN), DM, DM, DM, 0}; pg8::StaticOrder S; S.init(M, NIN, gridDim.x, blockIdx.x, WGM_P1);
        pg8::EpiBf16<0> E{(bf16*)(ws + WS_Q), MW, nullptr, 1024, (size_t)(WS_K - WS_Q) / 2, (const float*)(ws + WS_RS0)};
        for (int rep_ = 0; rep_ < GEMM_REP; ++rep_) pg8::gemm_phase((LAS unsigned char*)lds_raw, g, S, E, wv_);
    } SEAM(1);
    if (IN(2)) { MK_FRAME(F); F.w_conv = args.in[4];
        for (int rep_ = 0; rep_ < REP_P2I; ++rep_) p2_items(F);
        for (int rep_ = 0; rep_ < REP_MIX; ++rep_) p2_pooled(F);
        fold_pool(F);
    } SEAM(2);
    if (IN(4)) { MK_FRAME(F); F.g_mlstm = args.in[5]; F.w_conv = args.in[4];
        for (int rep_ = 0; rep_ < REP_P4; ++rep_) p4_phase(F);
    } SEAM(4);
    if (IN(5)) {
        unsigned char* ws = args.ws; unsigned char* ob = (unsigned char*)args.out;
        pg8::Gemm g{(const bf16*)(ob + DO_MIX), (const bf16*)(ws + WS_WOUT), DM, DM, DM, 0}; pg8::StaticOrder S; S.init(M, DM, gridDim.x, blockIdx.x, WGM_P5);
        pg8::EpiBf16<0> E{(bf16*)(ws + WS_A0), DM, nullptr, 0, 0, nullptr};
        for (int rep_ = 0; rep_ < GEMM_REP; ++rep_) pg8::gemm_phase((LAS unsigned char*)lds_raw, g, S, E, wv_);
    } SEAM(5);
    if (IN(6)) { MK_FRAME(F); for (int rep_ = 0; rep_ < REP_ROW; ++rep_) row_resnorm<true, true>(F, F.ws + WS_XB, F.ws + WS_A0, args.in[10], F.ob + DO_H1B, (float*)(F.ws + WS_RS1), (signed char*)(F.ob + DO_H1Q));
        quant_ff1_local(F, args.in[11], args.in[13], (float*)(F.ws + WS_CTL + CTL_CM1), (signed char*)(F.ws + WS_WFF1)); } SEAM(6);
    if (IN(7)) {
        unsigned char* ws = args.ws;
        pg8::Gemm g{(const void*)((unsigned char*)args.out + DO_H1Q), (const void*)(ws + WS_WFF1), DM, DM, DM, 0}; pg8::StaticOrder S; S.init(M, DFF, gridDim.x, blockIdx.x, WGM_P7);
        pg8::EpiI8Relu2 E{(bf16*)(ws + WS_HB), DFF, (const float*)(ws + WS_RS1), (const float*)(ws + WS_CTL + CTL_CM1)};
        for (int rep_ = 0; rep_ < REP_FF1; ++rep_) pg8::gemm_phase<pg8::EpiI8Relu2, pg8::StaticOrder, true>((LAS unsigned char*)lds_raw, g, S, E, wv_);
    } SEAM(7);
    if (IN(8)) {
        unsigned char* ws = args.ws;
        pg8::Gemm g{(const bf16*)(ws + WS_HB), (const bf16*)(ws + WS_WFF2), DFF, DFF, DFF, 0}; pg8::StaticOrder S; S.init(M, DM, gridDim.x, blockIdx.x, WGM_P8, 1);
        pg8::EpiBf16<0> E{(bf16*)(ws + WS_A0), DM, nullptr, 0, 0, nullptr};
        for (int rep_ = 0; rep_ < REP_FF2; ++rep_) pg8::gemm_phase((LAS unsigned char*)lds_raw, g, S, E, wv_);
    } SEAM(8);
    if (IN(9)) { MK_FRAME(F); row_resnorm<true>(F, F.ob + DO_H1B, F.ws + WS_A0, args.in[14], F.ws + WS_H2B, (float*)(F.ws + WS_RS2), (signed char*)(F.ws + WS_H2Q));
        quant_weight(F, args.in[16], DM, DM, DM, args.in[17], (const float*)(F.ws + WS_CTL + CTL_CM2), (signed char*)(F.ws + WS_WPG)); } SEAM(9);
    if (IN(10)) {
        unsigned char* ws = args.ws;
        {   pg8::Gemm g{(const bf16*)(ws + WS_PB), (const bf16*)(ws + WS_WPP), PD, PD, PD, 0}; pg8::StaticOrder S; S.init(M, DM, gridDim.x, blockIdx.x, WGM_P10);
            pg8::EpiBf16<0> E{(bf16*)(ws + WS_E), DM, nullptr, 0, 0, nullptr};
            for (int rep_ = 0; rep_ < GEMM_REP; ++rep_) pg8::gemm_phase((LAS unsigned char*)lds_raw, g, S, E, wv_); }
        asm volatile("s_waitcnt vmcnt(0)" ::: "memory"); __syncthreads();
        {   pg8::Gemm g{(const void*)(ws + WS_H2Q), (const void*)(ws + WS_WPG), DM, DM, DM, 0}; pg8::StaticOrder S; S.init(M, DM, gridDim.x, blockIdx.x, WGM_P10);
            pg8::EpiI8GateMul E{(const bf16*)(ws + WS_E), (bf16*)(ws + WS_A0), DM, (const float*)(ws + WS_RS2), (const float*)(ws + WS_CTL + CTL_CM2)};
            for (int rep_ = 0; rep_ < GEMM_REP; ++rep_) pg8::gemm_phase<pg8::EpiI8GateMul, pg8::StaticOrder, true>((LAS unsigned char*)lds_raw, g, S, E, wv_); }
    } SEAM(10);
    if (IN(11)) { MK_FRAME(F); row_final(F, F.ws + WS_H2B, F.ws + WS_A0, args.in[18], F.out); }
    if (DBG_TS >= 0) {
        __syncthreads();
        if (blockIdx.x == 0 && threadIdx.x == 0) { asm volatile("s_waitcnt vmcnt(0)" ::: "memory"); unsigned long long* ts = (unsigned long long*)(args.ws + WS_CTL + 65536); ts[12] = __builtin_amdgcn_s_memrealtime();
            const int k_ = DBG_TS < 12 ? DBG_TS : 0; float us = (float)(DBG_TS < 12 ? (ts[k_ + 1] - ts[k_]) : (ts[12] - ts[0])) * 0.01f; if (DBG_TS == 99) us = 500.f;
            ((float*)(args.ws + WS_CTL + 65536))[64] = (DBG_TS == 99) ? 0.5f : us * DBG_SCALE; }
        { BARSETUP(); xcd_barrier(bar); }
        const float delta = ((const float*)(args.ws + WS_CTL + 65536))[64];
        for (size_t i = (size_t)blockIdx.x * 512 + threadIdx.x; i < (size_t)M * DM / 4; i += (size_t)gridDim.x * 512) { f32x4 v = ((f32x4*)args.out)[i]; v = v + delta; ((f32x4*)args.out)[i] = v; }
    }
#undef IN
#undef SEAM
#undef BARSETUP
}


#ifdef DBG_STOP
struct DbgBuf { const void* p; size_t n; int is_f32; int bit; };
__global__ void __launch_bounds__(512) dbg_scan(DbgBuf b0, DbgBuf b1, DbgBuf b2, DbgBuf b3, DbgBuf b4, DbgBuf b5, unsigned* flag) {
    DbgBuf bs[6] = {b0, b1, b2, b3, b4, b5};
    unsigned mask = 0u;
    for (int k = 0; k < 6; ++k) { const DbgBuf b = bs[k]; if (!b.p) continue; bool bad = false;
        for (size_t i = (size_t)blockIdx.x * 512 + threadIdx.x; i < b.n; i += (size_t)gridDim.x * 512) {
            const float v = b.is_f32 ? ((const float*)b.p)[i] : __uint_as_float(((unsigned)((const unsigned short*)b.p)[i]) << 16);
            if (!(fabsf(v) < 1e30f)) bad = true; }
        if (bad) mask |= 1u << b.bit; }
    if (mask) atomicOr(flag, mask);
}
__global__ void __launch_bounds__(512) dbg_write(float* out, size_t n, const unsigned* flag) {
    for (size_t i = (size_t)blockIdx.x * 512 + threadIdx.x; i < n; i += (size_t)gridDim.x * 512) out[i] = (i == 0) ? 1000.0f * (float)(*flag) : 0.f;
}
#endif
extern "C" void kernel_launch(void* const* d_in, const int* in_sizes, int n_in, void* d_out, int out_size, void* d_ws, size_t ws_size, hipStream_t stream) {
    static int grid = 0;
    if (grid == 0) {
        if (n_in != 19 || out_size != M * DM || ws_size < WS_END) { fprintf(stderr, "kernel_launch: unexpected shapes (n_in %d, out %d, ws %zu)\n", n_in, out_size, ws_size); grid = -1; return; }
        int dev = 0, cus = 0, per_cu = 0;
        if (hipGetDevice(&dev) != hipSuccess || hipDeviceGetAttribute(&cus, hipDeviceAttributeMultiprocessorCount, dev) != hipSuccess) { grid = -1; return; }
        if (hipFuncSetAttribute((const void*)fwd_mega, hipFuncAttributeMaxDynamicSharedMemorySize, LDS_BYTES) != hipSuccess) { fprintf(stderr, "kernel_launch: hipFuncSetAttribute failed\n"); grid = -1; return; }
        if (hipOccupancyMaxActiveBlocksPerMultiprocessor(&per_cu, (const void*)fwd_mega, 512, LDS_BYTES) != hipSuccess || per_cu < 1) { fprintf(stderr, "kernel_launch: occupancy query failed (%d)\n", per_cu); (void)hipGetLastError(); per_cu = 1; }
        grid = cus * (per_cu < 1 ? 1 : per_cu);
        if (grid > 256) grid = 256;
        fprintf(stderr, "kernel_launch: %d CUs, %d blocks/CU by the occupancy query, grid %d\n", cus, per_cu, grid);
    }
    if (grid < 0) return;
    (void)hipMemsetAsync((char*)d_ws + WS_CTL, 0, CTL_BYTES, stream);
    Args a{};
    for (int i = 0; i < 19; ++i) a.in[i] = (const float*)d_in[i];
    a.out = (float*)d_out; a.ws = (unsigned char*)d_ws;
#if N_LAUNCH_MODE == 1
    a.ph_lo = 0; a.ph_hi = NPHASE;
    void* kargs[] = {&a};
    hipError_t e = hipLaunchCooperativeKernel((const void*)fwd_mega, dim3(grid), dim3(512), kargs, LDS_BYTES, stream);
    if (e != hipSuccess) fprintf(stderr, "kernel_launch: cooperative launch failed: %s (grid %d)\n", hipGetErrorString(e), grid);
#else
#ifdef DBG_STOP
    for (int ph = 0; ph < DBG_STOP; ++ph) { a.ph_lo = ph; a.ph_hi = ph + 1; hipLaunchKernelGGL(fwd_mega, dim3(grid), dim3(512), LDS_BYTES, stream, a); }
    { unsigned char* ws = (unsigned char*)d_ws; unsigned char* ob = (unsigned char*)d_out; unsigned* flag = (unsigned*)(ws + WS_CTL) + 100000;
      DBG_BUFS
      hipLaunchKernelGGL(dbg_scan, dim3(1024), dim3(512), 0, stream, B0, B1, B2, B3, B4, B5, flag);
      hipLaunchKernelGGL(dbg_write, dim3(1024), dim3(512), 0, stream, (float*)d_out, (size_t)M * DM, (const unsigned*)flag); }
#else
    for (int ph = 0; ph < NPHASE; ++ph) { a.ph_lo = ph; a.ph_hi = ph + 1; hipLaunchKernelGGL(fwd_mega, dim3(grid), dim3(512), LDS_BYTES, stream, a); }
#endif
#endif
}
```

```cpp
#include <hip/hip_runtime.h>
#include <hip/hip_cooperative_groups.h>
#include <cstdio>
#include <cstdint>
namespace cg = cooperative_groups;

#ifndef GEMM_REP
#define GEMM_REP 1
#endif
#ifndef REP_P0
#define REP_P0 1
#endif
#ifndef REP_P0A
#define REP_P0A 1
#endif
#ifndef REP_P0D
#define REP_P0D 1
#endif
#ifndef REP_P2I
#define REP_P2I 1
#endif
#ifndef REP_P3
#define REP_P3 1
#endif
#ifndef REP_P4
#define REP_P4 1
#endif
#ifndef REP_FF1
#define REP_FF1 1
#endif
#ifndef REP_FF2
#define REP_FF2 1
#endif
#ifndef REP_BAR
#define REP_BAR 1
#endif
#ifndef DBG_TS
#define DBG_TS -1
#endif
#ifndef DBG_SCALE
#define DBG_SCALE 2.5e-4f
#endif
#ifndef WGM_P1
#define WGM_P1 4
#endif
#ifndef WGM_P5
#define WGM_P5 4
#endif
#ifndef WGM_P7
#define WGM_P7 4
#endif
#ifndef WGM_P8
#define WGM_P8 4
#endif
#ifndef WGM_P10
#define WGM_P10 4
#endif
#ifndef STAG_NS
#define STAG_NS 0
#endif
#ifndef STAG_DIV
#define STAG_DIV 8
#endif
#ifndef NT_LOADS
#define NT_LOADS 1
#endif
#ifndef NT_MORE
#define NT_MORE 1
#endif
#ifndef REP_MIX
#define REP_MIX 1
#endif
#ifndef REP_ROW
#define REP_ROW 1
#endif
#ifndef NT_P2OUT
#define NT_P2OUT 0
#endif
#ifndef PK_BIAS
#define PK_BIAS 128.0f
#endif
#ifndef N_LAUNCH_MODE
#define N_LAUNCH_MODE 1
#endif

__device__ __forceinline__ int hw_tid(int wv) { return (wv << 6) | (int)__builtin_amdgcn_mbcnt_hi(~0u, __builtin_amdgcn_mbcnt_lo(~0u, 0u)); }

namespace pg8 {
#define PG8_LAS __attribute__((address_space(3)))
typedef unsigned short bf16_t;
typedef short bf16x8 __attribute__((ext_vector_type(8)));
typedef float f32x4 __attribute__((ext_vector_type(4)));
typedef unsigned u32x4 __attribute__((ext_vector_type(4)));
typedef unsigned u32x2 __attribute__((ext_vector_type(2)));
typedef int i32x4 __attribute__((ext_vector_type(4)));
template <bool I8> struct AccT { typedef f32x4 type; };
template <> struct AccT<true> { typedef i32x4 type; };
constexpr int BM = 256, BK = 64, HALF = 128, HTB = HALF * BK * 2, STAGE_BYTES = 8 * HTB, NXCD = 8;

__host__ __device__ __forceinline__ int lds_byte(int r, int c) { const int st = (r >> 4) * 2 + (c >> 5), rr = r & 15, cc = c & 31, ob = rr * 64 + cc * 2; return st * 1024 + (ob ^ (((ob >> 9) & 1) << 5)); }
__host__ __device__ __forceinline__ void stage_rc(int b, int& R, int& C) { const int st = b / 1024, sb = b % 1024, swz = sb ^ (((sb >> 9) & 1) << 5); R = (st >> 1) * 16 + swz / 64; C = (st & 1) * 32 + (swz % 64) / 2; }
__host__ __device__ __forceinline__ int perm32(int rho) { const int n = rho >> 4, i = rho & 15; return 8 * (i >> 2) + 4 * n + (i & 3); }

struct Unit { int pm, pn; };
struct Gemm { const void* A; const void* Bt; int lda, ldb, K, a_pn_off; };

struct StaticOrder {
    int nM, nN, nwg, G, c, WGM, rev;
    __host__ __device__ void init(int M, int N, int G_, int c_, int wgm = 4, int rev_ = 0) { nM = M / BM; nN = N / BM; nwg = nM * nN; G = G_; c = c_; WGM = wgm; rev = rev_; }
    __host__ __device__ bool next(int i, Unit& u) const {
        const long L = (long)i * G + c; if (L >= nwg) return false;
        int wgid = (int)L; { const int q = nwg / NXCD, r = nwg % NXCD, xcd = wgid % NXCD, off = wgid / NXCD; wgid = (xcd < r ? xcd * (q + 1) : r * (q + 1) + (xcd - r) * q) + off; }
        const int nig = WGM * nN, gid = wgid / nig, fm = gid * WGM, gsz = (nM - fm) < WGM ? (nM - fm) : WGM;
        u.pm = fm + ((wgid % nig) % gsz); u.pn = (wgid % nig) / gsz; if (rev) u.pm = nM - 1 - u.pm; return true;
    }
};

__device__ __forceinline__ unsigned cvt_pk_bf16(float lo, float hi) { unsigned r; asm volatile("v_cvt_pk_bf16_f32 %0, %1, %2" : "=v"(r) : "v"(lo), "v"(hi)); return r; }

template <int ACT  > struct EpiBf16 {
    static constexpr bool PERM = true;
    bf16_t* O; int ldc; const float* cscale; int split_cols; size_t split_stride; const float* rscale;
    __device__ __forceinline__ void operator()(const f32x4 (&acc)[2][2][4][2], const Unit& u, int wr, int wc, int fr, int fq) const {
        const int row0 = u.pm * BM + wr * 64 + fr; int colt = u.pn * BM; bf16_t* base = O;
        if (split_cols) { const int t = colt / split_cols; base += (size_t)t * split_stride; colt -= t * split_cols; }
        const int col0 = colt + wc * 32 + 8 * fq, bcol0 = u.pn * BM + wc * 32 + 8 * fq;
        f32x4 sv[2][2];
#pragma unroll
        for (int bj = 0; bj < 2; ++bj)
#pragma unroll
            for (int n = 0; n < 2; ++n) sv[bj][n] = cscale ? *(const f32x4*)(cscale + bcol0 + bj * HALF + 4 * n) : (f32x4){1.f, 1.f, 1.f, 1.f};
#pragma unroll
        for (int ai = 0; ai < 2; ++ai)
#pragma unroll
            for (int m = 0; m < 4; ++m) { bf16_t* rowp = base + (size_t)(row0 + ai * HALF + m * 16) * ldc + col0; const float rs = rscale ? rscale[row0 + ai * HALF + m * 16] : 1.0f;
#pragma unroll
                for (int bj = 0; bj < 2; ++bj) { f32x4 v0 = acc[ai][bj][m][0] * rs, v1 = acc[ai][bj][m][1] * rs;
                    if (ACT == 1) {
#pragma unroll
                        for (int j = 0; j < 4; ++j) { const float a = fmaxf(v0[j], 0.f), b = fmaxf(v1[j], 0.f); v0[j] = a * a; v1[j] = b * b; } }
                    v0 = v0 * sv[bj][0]; v1 = v1 * sv[bj][1];
                    u32x4 w; w.x = cvt_pk_bf16(v0[0], v0[1]); w.y = cvt_pk_bf16(v0[2], v0[3]); w.z = cvt_pk_bf16(v1[0], v1[1]); w.w = cvt_pk_bf16(v1[2], v1[3]);
                    *(u32x4*)(rowp + bj * HALF) = w; } }
    }
};
struct EpiF32 {
    static constexpr bool PERM = false;
    float* C; int ldc;
    __device__ __forceinline__ void operator()(const f32x4 (&acc)[2][2][4][2], const Unit& u, int wr, int wc, int fr, int fq) const {
        const int row0 = u.pm * BM + wr * 64 + fr, col0 = u.pn * BM + wc * 32 + 4 * fq;
#pragma unroll
        for (int ai = 0; ai < 2; ++ai)
#pragma unroll
            for (int m = 0; m < 4; ++m) { float* rowp = C + (size_t)(row0 + ai * HALF + m * 16) * ldc + col0;
#pragma unroll
                for (int bj = 0; bj < 2; ++bj)
#pragma unroll
                    for (int n = 0; n < 2; ++n) *(f32x4*)(rowp + bj * HALF + n * 16) = acc[ai][bj][m][n]; }
    }
};
struct EpiGateMul {
    static constexpr bool PERM = true;
    const bf16_t* E; bf16_t* O; int ldc; const float* rscale;
    __device__ __forceinline__ void operator()(const f32x4 (&acc)[2][2][4][2], const Unit& u, int wr, int wc, int fr, int fq) const {
        const int row0 = u.pm * BM + wr * 64 + fr, col0 = u.pn * BM + wc * 32 + 8 * fq;
#pragma unroll
        for (int ai = 0; ai < 2; ++ai)
#pragma unroll
            for (int m = 0; m < 4; ++m) { const size_t ro = (size_t)(row0 + ai * HALF + m * 16) * ldc + col0; const float rs = rscale[row0 + ai * HALF + m * 16];
#pragma unroll
                for (int bj = 0; bj < 2; ++bj) { const u32x4 e = *(const u32x4*)(E + ro + bj * HALF); const f32x4 a0 = acc[ai][bj][m][0] * rs, a1 = acc[ai][bj][m][1] * rs; float o[8];
#pragma unroll
                    for (int j = 0; j < 2; ++j) { o[2 * j] = __uint_as_float(e[j] << 16) * __builtin_amdgcn_rcpf(1.0f + __expf(-a0[2 * j])); o[2 * j + 1] = __uint_as_float(e[j] & 0xffff0000u) * __builtin_amdgcn_rcpf(1.0f + __expf(-a0[2 * j + 1]));
                        o[4 + 2 * j] = __uint_as_float(e[2 + j] << 16) * __builtin_amdgcn_rcpf(1.0f + __expf(-a1[2 * j])); o[4 + 2 * j + 1] = __uint_as_float(e[2 + j] & 0xffff0000u) * __builtin_amdgcn_rcpf(1.0f + __expf(-a1[2 * j + 1])); }
                    u32x4 w; w.x = cvt_pk_bf16(o[0], o[1]); w.y = cvt_pk_bf16(o[2], o[3]); w.z = cvt_pk_bf16(o[4], o[5]); w.w = cvt_pk_bf16(o[6], o[7]);
                    *(u32x4*)(O + ro + bj * HALF) = w; } }
    }
};

struct EpiI8Relu2 {
    static constexpr bool PERM = true;
    bf16_t* O; int ldc; const float* rowf; const float* colmax; const float* sk;
    __device__ __forceinline__ void operator()(const i32x4 (&acc)[2][2][4][2], const Unit& u, int wr, int wc, int fr, int fq) const {
        const int row0 = u.pm * BM + wr * 64 + fr, col0 = u.pn * BM + wc * 32 + 8 * fq;
        f32x4 cf[2][2];
#pragma unroll
        for (int bj = 0; bj < 2; ++bj)
#pragma unroll
            for (int n = 0; n < 2; ++n) { const f32x4 k4 = *(const f32x4*)(sk + col0 + bj * HALF + 4 * n); cf[bj][n] = *(const f32x4*)(colmax + col0 + bj * HALF + 4 * n) * (1.0f / 127.0f);
#pragma unroll
                for (int j = 0; j < 4; ++j) cf[bj][n][j] *= __builtin_sqrtf(k4[j]); }
#pragma unroll
        for (int ai = 0; ai < 2; ++ai)
#pragma unroll
            for (int m = 0; m < 4; ++m) { bf16_t* rowp = O + (size_t)(row0 + ai * HALF + m * 16) * ldc + col0; const float rs = rowf[row0 + ai * HALF + m * 16];
#pragma unroll
                for (int bj = 0; bj < 2; ++bj) { float o[8];
#pragma unroll
                    for (int j = 0; j < 4; ++j) { const float a = fmaxf((float)acc[ai][bj][m][0][j] * rs * cf[bj][0][j], 0.f), b = fmaxf((float)acc[ai][bj][m][1][j] * rs * cf[bj][1][j], 0.f); o[j] = a * a; o[4 + j] = b * b; }
                    u32x4 w; w.x = cvt_pk_bf16(o[0], o[1]); w.y = cvt_pk_bf16(o[2], o[3]); w.z = cvt_pk_bf16(o[4], o[5]); w.w = cvt_pk_bf16(o[6], o[7]);
                    *(u32x4*)(rowp + bj * HALF) = w; } }
    }
};

struct EpiI8Bf16 {
    static constexpr bool PERM = true;
    bf16_t* O; int ldc; const float* rowf; const float* colmax; const int* wsum; int split_cols; size_t split_stride;
    __device__ __forceinline__ void operator()(const i32x4 (&acc)[2][2][4][2], const Unit& u, int wr, int wc, int fr, int fq) const {
        const int row0 = u.pm * BM + wr * 64 + fr, col0 = u.pn * BM + wc * 32 + 8 * fq; int colt = u.pn * BM; bf16_t* base = O;
        if (split_cols) { const int t = colt / split_cols; base += (size_t)t * split_stride; colt -= t * split_cols; }
        const int ocol0 = colt + wc * 32 + 8 * fq;
        f32x4 cf[2][2]; i32x4 ws4[2][2];
#pragma unroll
        for (int bj = 0; bj < 2; ++bj)
#pragma unroll
            for (int n = 0; n < 2; ++n) { cf[bj][n] = colmax ? *(const f32x4*)(colmax + col0 + bj * HALF + 4 * n) * (1.0f / 127.0f) : (f32x4){1.f, 1.f, 1.f, 1.f}; ws4[bj][n] = wsum ? *(const i32x4*)(wsum + col0 + bj * HALF + 4 * n) * 128 : (i32x4){0, 0, 0, 0}; }
#pragma unroll
        for (int ai = 0; ai < 2; ++ai)
#pragma unroll
            for (int m = 0; m < 4; ++m) { bf16_t* rowp = base + (size_t)(row0 + ai * HALF + m * 16) * ldc + ocol0; const float rs = rowf[row0 + ai * HALF + m * 16];
#pragma unroll
                for (int bj = 0; bj < 2; ++bj) { float o[8];
#pragma unroll
                    for (int j = 0; j < 4; ++j) { o[j] = (float)(acc[ai][bj][m][0][j] + ws4[bj][0][j]) * rs * cf[bj][0][j]; o[4 + j] = (float)(acc[ai][bj][m][1][j] + ws4[bj][1][j]) * rs * cf[bj][1][j]; }
                    u32x4 w; w.x = cvt_pk_bf16(o[0], o[1]); w.y = cvt_pk_bf16(o[2], o[3]); w.z = cvt_pk_bf16(o[4], o[5]); w.w = cvt_pk_bf16(o[6], o[7]);
                    *(u32x4*)(rowp + bj * HALF) = w; } }
    }
};

struct EpiI8GateMul {
    static constexpr bool PERM = true;
    const bf16_t* E; bf16_t* O; int ldc; const float* rowf; const float* colmax;
    __device__ __forceinline__ void operator()(const i32x4 (&acc)[2][2][4][2], const Unit& u, int wr, int wc, int fr, int fq) const {
        const int row0 = u.pm * BM + wr * 64 + fr, col0 = u.pn * BM + wc * 32 + 8 * fq;
        f32x4 cf[2][2];
#pragma unroll
        for (int bj = 0; bj < 2; ++bj)
#pragma unroll
            for (int n = 0; n < 2; ++n) cf[bj][n] = *(const f32x4*)(colmax + col0 + bj * HALF + 4 * n) * (1.0f / 127.0f);
#pragma unroll
        for (int ai = 0; ai < 2; ++ai)
#pragma unroll
            for (int m = 0; m < 4; ++m) { const size_t ro = (size_t)(row0 + ai * HALF + m * 16) * ldc + col0; const float rs = rowf[row0 + ai * HALF + m * 16];
#pragma unroll
                for (int bj = 0; bj < 2; ++bj) { const u32x4 e = *(const u32x4*)(E + ro + bj * HALF); float o[8];
#pragma unroll
                    for (int j = 0; j < 2; ++j) {
                        const float g0 = (float)acc[ai][bj][m][0][2 * j] * rs * cf[bj][0][2 * j], g1 = (float)acc[ai][bj][m][0][2 * j + 1] * rs * cf[bj][0][2 * j + 1];
                        const float g2 = (float)acc[ai][bj][m][1][2 * j] * rs * cf[bj][1][2 * j], g3 = (float)acc[ai][bj][m][1][2 * j + 1] * rs * cf[bj][1][2 * j + 1];
                        o[2 * j] = __uint_as_float(e[j] << 16) * __builtin_amdgcn_rcpf(1.0f + __expf(-g0)); o[2 * j + 1] = __uint_as_float(e[j] & 0xffff0000u) * __builtin_amdgcn_rcpf(1.0f + __expf(-g1));
                        o[4 + 2 * j] = __uint_as_float(e[2 + j] << 16) * __builtin_amdgcn_rcpf(1.0f + __expf(-g2)); o[4 + 2 * j + 1] = __uint_as_float(e[2 + j] & 0xffff0000u) * __builtin_amdgcn_rcpf(1.0f + __expf(-g3)); }
                    u32x4 w; w.x = cvt_pk_bf16(o[0], o[1]); w.y = cvt_pk_bf16(o[2], o[3]); w.z = cvt_pk_bf16(o[4], o[5]); w.w = cvt_pk_bf16(o[6], o[7]);
                    *(u32x4*)(O + ro + bj * HALF) = w; } }
    }
};

template <class Epi, class Sched, bool I8 = false>
__device__ __forceinline__ void gemm_phase(PG8_LAS unsigned char* lds, const Gemm g, const Sched& S, const Epi& E, int wv) {
    constexpr int ES = I8 ? 1 : 2; typedef typename AccT<I8>::type acc_t;
    int tid_ = hw_tid(wv); asm volatile("" : "+v"(tid_));
    const int tid = tid_, wid = __builtin_amdgcn_readfirstlane(tid >> 6), lane = tid & 63, wr = wid >> 2, wc = wid & 3, fr = lane & 15, fq = lane >> 4;
    const int nt = g.K * ES / (BK * 2);
    unsigned voffA[2], voffB[2];
#pragma unroll
    for (int i = 0; i < 2; ++i) { int R, C; stage_rc(tid * 16 + i * 8192, R, C); const int Rb = Epi::PERM ? ((R & ~31) + perm32(R & 31)) : R;
        voffA[i] = (unsigned)(R * g.lda * ES + C * 2); voffB[i] = (unsigned)(Rb * g.ldb * ES + C * 2); }
    const size_t kstep = (size_t)(BK * 2);
    const size_t hA = (size_t)HALF * g.lda * ES, hB = (size_t)HALF * g.ldb * ES;
    const size_t tA = 2 * hA, tB = 2 * hB;
    const size_t pnA = (size_t)g.a_pn_off * ES;
    const unsigned ldsw = (unsigned)wid * 1024u;
    const int aoff = lds_byte(wr * 64 + fr, fq * 8), boff = lds_byte(wc * 32 + fr, fq * 8);
#define PG8_SA(b, h) (((b) * 2 + (h)) * HTB)
#define PG8_SB(b, h) ((4 + (b) * 2 + (h)) * HTB)
#define PG8_STAGE(bufoff, gbase, voff) do { _Pragma("unroll") for (int _i = 0; _i < 2; ++_i) \
        __builtin_amdgcn_global_load_lds((const unsigned*)((const char*)(gbase) + (voff)[_i]), (PG8_LAS unsigned*)(lds + (bufoff) + ldsw + _i * 8192), 16, 0, 0); } while (0)
#define PG8_LDA(dst, b, h) do { _Pragma("unroll") for (int m = 0; m < 4; ++m) _Pragma("unroll") for (int k = 0; k < 2; ++k) dst[m][k] = *(const PG8_LAS bf16x8*)(lds + PG8_SA(b, h) + aoff + m * 2048 + k * 1024); } while (0)
#define PG8_LDB(dst, b, h) do { _Pragma("unroll") for (int n = 0; n < 2; ++n) _Pragma("unroll") for (int k = 0; k < 2; ++k) dst[n][k] = *(const PG8_LAS bf16x8*)(lds + PG8_SB(b, h) + boff + n * 2048 + k * 1024); } while (0)
#define PG8_MMA(ai, bj, At, Bt) do { __builtin_amdgcn_s_setprio(1); _Pragma("unroll") for (int m = 0; m < 4; ++m) _Pragma("unroll") for (int n = 0; n < 2; ++n) _Pragma("unroll") for (int k = 0; k < 2; ++k) \
        { if constexpr (I8) acc[ai][bj][m][n] = __builtin_amdgcn_mfma_i32_16x16x64_i8(__builtin_bit_cast(i32x4, Bt[n][k]), __builtin_bit_cast(i32x4, At[m][k]), acc[ai][bj][m][n], 0, 0, 0); \
          else acc[ai][bj][m][n] = __builtin_amdgcn_mfma_f32_16x16x32_bf16(Bt[n][k], At[m][k], acc[ai][bj][m][n], 0, 0, 0); } __builtin_amdgcn_s_setprio(0); } while (0)
#define PG8_WAIT_V(n) asm volatile("s_waitcnt vmcnt(" #n ")" ::: "memory")
#define PG8_WAIT_L(n) asm volatile("s_waitcnt lgkmcnt(" #n ")" ::: "memory")
#define PG8_BAR __builtin_amdgcn_s_barrier()
#define PG8_SCHED __builtin_amdgcn_sched_barrier(0)
    Unit cur, nxt; int ui = 0;
    if (!S.next(0, cur)) return;
    if (STAG_NS > 0) { const unsigned long long t0 = __builtin_amdgcn_s_memrealtime(); const unsigned long long dl = (unsigned long long)((blockIdx.x / STAG_DIV) % 8) * STAG_NS / 10;
        while (__builtin_amdgcn_s_memrealtime() - t0 < dl) __builtin_amdgcn_s_sleep(2); }
    acc_t acc[2][2][4][2];
#pragma unroll
    for (int a = 0; a < 2; ++a)
#pragma unroll
        for (int b = 0; b < 2; ++b)
#pragma unroll
            for (int m = 0; m < 4; ++m)
#pragma unroll
                for (int n = 0; n < 2; ++n) acc[a][b][m][n] = (acc_t){0, 0, 0, 0};
    bf16x8 At[4][2], B0[2][2], B1[2][2];
    const char* cA = (const char*)g.A + (size_t)cur.pm * tA + (size_t)cur.pn * pnA; const char* cB = (const char*)g.Bt + (size_t)cur.pn * tB;
    PG8_STAGE(PG8_SB(0, 0), cB, voffB); PG8_STAGE(PG8_SB(0, 1), cB + hB, voffB); PG8_STAGE(PG8_SA(0, 0), cA, voffA); PG8_STAGE(PG8_SA(0, 1), cA + hA, voffA);
    if (wr == 1) PG8_BAR;
    PG8_WAIT_V(2); PG8_BAR;
    PG8_STAGE(PG8_SB(1, 0), cB + kstep, voffB); PG8_STAGE(PG8_SA(1, 0), cA + kstep, voffA); PG8_STAGE(PG8_SB(1, 1), cB + hB + kstep, voffB);
    PG8_WAIT_V(6); PG8_BAR;
    for (;;) {
        const bool has_next = S.next(ui + 1, nxt);
        const char* nA = has_next ? (const char*)g.A + (size_t)nxt.pm * tA + (size_t)nxt.pn * pnA : cA; const char* nB = has_next ? (const char*)g.Bt + (size_t)nxt.pn * tB : cB;
        for (int t = 0; t < nt; t += 2) {
            const bool last = (t == nt - 2);
            const char* a1 = cA + (size_t)(t + 1) * kstep;
            const char* a2 = last ? nA : cA + (size_t)(t + 2) * kstep; const char* b2 = last ? nB : cB + (size_t)(t + 2) * kstep;
            const char* a3 = a2 + kstep; const char* b3 = b2 + kstep;
            PG8_LDB(B0, 0, 0); PG8_LDB(B1, 0, 1); PG8_SCHED; PG8_LDA(At, 0, 0); PG8_STAGE(PG8_SA(1, 1), a1 + hA, voffA);
            PG8_WAIT_V(8); PG8_WAIT_L(0); PG8_BAR; PG8_MMA(0, 0, At, B0); PG8_MMA(0, 1, At, B1); PG8_BAR; PG8_SCHED;
            PG8_LDA(At, 0, 1); PG8_STAGE(PG8_SB(0, 0), b2, voffB); PG8_STAGE(PG8_SB(0, 1), b2 + hB, voffB); PG8_STAGE(PG8_SA(0, 0), a2, voffA);
            PG8_WAIT_V(8); PG8_WAIT_L(0); PG8_BAR; PG8_MMA(1, 0, At, B0); PG8_MMA(1, 1, At, B1); PG8_BAR; PG8_SCHED;
            PG8_LDB(B0, 1, 0); PG8_LDB(B1, 1, 1); PG8_SCHED; PG8_LDA(At, 1, 0); PG8_STAGE(PG8_SA(0, 1), a2 + hA, voffA);
            PG8_WAIT_V(8); PG8_WAIT_L(0); PG8_BAR; PG8_MMA(0, 0, At, B0); PG8_MMA(0, 1, At, B1); PG8_BAR; PG8_SCHED;
            PG8_LDA(At, 1, 1); PG8_STAGE(PG8_SB(1, 0), b3, voffB); PG8_STAGE(PG8_SB(1, 1), b3 + hB, voffB); PG8_STAGE(PG8_SA(1, 0), a3, voffA);
            PG8_WAIT_V(8); PG8_WAIT_L(0); PG8_BAR; PG8_MMA(1, 0, At, B0); PG8_MMA(1, 1, At, B1); PG8_BAR; PG8_SCHED;
        }
        if (wr == 0) PG8_BAR;
        E(acc, cur, wr, wc, fr, fq);
        if (!has_next) break;
#pragma unroll
        for (int a = 0; a < 2; ++a)
#pragma unroll
            for (int b = 0; b < 2; ++b)
#pragma unroll
                for (int m = 0; m < 4; ++m)
#pragma unroll
                    for (int n = 0; n < 2; ++n) acc[a][b][m][n] = (acc_t){0, 0, 0, 0};
        cur = nxt; cA = nA; cB = nB; ++ui;
        if (wr == 1) PG8_BAR;
    }
    PG8_WAIT_V(0);
    PG8_BAR;
#undef PG8_SA
#undef PG8_SB
#undef PG8_STAGE
#undef PG8_LDA
#undef PG8_LDB
#undef PG8_MMA
#undef PG8_WAIT_V
#undef PG8_WAIT_L
#undef PG8_BAR
#undef PG8_SCHED
}
}

constexpr int NB = 8, SEQ = 2048, DM = 2048, PD = 256, NH = 8, DH = 128, MW = 1024, PW = 1024, DFF = 8192, CH = 64, NCH = 32;
constexpr int M = NB * SEQ;
constexpr int INC = 5136, NIN = 5120;
constexpr int C_GATE = 4096, C_U = 4112;
constexpr int NITEM = NB * NH * NCH;
constexpr float EPS = 1e-6f;
constexpr size_t MiB = 1u << 20;
constexpr size_t WS_CTL = 0, CTL_BYTES = 384 * 1024;
constexpr size_t WS_WIN = 2 * MiB, WS_WOUT = 22 * MiB, WS_WFF1 = 30 * MiB, WS_WFF2 = 62 * MiB, WS_WPG = 94 * MiB, WS_WPP = 102 * MiB, WS_WPOOL = 103 * MiB;
constexpr size_t WS_GATES = 104 * MiB, WS_NLOC = 105 * MiB, WS_NPREV = 106 * MiB, WS_SCAL = 107 * MiB, WS_PB = 108 * MiB;
constexpr size_t WS_QK0 = 107 * MiB + 896 * 1024;
constexpr size_t WS_RS0 = 107 * MiB + 768 * 1024;
constexpr size_t WS_XB = 436 * MiB;
constexpr size_t WS_RS1 = 107 * MiB + 256 * 1024, WS_RS2 = 107 * MiB + 512 * 1024;
constexpr size_t WS_A0 = 116 * MiB;
constexpr size_t WS_Q = 180 * MiB, WS_K = 212 * MiB, WS_V = 244 * MiB, WS_O = 276 * MiB, WS_U = 308 * MiB;
constexpr size_t WS_CPREV = 180 * MiB;
constexpr size_t WS_QC = 340 * MiB, WS_KC = 372 * MiB;
constexpr size_t WS_HB = 180 * MiB;
constexpr size_t WS_E = 180 * MiB;
constexpr size_t WS_HN = 436 * MiB;
constexpr size_t WS_END = 500 * MiB;
constexpr size_t DO_MIX = 0, DO_POOLED = 64 * MiB, DO_VT = 96 * MiB;
constexpr size_t WS_H2Q = 372 * MiB;
constexpr size_t DO_H1Q = 64 * MiB;
constexpr size_t CTL_CM1 = 131072, CTL_CM2 = 196608;
constexpr size_t WS_H1B = WS_XB;
constexpr size_t WS_H2B = 308 * MiB;
constexpr size_t WS_TOT = 404 * MiB;
constexpr size_t WS_NTOT = WS_TOT + 8 * MiB;
constexpr size_t WS_GB = WS_TOT + 9 * MiB;
constexpr int P4X_N = 131072 + 4096, P4X_M = P4X_N + 4096, P4X_A = P4X_M + 32, P4X_B = P4X_M + 64;
constexpr size_t HBP = (size_t)DFF * 2;
constexpr size_t CTL_CM3 = 204800;
constexpr size_t CTL_WSUM = 212992;
constexpr size_t WS_SK = 107 * MiB + 448 * 1024;
constexpr size_t CTL_CM0 = 221184;
constexpr size_t DO_XQ = 0;
constexpr size_t WS_RSX = 107 * MiB + 320 * 1024;
constexpr size_t WS_WINQ = WS_WIN + (size_t)2048 * 2048 * 2;
constexpr size_t DO_HBQ = 0;
constexpr size_t CTL_RMAX = 262144;
constexpr size_t WS_RSH = 107 * MiB + 384 * 1024;
constexpr int LDS_BYTES = 147456;
constexpr int MISC_OFF = 131072 + 320;

typedef unsigned short bf16;
typedef short bf16x8 __attribute__((ext_vector_type(8)));
typedef float f32x4 __attribute__((ext_vector_type(4)));
typedef unsigned u32x4 __attribute__((ext_vector_type(4)));
typedef unsigned u32x2 __attribute__((ext_vector_type(2)));
#define LAS __attribute__((address_space(3)))
#define LDS_WAIT() asm volatile("s_waitcnt lgkmcnt(0)" ::: "memory")

template <class T> __device__ __forceinline__ T ld_once(const T* p) {
#if NT_MORE
    return __builtin_nontemporal_load(p);
#else
    return *p;
#endif
}
template <class T> __device__ __forceinline__ T ld_stream(const T* p) {
#if NT_LOADS
    return __builtin_nontemporal_load(p);
#else
    return *p;
#endif
}
__device__ __forceinline__ float bf2f(unsigned short b) { return __uint_as_float(((unsigned)b) << 16); }
__device__ __forceinline__ float bflo(unsigned w) { return __uint_as_float(w << 16); }
__device__ __forceinline__ float bfhi(unsigned w) { return __uint_as_float(w & 0xffff0000u); }
typedef __bf16 bf16v2_t __attribute__((ext_vector_type(2)));
typedef float f32v2_t __attribute__((ext_vector_type(2)));
__device__ __forceinline__ unsigned pk2(float lo, float hi) { const bf16v2_t r = __builtin_convertvector((f32v2_t){lo, hi}, bf16v2_t); return __builtin_bit_cast(unsigned, r); }
__device__ __forceinline__ float wave_sum(float v) {
#pragma unroll
    for (int o = 1; o < 64; o <<= 1) v += __shfl_xor(v, o);
    return v;
}
__device__ __forceinline__ float wave_max(float v) {
#pragma unroll
    for (int o = 1; o < 64; o <<= 1) v = fmaxf(v, __shfl_xor(v, o));
    return v;
}
__device__ __forceinline__ float frcp(float x) { return __builtin_amdgcn_rcpf(x); }
__device__ __forceinline__ float sigm(float x) { return frcp(1.0f + __expf(-x)); }
__device__ __forceinline__ float logsigm(float x) { return fminf(x, 0.f) - log1pf(__expf(-fabsf(x))); }

#define XB_TMO      128
#define XB_XCNT(j)  (256  + 64 * (j))
#define XB_XSUB(j)  (1280 + 64 * (j))
#define XB_XGEN(j)  (2304 + 64 * (j))
#define XB_TOP      3328
#define XB_TOPGEN   3392
#define XCD_BAR_WORDS 3456
#define XB_SPIN_CAP (1u << 18)
__device__ __forceinline__ unsigned xb_ld(unsigned* p)              { return __hip_atomic_load(p, __ATOMIC_RELAXED, __HIP_MEMORY_SCOPE_AGENT); }
__device__ __forceinline__ unsigned xb_add(unsigned* p, unsigned v) { return __hip_atomic_fetch_add(p, v, __ATOMIC_RELAXED, __HIP_MEMORY_SCOPE_AGENT); }
__device__ __forceinline__ unsigned xb_xcc_id() { return (unsigned)__builtin_amdgcn_s_getreg((3 << 11) | 20) & 0xFu; }
#define XB_SPIN(cond, bar) do { unsigned _sp = 0; while (cond) { __builtin_amdgcn_s_sleep(1); \
    if ((++_sp & 255u) == 0u) { if (xb_ld(&(bar)[XB_TMO])) break; if (_sp > XB_SPIN_CAP) { atomicAdd(&(bar)[XB_TMO], 1u); break; } } } } while (0)
struct XcdBarrier { unsigned* bar; unsigned x; volatile LAS unsigned* st; int wv; };
__device__ __forceinline__ XcdBarrier xcd_barrier_post(unsigned* bar, volatile LAS unsigned* st) {
    XcdBarrier b; b.bar = bar; b.x = xb_xcc_id(); b.st = st;
    if (threadIdx.x == 0) (void)xb_add(&bar[XB_XCNT(b.x)], 1u);
    return b;
}
__device__ __forceinline__ void xcd_barrier_complete(unsigned* bar, unsigned x, unsigned& nloc, unsigned& nx) {
    const unsigned G = gridDim.x * gridDim.y * gridDim.z;
    unsigned sum, cnt, mine, sp = 0u;
    for (;;) {
        sum = 0u; cnt = 0u; mine = 0u;
#pragma unroll
        for (unsigned j = 0; j < 16; ++j) { const unsigned c = xb_ld(&bar[XB_XCNT(j)]); sum += c; cnt += (c > 0u) ? 1u : 0u; mine = (j == x) ? c : mine; }
        if (sum == G) break;
        __builtin_amdgcn_s_sleep(1);
        if ((++sp & 255u) == 0u) { if (xb_ld(&bar[XB_TMO])) break; if (sp > XB_SPIN_CAP) { atomicAdd(&bar[XB_TMO], 1u); break; } }
    }
    nloc = mine > 0u ? mine : 1u; nx = cnt > 0u ? cnt : 1u;
}
__device__ __forceinline__ void xcd_barrier(const XcdBarrier& b) {
    asm volatile("s_waitcnt vmcnt(0)" ::: "memory");
    __syncthreads();
    if (hw_tid(b.wv) == 0) {
        unsigned* bar = b.bar;
        __builtin_amdgcn_s_waitcnt(0);
        unsigned nloc = b.st[0], nx = b.st[1];
        if (nloc == 0u) { xcd_barrier_complete(bar, b.x, nloc, nx); b.st[0] = nloc; b.st[1] = nx; }
        const unsigned old = xb_add(&bar[XB_XSUB(b.x)], 1u);
        const unsigned gen = old / nloc;
        if (old + 1u == (gen + 1u) * nloc) {
            __builtin_amdgcn_fence(__ATOMIC_RELEASE, "agent");
            asm volatile("s_waitcnt vmcnt(0)" ::: "memory");
            const unsigned og = xb_add(&bar[XB_TOP], 1u);
            const unsigned tg = og / nx;
            if (og + 1u == (tg + 1u) * nx) xb_add(&bar[XB_TOPGEN], 1u);
            else XB_SPIN(xb_ld(&bar[XB_TOPGEN]) == tg, bar);
            __builtin_amdgcn_fence(__ATOMIC_ACQUIRE, "agent");
            xb_add(&bar[XB_XGEN(b.x)], 1u);
            asm volatile("s_waitcnt vmcnt(0)" ::: "memory");
        } else {
            XB_SPIN(xb_ld(&bar[XB_XGEN(b.x)]) == gen, bar);
            __builtin_amdgcn_fence(__ATOMIC_ACQUIRE, "agent");
            asm volatile("s_waitcnt vmcnt(0)" ::: "memory");
        }
    }
    __syncthreads();
}

struct Args { const float* in[19]; float* out; unsigned char* ws; int ph_lo, ph_hi; };
struct Frame {
    LAS unsigned char* lds;
    int tid, lane, wave, G, bid;
    const float *x, *p, *w_in, *b_gates, *w_conv, *g_mlstm, *w_pool, *pool_scale, *w_out, *g_mix_pre, *g_mix_post, *w_ff1, *w_ff2, *g_ff_pre, *g_ff_post, *w_ple_proj, *w_ple_gate, *g_ple_gate, *g_ple_post;
    float* out; unsigned char* ws; unsigned char* ob;
};
#define MK_FRAME(F) Frame F; { int t_ = hw_tid(wv_); asm volatile("" : "+v"(t_)); F.lds = (LAS unsigned char*)lds_raw; F.tid = t_; F.lane = t_ & 63; F.wave = __builtin_amdgcn_readfirstlane(t_ >> 6); F.G = gridDim.x; F.bid = blockIdx.x; \
    F.out = args.out; F.ws = args.ws; F.ob = (unsigned char*)args.out; }

struct TrItem { const float* src; bf16* dst; const float* gk; int ldw, ldt; unsigned* cm; };
__device__ __forceinline__ bool tr_decode(const Frame& F, int hi, int lane, TrItem& t) {
    constexpr int I0 = 32 * 32  , I1 = 32 * 16, I2 = 32 * 32, I3 = 32 * 32  , I4 = 0  , I5 = 32 * 32, I6 = 4 * 32, I7 = 0  ;
    constexpr int NIT = I0 + I1 + I2 + I3 + I4 + I5 + I6 + I7;
    const int it = hi >> 1, half = hi & 1;
    if (it >= NIT) return false;
    unsigned char* ws = F.ws; int r = it; const float* W; int ldw, ns0, ldt, nd0, kb, nb; bf16* WT; const float* gk = nullptr; unsigned* cmb = nullptr;
    if (r < I0) { W = F.w_in; ldw = INC; ns0 = 0; WT = (bf16*)(ws + WS_WIN); ldt = DM; nd0 = 0; kb = r / 32; nb = r % 32; gk = F.g_mix_pre; }
    else if ((r -= I0) < I1) { W = F.w_in; ldw = INC; ns0 = C_U; WT = (bf16*)(ws + WS_WIN); ldt = DM; nd0 = 4096; kb = r / 16; nb = r % 16; gk = F.g_mix_pre; }
    else if ((r -= I1) < I2) { W = F.w_out; ldw = DM; ns0 = 0; WT = (bf16*)(ws + WS_WOUT); ldt = DM; nd0 = 0; kb = r / 32; nb = r % 32; }
    else if ((r -= I2) < I3) { W = F.w_in; ldw = INC; ns0 = 2048; WT = (bf16*)(ws + WS_WIN); ldt = DM; nd0 = 2048; kb = r / 32; nb = r % 32; gk = F.g_mix_pre; cmb = (unsigned*)(ws + WS_CTL + CTL_CM0); }
    else if ((r -= I3) < I4) { W = F.w_ff2; ldw = DM; ns0 = 0; WT = (bf16*)(ws + WS_WFF2); ldt = DFF; nd0 = 0; kb = r / 32; nb = r % 32; cmb = (unsigned*)(ws + WS_CTL + CTL_CM3); }
    else if ((r -= I4) < I5) { W = F.w_ple_gate; ldw = DM; ns0 = 0; WT = (bf16*)(ws + WS_WPG); ldt = DM; nd0 = 0; kb = r / 32; nb = r % 32; gk = F.g_ple_gate; cmb = (unsigned*)(ws + WS_CTL + CTL_CM2); }
    else if ((r -= I5) < I6) { W = F.w_ple_proj; ldw = DM; ns0 = 0; WT = (bf16*)(ws + WS_WPP); ldt = PD; nd0 = 0; kb = r / 32; nb = r % 32; }
    else { r -= I6; const int g = r / 16, rr = r % 16; W = F.w_pool + (size_t)g * 256 * 256; ldw = 256; ns0 = 0; WT = (bf16*)(ws + WS_WPOOL); ldt = 256; nd0 = g * 256; kb = rr / 4; nb = rr % 4; }
    const int k0 = 64 * kb, n4 = lane & 7, lr = lane >> 3, nh = 64 * nb + 32 * half;
    t.src = W + (size_t)(k0 + 8 * lr) * ldw + ns0 + nh + 4 * n4; t.dst = WT + (size_t)(nd0 + nh + lr) * ldt + k0 + 8 * n4; t.ldw = ldw; t.ldt = ldt; t.gk = gk ? gk + k0 + 8 * lr : nullptr; t.cm = cmb ? cmb + nh + 4 * n4 : nullptr;
    return true;
}
__device__ __forceinline__ void tr_load(const TrItem& t, f32x4 (&v)[8]) {
#pragma unroll
    for (int i = 0; i < 8; ++i) v[i] = ld_stream((const f32x4*)(t.src + (size_t)i * t.ldw));
}
__device__ __forceinline__ void tr_store(const Frame& F, const TrItem& t, f32x4 (&v)[8]) {
    const int lane = F.lane;
    if (t.gk) { const f32x4 g0 = *(const f32x4*)t.gk, g1 = *(const f32x4*)(t.gk + 4);
#pragma unroll
        for (int i = 0; i < 4; ++i) { v[i] = v[i] * g0[i]; v[4 + i] = v[4 + i] * g1[i]; } }
    if (t.cm) { f32x4 m = (f32x4){0.f, 0.f, 0.f, 0.f};
#pragma unroll
        for (int i = 0; i < 8; ++i)
#pragma unroll
            for (int j = 0; j < 4; ++j) m[j] = fmaxf(m[j], fabsf(v[i][j]));
#pragma unroll
        for (int j = 0; j < 4; ++j) { m[j] = fmaxf(m[j], __shfl_xor(m[j], 8)); m[j] = fmaxf(m[j], __shfl_xor(m[j], 16)); m[j] = fmaxf(m[j], __shfl_xor(m[j], 32)); }
        if (lane < 8) {
#pragma unroll
            for (int j = 0; j < 4; ++j) atomicMax(t.cm + j, __float_as_uint(m[j])); }
        return; }
    LAS unsigned char* T = F.lds + F.wave * 4096;
    const int n4 = lane & 7, r = lane >> 3;
#pragma unroll
    for (int j = 0; j < 4; ++j) { u32x4 o; o.x = pk2(v[0][j], v[1][j]); o.y = pk2(v[2][j], v[3][j]); o.z = pk2(v[4][j], v[5][j]); o.w = pk2(v[6][j], v[7][j]);
        *(LAS u32x4*)(T + (4 * n4 + j) * 128 + ((r ^ n4) << 4)) = o; }
#pragma unroll
    for (int s2 = 0; s2 < 4; ++s2) { const int nl = 8 * s2 + r; const u32x4 o = *(const LAS u32x4*)(T + nl * 128 + ((n4 ^ ((nl >> 2) & 7)) << 4));
        *(u32x4*)(t.dst + (size_t)(8 * s2) * t.ldt) = o; }
}
__device__ __forceinline__ void p0_transposes(Frame& F, int gw, int NGW) {
    TrItem t0, t1, t2; f32x4 v0[8], v1[8], v2[8];
    int hi = gw;
    bool m0 = tr_decode(F, hi, F.lane, t0);
    if (!m0) return;
    tr_load(t0, v0);
    hi += NGW; bool m1 = tr_decode(F, hi, F.lane, t1);
    if (m1) tr_load(t1, v1);
    for (;;) {
        hi += NGW; bool m2 = tr_decode(F, hi, F.lane, t2);
        if (m2) tr_load(t2, v2);
        tr_store(F, t0, v0);
        if (!m1) break;
        hi += NGW; m0 = tr_decode(F, hi, F.lane, t0);
        if (m0) tr_load(t0, v0);
        tr_store(F, t1, v1);
        if (!m2) break;
        hi += NGW; m1 = tr_decode(F, hi, F.lane, t1);
        if (m1) tr_load(t1, v1);
        tr_store(F, t2, v2);
        if (!m0) break;
    }
}

__device__ __forceinline__ unsigned pack4_i8(float a, float b, float c, float d) {
    unsigned r = 0u;
    r = __builtin_amdgcn_cvt_pk_u8_f32(a + PK_BIAS, 0u, r); r = __builtin_amdgcn_cvt_pk_u8_f32(b + PK_BIAS, 1u, r);
    r = __builtin_amdgcn_cvt_pk_u8_f32(c + PK_BIAS, 2u, r); r = __builtin_amdgcn_cvt_pk_u8_f32(d + PK_BIAS, 3u, r);
    return r ^ 0x80808080u;
}
__device__ __forceinline__ int xq_src(int p) { return 256 * (4 * (p >> 10) + ((p >> 2) & 3)) + 4 * ((p & 1023) >> 4) + (p & 3); }
__device__ __forceinline__ void quant_weight(Frame& F, const float* W, int ldw, int K, int N, const float* gk, const float* cm, signed char* WQ, int* wsum = nullptr, bool kperm = false) {
    const int gw = F.bid * 8 + F.wave, NGW = F.G * 8, lane = F.lane, nnb = N / 64, nit = (K / 32) * nnb;
    for (int it = gw; it < nit; it += NGW) { const int kb = it / nnb, nb = it % nnb, k0 = 32 * kb, n = 64 * nb + lane;
        const float cmax = cm[n], q = cmax > 0.f ? 127.0f / cmax : 0.f;
        float v[32];
#pragma unroll
        for (int i = 0; i < 32; ++i) { const int k = kperm ? xq_src(k0 + i) : k0 + i; v[i] = ld_stream(W + (size_t)k * ldw + n) * (gk ? gk[k] : 1.0f); }
#pragma unroll
        for (int i = 0; i < 32; ++i) v[i] = v[i] * q;
#pragma unroll
        for (int j = 0; j < 2; ++j) { u32x4 o;
#pragma unroll
            for (int w = 0; w < 4; ++w) o[w] = pack4_i8(v[16 * j + 4 * w], v[16 * j + 4 * w + 1], v[16 * j + 4 * w + 2], v[16 * j + 4 * w + 3]);
            *(u32x4*)(WQ + (size_t)n * K + k0 + 16 * j) = o; }
        if (wsum) { int sacc = 0;
#pragma unroll
            for (int i = 0; i < 32; ++i) sacc += (int)rintf(v[i]);
            atomicAdd(wsum + n, sacc); } }
}

constexpr int QL_PM = 131072 + 1024, QL_CM = 131072 + 2048;
__device__ __forceinline__ void quant_ff1_local(Frame& F, const float* W, const float* gk, float* cmout, signed char* WQ) {
    const int lane = F.lane, wave = F.wave, n4 = lane & 7, r = lane >> 3;
    LAS unsigned char* T = F.lds;
    for (int cb = F.bid; cb < DFF / 32; cb += F.G) {
        const float* src = W + (size_t)(256 * wave + 8 * r) * DFF + 32 * cb + 4 * n4;
        const float* gp = gk + 256 * wave + 8 * r;
        f32x4 va[8], vb[8]; f32x4 mx = (f32x4){0.f, 0.f, 0.f, 0.f};
#define QL_LOAD(v, hk) do { _Pragma("unroll") for (int i = 0; i < 8; ++i) v[i] = ld_stream((const f32x4*)(src + (size_t)(64 * (hk) + i) * DFF)); } while (0)
#define QL_PUT(v, hk) do { const f32x4 g0 = *(const f32x4*)(gp + 64 * (hk)), g1 = *(const f32x4*)(gp + 64 * (hk) + 4); \
        _Pragma("unroll") for (int i = 0; i < 4; ++i) { v[i] = v[i] * g0[i]; v[4 + i] = v[4 + i] * g1[i]; } \
        _Pragma("unroll") for (int i = 0; i < 8; ++i) { _Pragma("unroll") for (int j = 0; j < 4; ++j) mx[j] = fmaxf(mx[j], fabsf(v[i][j])); } \
        const int ck = 32 * wave + 8 * (hk) + r; \
        _Pragma("unroll") for (int j = 0; j < 4; ++j) { u32x4 o; o.x = pk2(v[0][j], v[1][j]); o.y = pk2(v[2][j], v[3][j]); o.z = pk2(v[4][j], v[5][j]); o.w = pk2(v[6][j], v[7][j]); \
            *(LAS u32x4*)(T + (4 * n4 + j) * 4096 + ((ck ^ n4) << 4)) = o; } } while (0)
        QL_LOAD(va, 0); QL_LOAD(vb, 1);
        QL_PUT(va, 0); QL_LOAD(va, 2);
        QL_PUT(vb, 1); QL_LOAD(vb, 3);
        QL_PUT(va, 2); QL_PUT(vb, 3);
#undef QL_LOAD
#undef QL_PUT
#pragma unroll
        for (int j = 0; j < 4; ++j) { mx[j] = fmaxf(mx[j], __shfl_xor(mx[j], 8)); mx[j] = fmaxf(mx[j], __shfl_xor(mx[j], 16)); mx[j] = fmaxf(mx[j], __shfl_xor(mx[j], 32)); }
        if (lane < 8) *(LAS f32x4*)(T + QL_PM + (wave * 32 + 4 * n4) * 4) = mx;
        __syncthreads();
        if (F.tid < 32) { float m = 0.f;
#pragma unroll
            for (int w = 0; w < 8; ++w) m = fmaxf(m, *(const LAS float*)(T + QL_PM + (w * 32 + F.tid) * 4));
            cmout[32 * cb + F.tid] = m; *(LAS float*)(T + QL_CM + F.tid * 4) = m > 0.f ? 127.0f / m : 0.f; }
        __syncthreads();
#pragma unroll
        for (int jj = 0; jj < 4; ++jj) { const int n = 4 * wave + jj; const float q = *(const LAS float*)(T + QL_CM + n * 4);
#pragma unroll
            for (int it = 0; it < 2; ++it) { const int c0 = 128 * it + 2 * lane;
                const u32x4 a = *(const LAS u32x4*)(T + n * 4096 + ((c0 ^ (wave & 7)) << 4)), b = *(const LAS u32x4*)(T + n * 4096 + (((c0 + 1) ^ (wave & 7)) << 4));
                u32x4 o;
                o.x = pack4_i8(bflo(a.x) * q, bfhi(a.x) * q, bflo(a.y) * q, bfhi(a.y) * q); o.y = pack4_i8(bflo(a.z) * q, bfhi(a.z) * q, bflo(a.w) * q, bfhi(a.w) * q);
                o.z = pack4_i8(bflo(b.x) * q, bfhi(b.x) * q, bflo(b.y) * q, bfhi(b.y) * q); o.w = pack4_i8(bflo(b.z) * q, bfhi(b.z) * q, bflo(b.w) * q, bfhi(b.w) * q);
                *(u32x4*)(WQ + (size_t)(32 * cb + n) * DM + 8 * c0) = o; } }
        __syncthreads();
    }
}

__device__ __forceinline__ void quant_w2_rows(Frame& F, const float* W, float* sk, signed char* WQ, int* wsum) {
    const int lane = F.lane, wave = F.wave, tid = F.tid;
    LAS unsigned* D = (LAS unsigned*)F.lds;
    for (int t = F.bid; t < DFF / 32; t += F.G) { const int k0 = 32 * t + 4 * wave;
        f32x4 v[4][8];
#pragma unroll
        for (int r = 0; r < 4; ++r)
#pragma unroll
            for (int i = 0; i < 8; ++i) v[r][i] = ld_stream((const f32x4*)(W + (size_t)(k0 + r) * DM + 256 * i + 4 * lane));
        float q[4];
#pragma unroll
        for (int r = 0; r < 4; ++r) { float mx = 0.f;
#pragma unroll
            for (int i = 0; i < 8; ++i) mx = fmaxf(mx, fmaxf(fmaxf(fabsf(v[r][i][0]), fabsf(v[r][i][1])), fmaxf(fabsf(v[r][i][2]), fabsf(v[r][i][3]))));
            mx = wave_max(mx); q[r] = mx > 0.f ? 127.0f / mx : 0.f;
            if (lane == 0) sk[k0 + r] = mx * (1.0f / 127.0f); }
        __syncthreads();
#pragma unroll
        for (int i = 0; i < 8; ++i) { u32x4 o;
#pragma unroll
            for (int j = 0; j < 4; ++j) o[j] = pack4_i8(v[0][i][j] * q[0], v[1][i][j] * q[1], v[2][i][j] * q[2], v[3][i][j] * q[3]);
            *(LAS u32x4*)(D + wave * 2048 + 256 * i + 4 * lane) = o; }
        __syncthreads();
#pragma unroll
        for (int c = 0; c < 4; ++c) { const int n = tid + 512 * c; u32x4 a, b; int sacc = 0;
#pragma unroll
            for (int g = 0; g < 4; ++g) { a[g] = D[g * 2048 + n]; b[g] = D[(4 + g) * 2048 + n]; }
#pragma unroll
            for (int g = 0; g < 4; ++g) { sacc = __builtin_amdgcn_sdot4((int)a[g], 0x01010101, sacc, false); sacc = __builtin_amdgcn_sdot4((int)b[g], 0x01010101, sacc, false); }
            *(u32x4*)(WQ + (size_t)n * DFF + 32 * t) = a; *(u32x4*)(WQ + (size_t)n * DFF + 32 * t + 16) = b;
            atomicAdd(wsum + n, sacc); }
    }
    __syncthreads();
}

__device__ __forceinline__ void p0_prologue(Frame& F) {
    const int gw = F.bid * 8 + F.wave, NGW = F.G * 8;
    unsigned char* ws = F.ws;
    for (int rep_ = 0; rep_ < REP_P0A; ++rep_) p0_transposes(F, gw, NGW);
    {
        const int gt = F.bid * 512 + F.tid, NGT = F.G * 512;
        for (int i = gt; i < M * PD / 8; i += NGT) { const f32x4 a = ld_stream((const f32x4*)(F.p + (size_t)i * 8)), b = ld_stream((const f32x4*)(F.p + (size_t)i * 8 + 4));
            u32x4 o; o.x = pk2(a[0], a[1]); o.y = pk2(a[2], a[3]); o.z = pk2(b[0], b[1]); o.w = pk2(b[2], b[3]); *(u32x4*)(ws + WS_PB + (size_t)i * 16) = o; }
    }
    {
        const int gt = F.bid * 512 + F.tid, NGT = F.G * 512;
        for (int i = gt; i < 4 * 256 * 256 / 8; i += NGT) { const int d8 = (i & 31) * 8, g = i >> 13;
            const f32x4 a = *(const f32x4*)(F.w_pool + (size_t)i * 8), b = *(const f32x4*)(F.w_pool + (size_t)i * 8 + 4);
            const f32x4 sa = *(const f32x4*)(F.pool_scale + 256 * g + d8), sb = *(const f32x4*)(F.pool_scale + 256 * g + d8 + 4);
            u32x4 o; o.x = pk2(a[0] * sa[0], a[1] * sa[1]); o.y = pk2(a[2] * sa[2], a[3] * sa[3]); o.z = pk2(b[0] * sb[0], b[1] * sb[1]); o.w = pk2(b[2] * sb[2], b[3] * sb[3]);
            *(u32x4*)(ws + WS_WPOOL + (size_t)i * 16) = o; }
    }
    __syncthreads();
    {
        LAS f32x4* wg = (LAS f32x4*)F.lds;
        for (int idx = F.tid; idx < 8192; idx += 512) { const int ln = idx & 63, c4 = (idx >> 6) & 3, i = (idx >> 8) & 3, jj = idx >> 10; const int k = 256 * jj + 4 * ln + i;
            wg[idx] = *(const f32x4*)(F.w_in + (size_t)k * INC + C_GATE + 4 * c4); }
    }
    __syncthreads();
    {
        const LAS f32x4* wg = (const LAS f32x4*)F.lds;
        const int lane = F.lane;
        f32x4 gq[8];
#pragma unroll
        for (int jj = 0; jj < 8; ++jj) gq[jj] = *(const f32x4*)(F.g_mix_pre + 256 * jj + 4 * lane);
        const float bgl = (lane < 16) ? F.b_gates[lane] : 0.f;
        for (int rep_ = 0; rep_ < REP_P0D; ++rep_) {
        f32x4 v[8], nx[8];
        int m = gw;
        if (m < M) {
#pragma unroll
            for (int jj = 0; jj < 8; ++jj) nx[jj] = ld_stream((const f32x4*)(F.x + (size_t)m * DM + 256 * jj + 4 * lane)); }
        for (; m < M; m += NGW) {
#pragma unroll
            for (int jj = 0; jj < 8; ++jj) v[jj] = nx[jj];
            if (m + NGW < M) {
#pragma unroll
                for (int jj = 0; jj < 8; ++jj) nx[jj] = ld_stream((const f32x4*)(F.x + (size_t)(m + NGW) * DM + 256 * jj + 4 * lane)); }
            float s = 0.f;
#pragma unroll
            for (int jj = 0; jj < 8; ++jj) s += (v[jj][0] * v[jj][0] + v[jj][1] * v[jj][1]) + (v[jj][2] * v[jj][2] + v[jj][3] * v[jj][3]);
            const float rs = rsqrtf(wave_sum(s) * (1.0f / DM) + EPS);
            {
                float mx = 0.f;
#pragma unroll
                for (int jj = 0; jj < 8; ++jj) mx = fmaxf(mx, fmaxf(fmaxf(fabsf(v[jj][0]), fabsf(v[jj][1])), fmaxf(fabsf(v[jj][2]), fabsf(v[jj][3]))));
                mx = wave_max(mx); const float qa = mx > 0.f ? 127.0f / mx : 0.f;
#pragma unroll
                for (int h = 0; h < 2; ++h) { u32x4 o;
#pragma unroll
                    for (int j = 0; j < 4; ++j) o[j] = pack4_i8(v[4 * h + j][0] * qa, v[4 * h + j][1] * qa, v[4 * h + j][2] * qa, v[4 * h + j][3] * qa);
                    *(u32x4*)(F.ob + DO_XQ + (size_t)m * DM + 1024 * h + 16 * lane) = o; }
                if (lane == 0) ((float*)(ws + WS_RSX))[m] = rs * mx * (1.0f / 127.0f);
            }
            f32x4 ga[4];
#pragma unroll
            for (int c4 = 0; c4 < 4; ++c4) ga[c4] = (f32x4){0.f, 0.f, 0.f, 0.f};
#pragma unroll
            for (int jj = 0; jj < 8; ++jj) {
                u32x2 o; o.x = pk2(v[jj][0], v[jj][1]); o.y = pk2(v[jj][2], v[jj][3]); *(u32x2*)(ws + WS_XB + ((size_t)m * DM + 256 * jj + 4 * lane) * 2) = o;
                v[jj] = v[jj] * rs * gq[jj];
#pragma unroll
                for (int i = 0; i < 4; ++i)
#pragma unroll
                    for (int c4 = 0; c4 < 4; ++c4) ga[c4] += wg[((jj * 4 + i) * 4 + c4) * 64 + lane] * v[jj][i];
                asm volatile("" ::: "memory"); }
            float res = 0.f;
#pragma unroll
            for (int c4 = 0; c4 < 4; ++c4)
#pragma unroll
                for (int j = 0; j < 4; ++j) { const float t = wave_sum(ga[c4][j]); if (lane == c4 * 4 + j) res = t; }
            if (lane < 16) ((float*)(ws + WS_GATES))[(size_t)m * 16 + lane] = res + bgl;
            if (lane == 0) ((float*)(ws + WS_RS0))[m] = rs;
        } }
    }
}

__device__ __forceinline__ void p0_first_tokens(Frame& F) {
    LAS float* red = (LAS float*)F.lds;
    const int tid = F.tid, colq = tid & 7, part = tid >> 3;
    for (int cb = F.bid; cb < 256; cb += F.G) {
        float acc[8];
#pragma unroll
        for (int r = 0; r < 8; ++r) acc[r] = 0.f;
#pragma unroll 4
        for (int k4 = 0; k4 < 8; ++k4) { const int k = 32 * part + 4 * k4;
            const f32x4 g = *(const f32x4*)(F.g_mix_pre + k);
            float w[4];
#pragma unroll
            for (int i = 0; i < 4; ++i) w[i] = F.w_in[(size_t)(k + i) * INC + 8 * cb + colq] * g[i];
#pragma unroll
            for (int r = 0; r < 8; ++r) { const f32x4 xv = *(const f32x4*)(F.x + (size_t)r * SEQ * DM + k); acc[r] += (xv[0] * w[0] + xv[1] * w[1]) + (xv[2] * w[2] + xv[3] * w[3]); } }
        __syncthreads();
#pragma unroll
        for (int r = 0; r < 8; ++r) red[(part * 8 + r) * 8 + colq] = acc[r];
        __syncthreads();
        if (tid < 64) { float s = 0.f;
#pragma unroll 8
            for (int p = 0; p < 64; ++p) s += red[p * 64 + tid];
            ((float*)(F.ws + WS_QK0))[(tid >> 3) * 2048 + 8 * cb + (tid & 7)] = s; }
    }
    __syncthreads();
}

constexpr int PA_KT = 0, PA_VW = 18432, PA_VT = 36864, PA_W = 53248;
__device__ __forceinline__ int p2swz(int row, int byteoff) { return (((byteoff >> 4) ^ ((row >> 3) & 7)) << 4) | (byteoff & 15); }
__device__ __forceinline__ int vt_pos(int j) { return (j & 32) | (((j >> 2) & 3) << 3) | (((j >> 4) & 1) << 2) | (j & 3); }
struct P2Regs { u32x4 qr[5], kr[5], vr[2]; float gi, gf; };
__device__ __forceinline__ void p2_issue(const unsigned char* ws, int item, int tid, int lane, int wave, P2Regs& R) {
    const int c = item & 31, bh = item >> 5, h = bh & 7, b = bh >> 3; const int m0 = b * SEQ + c * CH;
    const int cg8 = tid & 15, rp = tid >> 4, l0 = 2 * rp, col = h * DH + cg8 * 8;
#pragma unroll
    for (int i = 0; i < 5; ++i) { const int r = l0 - 3 + i; const bool ok = (c > 0) || (r >= 0);
        const unsigned off = (unsigned)(((m0 + r) * MW + col) * 2);
        R.qr[i] = ok ? *(const u32x4*)(ws + WS_Q + off) : (u32x4){0u, 0u, 0u, 0u};
        R.kr[i] = ok ? *(const u32x4*)(ws + WS_K + off) : (u32x4){0u, 0u, 0u, 0u}; }
#pragma unroll
    for (int i = 0; i < 2; ++i) R.vr[i] = *(const u32x4*)(ws + WS_V + (unsigned)(((m0 + l0 + i) * MW + col) * 2));
    if (wave == 0) { const float* gates = (const float*)(ws + WS_GATES); R.gi = gates[(size_t)(m0 + lane) * 16 + h]; R.gf = gates[(size_t)(m0 + lane) * 16 + 8 + h]; }
}
__device__ __forceinline__ void p2_items(Frame& F) {
    unsigned char* ws = F.ws;
    const int tid = F.tid, lane = F.lane, wave = F.wave;
    LAS unsigned char* lds = F.lds;
    LAS float* wl = (LAS float*)(lds + PA_W);
    const int cg8 = tid & 15, rp = tid >> 4, l0 = 2 * rp;
    for (int blk = F.bid; blk * 8 < NITEM; blk += F.G) {
        const int it0 = blk * 8, h = (it0 >> 5) & 7, col = h * DH + cg8 * 8;
        float wq[4][8], wk[4][8];
#pragma unroll
        for (int kk = 0; kk < 4; ++kk) { const f32x4 a = *(const f32x4*)(F.w_conv + kk * 2048 + col), b2 = *(const f32x4*)(F.w_conv + kk * 2048 + col + 4);
            const f32x4 c2 = *(const f32x4*)(F.w_conv + kk * 2048 + 1024 + col), d2 = *(const f32x4*)(F.w_conv + kk * 2048 + 1024 + col + 4);
#pragma unroll
            for (int j = 0; j < 4; ++j) { wq[kk][j] = a[j]; wq[kk][4 + j] = b2[j]; wk[kk][j] = c2[j]; wk[kk][4 + j] = d2[j]; } }
        P2Regs R;
        p2_issue(ws, it0, tid, lane, wave, R);
        LAS f32x4* run = (LAS f32x4*)(lds + 65536) + tid;
#pragma unroll
        for (int et = 0; et < 8; ++et) { float zf = 0.f; asm volatile("" : "+v"(zf)); run[et * 512] = (f32x4){zf, zf, zf, zf}; }
        LAS float* nrun = wl + 128 + tid;
        { float zf = 0.f; asm volatile("" : "+v"(zf)); if (tid < 128) *nrun = zf; if (tid == 0) { wl[66] = zf; wl[67] = zf; } }
        for (int k = 0; k < 8; ++k) {
            const int item = it0 + k, c = item & 31, b = item >> 8; const int m0 = b * SEQ + c * CH;
            if (wave == 0) {
                const float li = R.gi, lf = logsigm(R.gf);
                float bs = lf;
#pragma unroll
                for (int o = 1; o < 64; o <<= 1) { const float t = __shfl_up(bs, o); if (lane >= o) bs += t; }
                const float btot = __shfl(bs, 63);
                const float a = btot - bs + li, amax = wave_max(a);
                wl[lane] = __expf(a - amax);
                if (lane == 0) { ((float*)(ws + WS_SCAL))[item] = amax; ((float*)(ws + WS_SCAL))[NITEM + item] = btot;
                    const float mL = wl[66], Bc = wl[67], mn = fmaxf(btot + mL, amax);
                    ((float*)(ws + WS_SCAL))[2 * NITEM + item] = mL; ((float*)(ws + WS_SCAL))[3 * NITEM + item] = Bc;
                    wl[64] = __expf(btot + mL - mn); wl[65] = __expf(amax - mn); wl[66] = mn; wl[67] = Bc + btot; }
            }
            float qy[2][8], ky[2][8], vv[2][8];
            {
                float xq[5][8], xk[5][8];
#pragma unroll
                for (int i = 0; i < 5; ++i)
#pragma unroll
                    for (int p = 0; p < 4; ++p) { xq[i][2 * p] = bflo(R.qr[i][p]); xq[i][2 * p + 1] = bfhi(R.qr[i][p]); xk[i][2 * p] = bflo(R.kr[i][p]); xk[i][2 * p + 1] = bfhi(R.kr[i][p]); }
#pragma unroll
                for (int rr = 0; rr < 2; ++rr)
#pragma unroll
                    for (int j = 0; j < 8; ++j) { float aq = 0.f, ak = 0.f;
#pragma unroll
                        for (int kk = 0; kk < 4; ++kk) { aq += wq[kk][j] * xq[rr + kk][j]; ak += wk[kk][j] * xk[rr + kk][j]; }
                        qy[rr][j] = aq * sigm(aq); ky[rr][j] = ak * sigm(ak) * 0.08838834764831845f;
                        vv[rr][j] = (j & 1) ? bfhi(R.vr[rr][j >> 1]) : bflo(R.vr[rr][j >> 1]); }
            }
            if (k < 7) p2_issue(ws, item + 1, tid, lane, wave, R);
#pragma unroll
            for (int rr = 0; rr < 2; ++rr) { const unsigned off = (unsigned)(((m0 + l0 + rr) * MW + col) * 2);
                u32x4 o; o.x = pk2(qy[rr][0], qy[rr][1]); o.y = pk2(qy[rr][2], qy[rr][3]); o.z = pk2(qy[rr][4], qy[rr][5]); o.w = pk2(qy[rr][6], qy[rr][7]); if (NT_P2OUT) __builtin_nontemporal_store(o, (u32x4*)(ws + WS_QC + off)); else *(u32x4*)(ws + WS_QC + off) = o;
                u32x4 k2; k2.x = pk2(ky[rr][0], ky[rr][1]); k2.y = pk2(ky[rr][2], ky[rr][3]); k2.z = pk2(ky[rr][4], ky[rr][5]); k2.w = pk2(ky[rr][6], ky[rr][7]); if (NT_P2OUT) __builtin_nontemporal_store(k2, (u32x4*)(ws + WS_KC + off)); else *(u32x4*)(ws + WS_KC + off) = k2; }
            __syncthreads();
            {
                const float w0 = wl[l0], w1 = wl[l0 + 1];
                const int pv = vt_pos(l0);
#pragma unroll
                for (int j = 0; j < 8; ++j) { const int e = cg8 * 8 + j;
                    *(LAS unsigned*)(lds + PA_KT + e * 144 + p2swz(e, l0 * 2)) = pk2(ky[0][j], ky[1][j]);
                    *(LAS unsigned*)(lds + PA_VW + e * 144 + p2swz(e, l0 * 2)) = pk2(vv[0][j] * w0, vv[1][j] * w1);
                    *(LAS unsigned*)(lds + PA_VT + e * 128 + p2swz(e, pv * 2)) = pk2(vv[0][j], vv[1][j]); }
            }
            __syncthreads();
            {
                const int fr = lane & 15, fq = lane >> 4;
                f32x4 acc[8];
#pragma unroll
                for (int et = 0; et < 8; ++et) acc[et] = (f32x4){0.f, 0.f, 0.f, 0.f};
#pragma unroll
                for (int ks = 0; ks < 2; ++ks) { const bf16x8 bfr = *(const LAS bf16x8*)(lds + PA_VW + (16 * wave + fr) * 144 + p2swz(16 * wave + fr, (32 * ks + 8 * fq) * 2));
#pragma unroll
                    for (int et = 0; et < 8; ++et) { const bf16x8 afr = *(const LAS bf16x8*)(lds + PA_KT + (16 * et + fr) * 144 + p2swz(16 * et + fr, (32 * ks + 8 * fq) * 2));
                        acc[et] = __builtin_amdgcn_mfma_f32_16x16x32_bf16(afr, bfr, acc[et], 0, 0, 0); } }
                const int d = 16 * wave + fr;
                const float dec = wl[64], sc = wl[65];
#pragma unroll
                for (int et = 0; et < 8; ++et) { const f32x4 rv = run[et * 512]; u32x2 o; o.x = pk2(rv[0], rv[1]); o.y = pk2(rv[2], rv[3]);
                    if (k > 0) *(u32x2*)(ws + WS_A0 + (unsigned)(((item * 128 + d) * 128 + 16 * et + 4 * fq) * 2)) = o;
                    run[et * 512] = rv * dec + acc[et] * sc; }
                if (tid < 128) { float s = 0.f;
#pragma unroll 8
                    for (int l = 0; l < 64; ++l) s += wl[l] * bf2f(*(const LAS unsigned short*)(lds + PA_KT + tid * 144 + p2swz(tid, l * 2)));
                    const float nr = *nrun; ((float*)(ws + WS_NLOC))[(unsigned)(item * 128 + tid)] = nr; *nrun = nr * dec + s * sc; }
            }
#pragma unroll
            for (int i = 0; i < 2; ++i) { int t4 = tid; asm volatile("" : "+v"(t4)); const int idx = t4 + 512 * i, row = idx >> 3, chk = idx & 7;
                const u32x4 vt4 = *(const LAS u32x4*)(lds + PA_VT + row * 128 + p2swz(row, chk * 16));
                if (NT_P2OUT) __builtin_nontemporal_store(vt4, (u32x4*)(F.ob + DO_VT + (unsigned)((item * 128 + row) * 128 + chk * 16))); else *(u32x4*)(F.ob + DO_VT + (unsigned)((item * 128 + row) * 128 + chk * 16)) = vt4; }
            __syncthreads();
        }
        {
            int t3 = tid; asm volatile("" : "+v"(t3));
            const int fr = t3 & 15, fq = (t3 >> 4) & 3, d = 16 * wave + fr;
#pragma unroll
            for (int et = 0; et < 8; ++et) { const f32x4 rv = ((LAS f32x4*)(lds + 65536) + t3)[et * 512]; u32x2 o; o.x = pk2(rv[0], rv[1]); o.y = pk2(rv[2], rv[3]);
                *(u32x2*)(ws + WS_TOT + (unsigned)(((blk * 128 + d) * 128 + 16 * et + 4 * fq) * 2)) = o; }
            if (t3 < 128) ((float*)(ws + WS_NTOT))[(unsigned)(blk * 128 + t3)] = wl[128 + t3];
            if (t3 == 0) { ((float*)(ws + WS_SCAL))[4 * NITEM + blk] = wl[66]; ((float*)(ws + WS_SCAL))[4 * NITEM + 256 + blk] = wl[67]; }
        }
    }
}
template <int W> __device__ __forceinline__ void pooled_item(const unsigned char* U, unsigned char* P, int m4, int c8) {
    const int t0 = m4 & (SEQ - 1);
    u32x4 rows[W + 3];
#pragma unroll
    for (int i = 0; i < W + 3; ++i) { const int dt = i - (W - 1);
        rows[i] = (t0 + dt >= 0) ? *(const u32x4*)(U + ((size_t)(m4 + dt) * PW + c8 * 8) * 2) : (u32x4){0u, 0u, 0u, 0u}; }
#pragma unroll
    for (int r = 0; r < 4; ++r) { float s[8];
#pragma unroll
        for (int j = 0; j < 8; ++j) s[j] = 0.f;
#pragma unroll
        for (int i = 0; i < W; ++i) { const u32x4 v = rows[r + i];
#pragma unroll
            for (int j = 0; j < 4; ++j) { s[2 * j] += bflo(v[j]); s[2 * j + 1] += bfhi(v[j]); } }
        const int n = (t0 + r + 1 < W) ? (t0 + r + 1) : W; const float inv = 1.0f / (float)n;
        const u32x4 cur = rows[r + W - 1]; u32x4 o;
#pragma unroll
        for (int j = 0; j < 4; ++j) o[j] = pk2(s[2 * j] * inv - bflo(cur[j]), s[2 * j + 1] * inv - bfhi(cur[j]));
        *(u32x4*)(P + ((size_t)(m4 + r) * DM + c8 * 8) * 2) = o; }
}
__device__ __forceinline__ void p2_pooled(Frame& F) {
    const int gt = F.bid * 512 + F.tid, NGT = F.G * 512;
    const unsigned char* U = F.ws + WS_U; unsigned char* P = F.ob + DO_MIX + 1024 * 2;
    for (int i = gt; i < (M / 4) * 128; i += NGT) { const int m4 = (i >> 7) * 4, c8 = i & 127, g = c8 >> 5;
        if (g == 0) pooled_item<2>(U, P, m4, c8); else if (g == 1) pooled_item<4>(U, P, m4, c8); else if (g == 2) pooled_item<8>(U, P, m4, c8); else pooled_item<16>(U, P, m4, c8); }
}

__device__ __forceinline__ void fold_pool(Frame& F) {
    const int lane = F.lane, wave = F.wave, fr = lane & 15, fq = lane >> 4;
    bf16* WO = (bf16*)(F.ws + WS_WOUT); const bf16* WP = (const bf16*)(F.ws + WS_WPOOL);
    for (int t = F.bid; t < 256; t += F.G) { const int g = t & 3, nb = t >> 2;
        f32x4 acc[2][2];
#pragma unroll
        for (int ct = 0; ct < 2; ++ct)
#pragma unroll
            for (int nt = 0; nt < 2; ++nt) acc[ct][nt] = (f32x4){0.f, 0.f, 0.f, 0.f};
        const bf16* ap = WP + (size_t)(256 * g + 32 * wave + fr) * 256 + 8 * fq;
        const bf16* bp = WO + (size_t)(32 * nb + fr) * DM + 1024 + 256 * g + 8 * fq;
#pragma unroll
        for (int h = 0; h < 2; ++h) { bf16x8 a[4][2], b[4][2];
#pragma unroll
            for (int d4 = 0; d4 < 4; ++d4)
#pragma unroll
                for (int q = 0; q < 2; ++q) { a[d4][q] = *(const bf16x8*)(ap + (size_t)(16 * q) * 256 + 32 * (4 * h + d4)); b[d4][q] = *(const bf16x8*)(bp + (size_t)(16 * q) * DM + 32 * (4 * h + d4)); }
#pragma unroll
            for (int d4 = 0; d4 < 4; ++d4)
#pragma unroll
                for (int ct = 0; ct < 2; ++ct)
#pragma unroll
                    for (int nt = 0; nt < 2; ++nt) acc[ct][nt] = __builtin_amdgcn_mfma_f32_16x16x32_bf16(a[d4][ct], b[d4][nt], acc[ct][nt], 0, 0, 0); }
        __syncthreads();
#pragma unroll
        for (int ct = 0; ct < 2; ++ct)
#pragma unroll
            for (int nt = 0; nt < 2; ++nt) { u32x2 o; o.x = pk2(acc[ct][nt][0], acc[ct][nt][1]); o.y = pk2(acc[ct][nt][2], acc[ct][nt][3]);
                *(u32x2*)(WO + (size_t)(32 * nb + 16 * nt + fr) * DM + 1024 + 256 * g + 32 * wave + 16 * ct + 4 * fq) = o; }
        __syncthreads();
    }
}

__device__ __forceinline__ void p3_scan(Frame& F) {
    unsigned char* ws = F.ws;
    const int gt = F.bid * 512 + F.tid;
    const float* amaxp = (const float*)(ws + WS_SCAL); const float* btotp = amaxp + NITEM; float* mprev = (float*)(ws + WS_SCAL) + 2 * NITEM;
    for (int id = gt; id < 64 * 128 * 16; id += F.G * 512) {
        const int bh = id >> 11, d = (id >> 4) & 127, e8 = id & 15;
        float acc[8], nacc[8];
#pragma unroll
        for (int j = 0; j < 8; ++j) { acc[j] = 0.f; nacc[j] = 0.f; }
        float m = 0.f;
        const bool do_n = (d == 0);
        for (int cb = 0; cb < NCH; cb += 8) {
            u32x4 cl[8]; float am[8], bt[8]; f32x4 na[8], nb2[8];
#pragma unroll
            for (int k = 0; k < 8; ++k) { const int item = bh * 32 + cb + k;
                cl[k] = ld_once((const u32x4*)(ws + WS_A0 + (((size_t)item * 128 + d) * 128 + e8 * 8) * 2)); am[k] = amaxp[item]; bt[k] = btotp[item];
                if (do_n) { const float* nl = (const float*)(ws + WS_NLOC) + (size_t)item * 128 + e8 * 8; na[k] = *(const f32x4*)nl; nb2[k] = *(const f32x4*)(nl + 4); } }
#pragma unroll
            for (int k = 0; k < 8; ++k) { const int item = bh * 32 + cb + k;
                u32x4 o; o.x = pk2(acc[0], acc[1]); o.y = pk2(acc[2], acc[3]); o.z = pk2(acc[4], acc[5]); o.w = pk2(acc[6], acc[7]);
                *(u32x4*)(ws + WS_CPREV + (((size_t)item * 128 + d) * 128 + e8 * 8) * 2) = o;
                const float mn = fmaxf(bt[k] + m, am[k]), dec = __expf(bt[k] + m - mn), sc = __expf(am[k] - mn);
                if (do_n) { float* np = (float*)(ws + WS_NPREV) + (size_t)item * 128 + e8 * 8;
                    *(f32x4*)np = (f32x4){nacc[0], nacc[1], nacc[2], nacc[3]}; *(f32x4*)(np + 4) = (f32x4){nacc[4], nacc[5], nacc[6], nacc[7]};
#pragma unroll
                    for (int j = 0; j < 4; ++j) { nacc[j] = dec * nacc[j] + sc * na[k][j]; nacc[4 + j] = dec * nacc[4 + j] + sc * nb2[k][j]; }
                    if (e8 == 0) mprev[item] = m; }
#pragma unroll
                for (int j = 0; j < 4; ++j) { acc[2 * j] = dec * acc[2 * j] + sc * bflo(cl[k][j]); acc[2 * j + 1] = dec * acc[2 * j + 1] + sc * bfhi(cl[k][j]); }
                m = mn; }
        }
    }
}

__device__ __forceinline__ void p4_issue(const unsigned char* ws, const unsigned char* ob, int it0, int tid, u32x4 (&st)[16]) {
#pragma unroll
    for (int i = 0; i < 16; ++i) { const int item = it0 + (i >> 3), cid = (tid + 512 * i) & 4095;
        const int c = item & 31, bh = item >> 5, h = bh & 7, b = bh >> 3; const int m0 = b * SEQ + c * CH;
        const unsigned char* src;
        if ((i & 7) < 2) { const int r = cid >> 4, c16 = cid & 15; src = ws + WS_KC + (unsigned)(((m0 + r) * MW + h * DH) * 2 + c16 * 16); }
        else if ((i & 7) < 6) { const int r = (cid - 1024) >> 4, c16 = cid & 15; src = ws + WS_A0 + (unsigned)((item * 128 + r) * 256 + c16 * 16); }
        else { const int r = (cid - 3072) >> 3, c8 = cid & 7; src = ob + DO_VT + (unsigned)((item * 128 + r) * 128 + c8 * 16); }
        st[i] = (((i & 7) >= 2) && ((i & 7) < 6) && ((item & 7) == 0)) ? (u32x4){0u, 0u, 0u, 0u} : ld_once((const u32x4*)src); }
}
__device__ __forceinline__ void p4_write(LAS unsigned char* lds, int tid, const u32x4 (&st)[16], int it0, const unsigned char* gb) {
#pragma unroll
    for (int i = 0; i < 16; ++i) { const int cid = (tid + 512 * i) & 4095; LAS unsigned char* base = lds + (i >> 3) * 65536; int off;
        u32x4 v = st[i];
        if ((i & 7) < 2) { const int r = cid >> 4, c16 = cid & 15; off = r * 256 + ((c16 ^ (r & 15)) << 4); }
        else if ((i & 7) < 6) { const int r = (cid - 1024) >> 4, c16 = cid & 15; off = 16384 + r * 256 + ((c16 ^ (r & 15)) << 4);
            const int kk = (it0 + (i >> 3)) & 7; const float al = *(const LAS float*)(lds + P4X_A + kk * 4), be = *(const LAS float*)(lds + P4X_B + kk * 4);
            int t5 = tid; asm volatile("" : "+v"(t5));
            const u32x4 g = *(const u32x4*)(gb + (unsigned)(((((i & 7) - 2) * 512) + t5) * 16));
#pragma unroll
            for (int q = 0; q < 4; ++q) v[q] = pk2(al * bflo(v[q]) + be * bflo(g[q]), al * bfhi(v[q]) + be * bfhi(g[q])); }
        else { const int r = (cid - 3072) >> 3, c8 = cid & 7; off = 49152 + r * 128 + ((c8 ^ ((r >> 1) & 7)) << 4); }
        *(LAS u32x4*)(base + off) = v; }
}
__device__ __forceinline__ void p4_compute(Frame& F, int item, int rb, const LAS unsigned char* L) {
    unsigned char* ws = F.ws;
    const int lane = F.lane, fr = lane & 15, fq = lane >> 4;
    const int c = item & 31, bh = item >> 5, h = bh & 7, b = bh >> 3;
    const int m0 = b * SEQ + c * CH;
    const float* gates = (const float*)(ws + WS_GATES);
    const float li = gates[(unsigned)((m0 + lane) * 16 + h)], lf = logsigm(gates[(unsigned)((m0 + lane) * 16 + 8 + h)]);
    float bs = lf;
#pragma unroll
    for (int o = 1; o < 64; o <<= 1) { const float t = __shfl_up(bs, o); if (lane >= o) bs += t; }
    const float gg = li - bs;
    float pmx = gg;
#pragma unroll
    for (int o = 1; o < 64; o <<= 1) { const float t = __shfl_up(pmx, o); if (lane >= o) pmx = fmaxf(pmx, t); }
    const float m_prev = *(const LAS float*)(F.lds + P4X_M + (item & 7) * 4);
    const float pm = fmaxf(m_prev, pmx);
    const int l = 16 * rb + fr;
    const float b_l = __shfl(bs, l), pm_l = __shfl(pm, l);
    const float inter_w = __expf(m_prev - pm_l);
    bf16x8 qf[4];
#pragma unroll
    for (int ks = 0; ks < 4; ++ks) qf[ks] = *(const bf16x8*)(ws + WS_QC + (unsigned)(((m0 + l) * MW + h * DH + 32 * ks + 8 * fq) * 2));
    f32x4 T[4];
#pragma unroll
    for (int jt = 0; jt < 4; ++jt) { T[jt] = (f32x4){0.f, 0.f, 0.f, 0.f};
        if (jt <= rb) {
#pragma unroll
            for (int ks = 0; ks < 4; ++ks) { const int r = 16 * jt + fr; const bf16x8 kf = *(const LAS bf16x8*)(L + r * 256 + (((4 * ks + fq) ^ (r & 15)) << 4));
                T[jt] = __builtin_amdgcn_mfma_f32_16x16x32_bf16(kf, qf[ks], T[jt], 0, 0, 0); } } }
    if (c == 0 && rb == 0) {
        const float* qk0 = (const float*)(ws + WS_QK0) + b * 2048; float part = 0.f; const float rs0 = ((const float*)(ws + WS_RS0))[b * SEQ];
#pragma unroll
        for (int i = 0; i < 2; ++i) { const int e = h * DH + lane + 64 * i;
            const float yq = F.w_conv[3 * 2048 + e] * qk0[e] * rs0, yk = F.w_conv[3 * 2048 + 1024 + e] * qk0[1024 + e] * rs0;
            part += (yq * sigm(yq)) * (yk * sigm(yk)); }
        const float s00 = wave_sum(part) * 0.08838834764831845f;
        if (lane == 0) T[0][0] = s00;
    }
    float rowsum = 0.f;
#pragma unroll
    for (int jt = 0; jt < 4; ++jt)
#pragma unroll
        for (int r = 0; r < 4; ++r) { const int j = 16 * jt + 4 * fq + r; const float gj = __shfl(gg, j);
            const float wgt = (j <= l) ? __expf(gj - pm_l) : 0.f; const float sv = T[jt][r] * wgt; T[jt][r] = sv; rowsum += sv; }
    bf16x8 pf[2];
#pragma unroll
    for (int s2 = 0; s2 < 2; ++s2) { u32x4 w; w.x = pk2(T[2 * s2][0], T[2 * s2][1]); w.y = pk2(T[2 * s2][2], T[2 * s2][3]); w.z = pk2(T[2 * s2 + 1][0], T[2 * s2 + 1][1]); w.w = pk2(T[2 * s2 + 1][2], T[2 * s2 + 1][3]);
        pf[s2] = __builtin_bit_cast(bf16x8, w); }
    float nq = 0.f;
#pragma unroll
    for (int ks = 0; ks < 4; ++ks) { const LAS float* np = (const LAS float*)(F.lds + P4X_N) + (item & 7) * 128 + 32 * ks + 8 * fq; const f32x4 a = *(const LAS f32x4*)np, b2 = *(const LAS f32x4*)(np + 4);
        const u32x4 qw = __builtin_bit_cast(u32x4, qf[ks]);
        nq += a[0] * bflo(qw[0]) + a[1] * bfhi(qw[0]) + a[2] * bflo(qw[1]) + a[3] * bfhi(qw[1]) + b2[0] * bflo(qw[2]) + b2[1] * bfhi(qw[2]) + b2[2] * bflo(qw[3]) + b2[3] * bfhi(qw[3]); }
    nq += __shfl_xor(nq, 16); nq += __shfl_xor(nq, 32);
    rowsum += __shfl_xor(rowsum, 16); rowsum += __shfl_xor(rowsum, 32);
    const float den = inter_w * nq + rowsum;
    const float inv = frcp(fmaxf(fabsf(den), __expf(-(b_l + pm_l))));
    f32x4 acc[8]; float ss = 0.f;
#pragma unroll
    for (int dt = 0; dt < 8; ++dt) { acc[dt] = (f32x4){0.f, 0.f, 0.f, 0.f}; const int r = 16 * dt + fr;
#pragma unroll
        for (int ks = 0; ks < 4; ++ks) { const bf16x8 cf = *(const LAS bf16x8*)(L + 16384 + r * 256 + (((4 * ks + fq) ^ (r & 15)) << 4));
            acc[dt] = __builtin_amdgcn_mfma_f32_16x16x32_bf16(cf, qf[ks], acc[dt], 0, 0, 0); }
        acc[dt] = acc[dt] * inter_w;
#pragma unroll
        for (int s2 = 0; s2 < 2; ++s2) { if (s2 == 0 || rb >= 2) { const bf16x8 vf = *(const LAS bf16x8*)(L + 49152 + r * 128 + (((4 * s2 + fq) ^ ((r >> 1) & 7)) << 4));
                acc[dt] = __builtin_amdgcn_mfma_f32_16x16x32_bf16(vf, pf[s2], acc[dt], 0, 0, 0); } }
        acc[dt] = acc[dt] * inv;
        ss += (acc[dt][0] * acc[dt][0] + acc[dt][1] * acc[dt][1]) + (acc[dt][2] * acc[dt][2] + acc[dt][3] * acc[dt][3]); }
    ss += __shfl_xor(ss, 16); ss += __shfl_xor(ss, 32);
    const float rn = rsqrtf(ss * (1.0f / DH) + EPS);
#pragma unroll
    for (int dt = 0; dt < 8; ++dt) { const int d0 = 16 * dt + 4 * fq;
        const u32x2 ow = *(const u32x2*)(ws + WS_O + (unsigned)(((m0 + l) * MW + h * DH + d0) * 2));
        const f32x4 gm = *(const f32x4*)(F.g_mlstm + h * DH + d0);
        const float o0 = sigm(bflo(ow.x)) * acc[dt][0] * rn * gm[0], o1 = sigm(bfhi(ow.x)) * acc[dt][1] * rn * gm[1];
        const float o2 = sigm(bflo(ow.y)) * acc[dt][2] * rn * gm[2], o3 = sigm(bfhi(ow.y)) * acc[dt][3] * rn * gm[3];
        u32x2 o; o.x = pk2(o0, o1); o.y = pk2(o2, o3);
        *(u32x2*)(F.ob + DO_MIX + (unsigned)(((m0 + l) * DM + h * DH + d0) * 2)) = o; }
}
__device__ __forceinline__ void p4_phase(Frame& F) {
    const int npair = NITEM / 2;
    u32x4 st[16];
    int pr = F.bid * 4;
    for (int blk = F.bid; blk * 4 < npair; blk += F.G) {
        pr = blk * 4;
        const unsigned char* gb = F.ws + WS_GB + (size_t)blk * 32768;
        {
            const float* scal = (const float*)(F.ws + WS_SCAL);
            const int grp = blk & 3; int tid = F.tid; asm volatile("" : "+v"(tid));
            float S[4][8]; float nS = 0.f, mS = 0.f;
#pragma unroll
            for (int q = 0; q < 4; ++q)
#pragma unroll
                for (int j = 0; j < 8; ++j) S[q][j] = 0.f;
            for (int i = 0; i < grp; ++i) { const int bi = blk - grp + i;
                const float mT = scal[4 * NITEM + bi], BT = scal[4 * NITEM + 256 + bi];
                const float mn = fmaxf(BT + mS, mT), dec = __expf(BT + mS - mn), sc = __expf(mT - mn);
#pragma unroll
                for (int q = 0; q < 4; ++q) { const int cid = (tid + 512 * (2 + q)) & 4095, r = (cid - 1024) >> 4, c16 = cid & 15;
                    const u32x4 t = *(const u32x4*)(F.ws + WS_TOT + (unsigned)((bi * 128 + r) * 256 + c16 * 16));
#pragma unroll
                    for (int j = 0; j < 4; ++j) { S[q][2 * j] = dec * S[q][2 * j] + sc * bflo(t[j]); S[q][2 * j + 1] = dec * S[q][2 * j + 1] + sc * bfhi(t[j]); } }
                if (tid < 128) nS = dec * nS + sc * ((const float*)(F.ws + WS_NTOT))[(unsigned)(bi * 128 + tid)];
                mS = mn; }
#pragma unroll
            for (int q = 0; q < 4; ++q) { u32x4 g4;
#pragma unroll
                for (int j = 0; j < 4; ++j) g4[j] = pk2(S[q][2 * j], S[q][2 * j + 1]);
                *(u32x4*)(F.ws + WS_GB + (size_t)blk * 32768 + (unsigned)((q * 512 + tid) * 16)) = g4; }
            asm volatile("s_waitcnt vmcnt(0)" ::: "memory");
            __syncthreads();
#pragma unroll 1
            for (int kk = 0; kk < 8; ++kk) { const int item = 8 * blk + kk; const float mL = scal[2 * NITEM + item], Bc = scal[3 * NITEM + item];
                const float mp = fmaxf(mL, mS + Bc), al = __expf(mL - mp), be = __expf(mS + Bc - mp);
                if (tid < 128) *(LAS float*)(F.lds + P4X_N + (kk * 128 + tid) * 4) = al * ((const float*)(F.ws + WS_NLOC))[(unsigned)(item * 128 + tid)] + be * nS;
                if (tid == 0) { *(LAS float*)(F.lds + P4X_M + kk * 4) = mp; *(LAS float*)(F.lds + P4X_A + kk * 4) = al; *(LAS float*)(F.lds + P4X_B + kk * 4) = be; } }
        }
        p4_issue(F.ws, F.ob, 2 * (pr + 3), F.tid, st);
        for (int k = 3; k >= 0; --k) {
            __syncthreads();
            p4_write(F.lds, F.tid, st, 2 * (pr + k), gb);
            if (k > 0) p4_issue(F.ws, F.ob, 2 * (pr + k - 1), F.tid, st);
            __syncthreads();
            p4_compute(F, 2 * (pr + k) + (F.wave >> 2), F.wave & 3, F.lds + (F.wave >> 2) * 65536);
        }
    }
    __syncthreads();
}

template <bool BASE_BF16, bool NTH = false>
__device__ __forceinline__ void row_resnorm(Frame& F, const void* base, const unsigned char* y, const float* g1, unsigned char* hout, float* rsout, signed char* qout) {
    const int gw = F.bid * 8 + F.wave, NGW = F.G * 8, lane = F.lane;
    constexpr int NB = BASE_BF16 ? 4 : 8;
    f32x4 ga[8];
#pragma unroll
    for (int j = 0; j < 4; ++j) { const size_t co = 512 * j + 8 * lane; ga[2 * j] = *(const f32x4*)(g1 + co); ga[2 * j + 1] = *(const f32x4*)(g1 + co + 4); }
    u32x4 ny[4], nb[NB];
    int m = gw;
#define ROW_LOAD(mm) do { _Pragma("unroll") for (int j = 0; j < 4; ++j) { const size_t co = (size_t)(mm) * DM + 512 * j + 8 * lane; ny[j] = ld_once((const u32x4*)(y + co * 2)); \
        if (BASE_BF16) nb[j] = ld_once((const u32x4*)((const unsigned char*)base + co * 2)); \
        else { nb[(2 * j) % NB] = *(const u32x4*)((const unsigned char*)base + co * 4); nb[(2 * j + 1) % NB] = *(const u32x4*)((const unsigned char*)base + co * 4 + 16); } } } while (0)
    if (m < M) ROW_LOAD(m);
    for (; m < M; m += NGW) {
        float v[32], bv[32]; float s = 0.f;
#pragma unroll
        for (int j = 0; j < 4; ++j) {
#pragma unroll
            for (int q = 0; q < 4; ++q) { v[8 * j + 2 * q] = bflo(ny[j][q]); v[8 * j + 2 * q + 1] = bfhi(ny[j][q]); }
            if (BASE_BF16) {
#pragma unroll
                for (int q = 0; q < 4; ++q) { bv[8 * j + 2 * q] = bflo(nb[j][q]); bv[8 * j + 2 * q + 1] = bfhi(nb[j][q]); } }
            else {
#pragma unroll
                for (int q = 0; q < 4; ++q) { bv[8 * j + q] = __uint_as_float(nb[(2 * j) % NB][q]); bv[8 * j + 4 + q] = __uint_as_float(nb[(2 * j + 1) % NB][q]); } } }
        if (m + NGW < M) ROW_LOAD(m + NGW);
#pragma unroll
        for (int i = 0; i < 32; ++i) s += v[i] * v[i];
        const float r1 = rsqrtf(wave_sum(s) * (1.0f / DM) + EPS);
        float s2 = 0.f;
#pragma unroll
        for (int j = 0; j < 4; ++j) { const size_t co = 512 * j + 8 * lane;
#pragma unroll
            for (int q = 0; q < 4; ++q) { v[8 * j + q] = bv[8 * j + q] + v[8 * j + q] * r1 * ga[2 * j][q]; v[8 * j + 4 + q] = bv[8 * j + 4 + q] + v[8 * j + 4 + q] * r1 * ga[2 * j + 1][q]; }
            u32x4 o; o.x = pk2(v[8 * j], v[8 * j + 1]); o.y = pk2(v[8 * j + 2], v[8 * j + 3]); o.z = pk2(v[8 * j + 4], v[8 * j + 5]); o.w = pk2(v[8 * j + 6], v[8 * j + 7]);
            if (NTH) __builtin_nontemporal_store(o, (u32x4*)(hout + ((size_t)m * DM + co) * 2)); else *(u32x4*)(hout + ((size_t)m * DM + co) * 2) = o; }
#pragma unroll
        for (int i = 0; i < 32; ++i) s2 += v[i] * v[i];
        const float r2 = rsqrtf(wave_sum(s2) * (1.0f / DM) + EPS);
        float mx = 0.f;
#pragma unroll
        for (int i = 0; i < 32; ++i) mx = fmaxf(mx, fabsf(v[i]));
        mx = wave_max(mx);
        const float qa = mx > 0.f ? 127.0f / mx : 0.f;
#pragma unroll
        for (int j = 0; j < 4; ++j) { u32x2 o; o.x = pack4_i8(v[8 * j] * qa, v[8 * j + 1] * qa, v[8 * j + 2] * qa, v[8 * j + 3] * qa); o.y = pack4_i8(v[8 * j + 4] * qa, v[8 * j + 5] * qa, v[8 * j + 6] * qa, v[8 * j + 7] * qa);
            *(u32x2*)(qout + (size_t)m * DM + 512 * j + 8 * lane) = o; }
        if (lane == 0) rsout[m] = r2 * mx * (1.0f / 127.0f);
    }
#undef ROW_LOAD
}
__device__ __forceinline__ void row_final(Frame& F, const unsigned char* base, const unsigned char* y, const float* g, float* out) {
    const int gw = F.bid * 8 + F.wave, NGW = F.G * 8, lane = F.lane;
    f32x4 ga[8];
#pragma unroll
    for (int j = 0; j < 4; ++j) { const size_t co = 512 * j + 8 * lane; ga[2 * j] = *(const f32x4*)(g + co); ga[2 * j + 1] = *(const f32x4*)(g + co + 4); }
    u32x4 ny[4], nb[4];
    int m = gw;
#define ROW_LOAD(mm) do { _Pragma("unroll") for (int j = 0; j < 4; ++j) { const size_t co = (size_t)(mm) * DM + 512 * j + 8 * lane; ny[j] = ld_once((const u32x4*)(y + co * 2)); nb[j] = ld_once((const u32x4*)(base + co * 2)); } } while (0)
    if (m < M) ROW_LOAD(m);
    for (; m < M; m += NGW) {
        float v[32], bv[32]; float s = 0.f;
#pragma unroll
        for (int j = 0; j < 4; ++j)
#pragma unroll
            for (int q = 0; q < 4; ++q) { v[8 * j + 2 * q] = bflo(ny[j][q]); v[8 * j + 2 * q + 1] = bfhi(ny[j][q]); bv[8 * j + 2 * q] = bflo(nb[j][q]); bv[8 * j + 2 * q + 1] = bfhi(nb[j][q]); }
        if (m + NGW < M) ROW_LOAD(m + NGW);
#pragma unroll
        for (int i = 0; i < 32; ++i) s += v[i] * v[i];
        const float r1 = rsqrtf(wave_sum(s) * (1.0f / DM) + EPS);
#pragma unroll
        for (int j = 0; j < 4; ++j) { const size_t co = 512 * j + 8 * lane; f32x4 o0, o1;
#pragma unroll
            for (int q = 0; q < 4; ++q) { o0[q] = bv[8 * j + q] + v[8 * j + q] * r1 * ga[2 * j][q]; o1[q] = bv[8 * j + 4 + q] + v[8 * j + 4 + q] * r1 * ga[2 * j + 1][q]; }
            __builtin_nontemporal_store(o0, (f32x4*)(out + (size_t)m * DM + co)); __builtin_nontemporal_store(o1, (f32x4*)(out + (size_t)m * DM + co + 4)); }
    }
#undef ROW_LOAD
}

__device__ __forceinline__ void hb_quant(Frame& F, const unsigned char* hb, unsigned char* hq, float* rsh) {
    const int gw = F.bid * 8 + F.wave, NGW = F.G * 8, lane = F.lane;
    u32x4 cur[16], nxt[16];
    int m = gw;
#define HQ_LOAD(dst, mm) do { _Pragma("unroll") for (int j = 0; j < 8; ++j) { dst[2 * j] = ld_once((const u32x4*)(hb + (size_t)(mm) * HBP + 2048 * j + 32 * lane)); \
        dst[2 * j + 1] = ld_once((const u32x4*)(hb + (size_t)(mm) * HBP + 2048 * j + 32 * lane + 16)); } } while (0)
    if (m < M) HQ_LOAD(nxt, m);
    for (; m < M; m += NGW) {
#pragma unroll
        for (int j = 0; j < 16; ++j) cur[j] = nxt[j];
        if (m + NGW < M) HQ_LOAD(nxt, m + NGW);
        float mx = 0.f;
#pragma unroll
        for (int j = 0; j < 16; ++j)
#pragma unroll
            for (int w = 0; w < 4; ++w) mx = fmaxf(mx, fmaxf(bflo(cur[j][w]), bfhi(cur[j][w])));
        mx = wave_max(mx);
        const float q = mx > 0.f ? 255.0f / mx : 0.f;
#define HQ_Q(x) (fminf((x) * q, 255.f) - 128.f)
#pragma unroll
        for (int j = 0; j < 8; ++j) { u32x4 o;
#pragma unroll
            for (int h = 0; h < 2; ++h) { const u32x4 c = cur[2 * j + h];
                o[2 * h] = pack4_i8(HQ_Q(bflo(c.x)), HQ_Q(bfhi(c.x)), HQ_Q(bflo(c.y)), HQ_Q(bfhi(c.y)));
                o[2 * h + 1] = pack4_i8(HQ_Q(bflo(c.z)), HQ_Q(bfhi(c.z)), HQ_Q(bflo(c.w)), HQ_Q(bfhi(c.w))); }
            *(u32x4*)(hq + (size_t)m * DFF + 1024 * j + 16 * lane) = o; }
#undef HQ_Q
        if (lane == 0) rsh[m] = mx * (1.0f / 255.0f);
    }
#undef HQ_LOAD
}

constexpr int NPHASE = 12;
__global__ void __launch_bounds__(512, 2) fwd_mega(const Args args) {
    extern __shared__ __attribute__((aligned(16))) unsigned char lds_raw[];
    const int wv_ = __builtin_amdgcn_readfirstlane((int)threadIdx.x >> 6);
    {
        const int t0 = threadIdx.x;
        for (int u = t0; u < (LDS_BYTES - 131072) / 4; u += 512) ((LAS unsigned*)((LAS unsigned char*)lds_raw + 131072))[u] = 0u;
    }
    __syncthreads();
    const int lo = args.ph_lo, hi = args.ph_hi;
    if (lo < 0) cg::this_grid().sync();
#define IN(k) (lo <= (k) && (k) < hi)
#define BARSETUP() XcdBarrier bar; bar.wv = wv_; bar.bar = (unsigned*)(args.ws + WS_CTL) + 4096; bar.x = xb_xcc_id(); bar.st = (volatile LAS unsigned*)((LAS unsigned char*)lds_raw + MISC_OFF) + 8;
#define SEAM(k) do { if (IN(k) && IN((k) + 1)) { BARSETUP(); for (int rb_ = 0; rb_ < REP_BAR; ++rb_) xcd_barrier(bar); } if (DBG_TS >= 0 && blockIdx.x == 0 && threadIdx.x == 0) ((unsigned long long*)(args.ws + WS_CTL + 65536))[(k) + 1] = __builtin_amdgcn_s_memrealtime(); } while (0)
    if (DBG_TS >= 0 && blockIdx.x == 0 && threadIdx.x == 0) ((unsigned long long*)(args.ws + WS_CTL + 65536))[0] = __builtin_amdgcn_s_memrealtime();
    if (hi - lo > 1) { if (threadIdx.x == 0) (void)xb_add((unsigned*)(args.ws + WS_CTL) + 4096 + XB_XCNT(xb_xcc_id()), 1u); }

    if (IN(0)) { MK_FRAME(F); F.x = args.in[0]; F.p = args.in[1]; F.w_in = args.in[2]; F.b_gates = args.in[3]; F.w_pool = args.in[6]; F.pool_scale = args.in[7]; F.w_out = args.in[8]; F.g_mix_pre = args.in[9];
        F.w_ff1 = args.in[11]; F.w_ff2 = args.in[12]; F.w_ple_proj = args.in[15]; F.w_ple_gate = args.in[16]; F.g_ff_pre = args.in[13]; F.g_ple_gate = args.in[17];
        for (int rep_ = 0; rep_ < REP_P0; ++rep_) { p0_prologue(F); __syncthreads(); }
        p0_first_tokens(F); } SEAM(0);
    if (IN(1)) {
        unsigned char* ws = args.ws;
        { MK_FRAME(F); quant_weight(F, args.in[2] + 2048, INC, DM, 2048, args.in[9], (const float*)(F.ws + WS_CTL + CTL_CM0), (signed char*)(F.ws + WS_WINQ), nullptr, true); }
        { BARSETUP(); xcd_barrier(bar); }
        {   pg8::Gemm g{(const void*)((unsigned char*)args.out + DO_XQ), (const void*)(ws + WS_WINQ), DM, DM, DM, 0}; pg8::StaticOrder S; S.init(M, 2048, gridDim.x, blockIdx.x, WGM_P1);
            pg8::EpiI8Bf16 E{(bf16*)(ws + WS_V), MW, (const float*)(ws + WS_RSX), (const float*)(ws + WS_CTL + CTL_CM0), nullptr, 1024, (size_t)(WS_O - WS_V) / 2};
            for (int rep_ = 0; rep_ < GEMM_REP; ++rep_) pg8::gemm_phase<pg8::EpiI8Bf16, pg8::StaticOrder, true>((LAS unsigned char*)lds_raw, g, S, E, wv_); }
        {   pg8::Gemm g{(const bf16*)(ws + WS_XB), (const bf16*)(ws + WS_WIN), DM, DM, DM, 0}; pg8::StaticOrder S; S.init(M, 2048, gridDim.x, blockIdx.x, WGM_P1);
            pg8::EpiBf16<0> E{(bf16*)(ws + WS_Q), MW, nullptr, 1024, (size_t)(WS_K - WS_Q) / 2, (const float*)(ws + WS_RS0)};
            for (int rep_ = 0; rep_ < GEMM_REP; ++rep_) pg8::gemm_phase((LAS unsigned char*)lds_raw, g, S, E, wv_); }
        {   pg8::Gemm g{(const bf16*)(ws + WS_XB), (const bf16*)(ws + WS_WIN) + (size_t)4096 * DM, DM, DM, DM, 0}; pg8::StaticOrder S; S.init(M, 1024, gridDim.x, blockIdx.x, 8);
            pg8::EpiBf16<0> E{(bf16*)(ws + WS_U), MW, nullptr, 0, 0, (const float*)(ws + WS_RS0)};
            for (int rep_ = 0; rep_ < GEMM_REP; ++rep_) pg8::gemm_phase((LAS unsigned char*)lds_raw, g, S, E, wv_); }
    } SEAM(1);
    if (IN(2)) { MK_FRAME(F); F.w_conv = args.in[4];
        for (int rep_ = 0; rep_ < REP_P2I; ++rep_) p2_items(F);
        for (int rep_ = 0; rep_ < REP_MIX; ++rep_) p2_pooled(F);
        fold_pool(F);
    } SEAM(2);
    if (IN(4)) { MK_FRAME(F); F.g_mlstm = args.in[5]; F.w_conv = args.in[4];
        for (int rep_ = 0; rep_ < REP_P4; ++rep_) p4_phase(F);
    } SEAM(4);
    if (IN(5)) {
        unsigned char* ws = args.ws; unsigned char* ob = (unsigned char*)args.out;
        pg8::Gemm g{(const bf16*)(ob + DO_MIX), (const bf16*)(ws + WS_WOUT), DM, DM, DM, 0}; pg8::StaticOrder S; S.init(M, DM, gridDim.x, blockIdx.x, WGM_P5);
        pg8::EpiBf16<0> E{(bf16*)(ws + WS_A0), DM, nullptr, 0, 0, nullptr};
        for (int rep_ = 0; rep_ < GEMM_REP; ++rep_) pg8::gemm_phase((LAS unsigned char*)lds_raw, g, S, E, wv_);
    } SEAM(5);
    if (IN(6)) { MK_FRAME(F); for (int rep_ = 0; rep_ < REP_ROW; ++rep_) row_resnorm<true, true>(F, F.ws + WS_XB, F.ws + WS_A0, args.in[10], F.ws + WS_H1B, (float*)(F.ws + WS_RS1), (signed char*)(F.ob + DO_H1Q));
        quant_ff1_local(F, args.in[11], args.in[13], (float*)(F.ws + WS_CTL + CTL_CM1), (signed char*)(F.ws + WS_WFF1));
        quant_w2_rows(F, args.in[12], (float*)(F.ws + WS_SK), (signed char*)(F.ws + WS_WFF2), (int*)(F.ws + WS_CTL + CTL_WSUM)); } SEAM(6);
    if (IN(7)) {
        unsigned char* ws = args.ws;
        pg8::Gemm g{(const void*)((unsigned char*)args.out + DO_H1Q), (const void*)(ws + WS_WFF1), DM, DM, DM, 0}; pg8::StaticOrder S; S.init(M, DFF, gridDim.x, blockIdx.x, WGM_P7);
        pg8::EpiI8Relu2 E{(bf16*)(ws + WS_HB), DFF, (const float*)(ws + WS_RS1), (const float*)(ws + WS_CTL + CTL_CM1), (const float*)(ws + WS_SK)};
        for (int rep_ = 0; rep_ < REP_FF1; ++rep_) pg8::gemm_phase<pg8::EpiI8Relu2, pg8::StaticOrder, true>((LAS unsigned char*)lds_raw, g, S, E, wv_);
    } SEAM(7);
    if (IN(8)) {
        unsigned char* ws = args.ws;
        { MK_FRAME(F); hb_quant(F, F.ws + WS_HB, F.ob + DO_HBQ, (float*)(F.ws + WS_RSH)); }
        { BARSETUP(); xcd_barrier(bar); }
        pg8::Gemm g{(const void*)((unsigned char*)args.out + DO_HBQ), (const void*)(ws + WS_WFF2), DFF, DFF, DFF, 0}; pg8::StaticOrder S; S.init(M, DM, gridDim.x, blockIdx.x, WGM_P8, 1);
        pg8::EpiI8Bf16 E{(bf16*)(ws + WS_A0), DM, (const float*)(ws + WS_RSH), nullptr, (const int*)(ws + WS_CTL + CTL_WSUM), 0, 0};
        for (int rep_ = 0; rep_ < REP_FF2; ++rep_) pg8::gemm_phase<pg8::EpiI8Bf16, pg8::StaticOrder, true>((LAS unsigned char*)lds_raw, g, S, E, wv_);
    } SEAM(8);
    if (IN(9)) { MK_FRAME(F); row_resnorm<true>(F, F.ws + WS_H1B, F.ws + WS_A0, args.in[14], F.ws + WS_H2B, (float*)(F.ws + WS_RS2), (signed char*)(F.ws + WS_H2Q));
        quant_weight(F, args.in[16], DM, DM, DM, args.in[17], (const float*)(F.ws + WS_CTL + CTL_CM2), (signed char*)(F.ws + WS_WPG)); } SEAM(9);
    if (IN(10)) {
        unsigned char* ws = args.ws;
        {   pg8::Gemm g{(const bf16*)(ws + WS_PB), (const bf16*)(ws + WS_WPP), PD, PD, PD, 0}; pg8::StaticOrder S; S.init(M, DM, gridDim.x, blockIdx.x, WGM_P10);
            pg8::EpiBf16<0> E{(bf16*)(ws + WS_E), DM, nullptr, 0, 0, nullptr};
            for (int rep_ = 0; rep_ < GEMM_REP; ++rep_) pg8::gemm_phase((LAS unsigned char*)lds_raw, g, S, E, wv_); }
        asm volatile("s_waitcnt vmcnt(0)" ::: "memory"); __syncthreads();
        {   pg8::Gemm g{(const void*)(ws + WS_H2Q), (const void*)(ws + WS_WPG), DM, DM, DM, 0}; pg8::StaticOrder S; S.init(M, DM, gridDim.x, blockIdx.x, WGM_P10);
            pg8::EpiI8GateMul E{(const bf16*)(ws + WS_E), (bf16*)(ws + WS_A0), DM, (const float*)(ws + WS_RS2), (const float*)(ws + WS_CTL + CTL_CM2)};
            for (int rep_ = 0; rep_ < GEMM_REP; ++rep_) pg8::gemm_phase<pg8::EpiI8GateMul, pg8::StaticOrder, true>((LAS unsigned char*)lds_raw, g, S, E, wv_); }
    } SEAM(10);
    if (IN(11)) { MK_FRAME(F); row_final(F, F.ws + WS_H2B, F.ws + WS_A0, args.in[18], F.out); }
    if (DBG_TS >= 0) {
        __syncthreads();
        if (blockIdx.x == 0 && threadIdx.x == 0) { asm volatile("s_waitcnt vmcnt(0)" ::: "memory"); unsigned long long* ts = (unsigned long long*)(args.ws + WS_CTL + 65536); ts[12] = __builtin_amdgcn_s_memrealtime();
            const int k_ = DBG_TS < 12 ? DBG_TS : 0; float us = (float)(DBG_TS < 12 ? (ts[k_ + 1] - ts[k_]) : (ts[12] - ts[0])) * 0.01f; if (DBG_TS == 99) us = 500.f;
            ((float*)(args.ws + WS_CTL + 65536))[64] = (DBG_TS == 99) ? 0.5f : us * DBG_SCALE; }
        { BARSETUP(); xcd_barrier(bar); }
        const float delta = ((const float*)(args.ws + WS_CTL + 65536))[64];
        for (size_t i = (size_t)blockIdx.x * 512 + threadIdx.x; i < (size_t)M * DM / 4; i += (size_t)gridDim.x * 512) { f32x4 v = ((f32x4*)args.out)[i]; v = v + delta; ((f32x4*)args.out)[i] = v; }
    }
#undef IN
#undef SEAM
#undef BARSETUP
}


#ifdef DBG_STOP
struct DbgBuf { const void* p; size_t n; int is_f32; int bit; };
__global__ void __launch_bounds__(512) dbg_scan(DbgBuf b0, DbgBuf b1, DbgBuf b2, DbgBuf b3, DbgBuf b4, DbgBuf b5, unsigned* flag) {
    DbgBuf bs[6] = {b0, b1, b2, b3, b4, b5};
    unsigned mask = 0u;
    for (int k = 0; k < 6; ++k) { const DbgBuf b = bs[k]; if (!b.p) continue; bool bad = false;
        for (size_t i = (size_t)blockIdx.x * 512 + threadIdx.x; i < b.n; i += (size_t)gridDim.x * 512) {
            const float v = b.is_f32 ? ((const float*)b.p)[i] : __uint_as_float(((unsigned)((const unsigned short*)b.p)[i]) << 16);
            if (!(fabsf(v) < 1e30f)) bad = true; }
        if (bad) mask |= 1u << b.bit; }
    if (mask) atomicOr(flag, mask);
}
__global__ void __launch_bounds__(512) dbg_write(float* out, size_t n, const unsigned* flag) {
    for (size_t i = (size_t)blockIdx.x * 512 + threadIdx.x; i < n; i += (size_t)gridDim.x * 512) out[i] = (i == 0) ? 1000.0f * (float)(*flag) : 0.f;
}
#endif
extern "C" void kernel_launch(void* const* d_in, const int* in_sizes, int n_in, void* d_out, int out_size, void* d_ws, size_t ws_size, hipStream_t stream) {
    static int grid = 0;
    if (grid == 0) {
        if (n_in != 19 || out_size != M * DM || ws_size < WS_END) { fprintf(stderr, "kernel_launch: unexpected shapes (n_in %d, out %d, ws %zu)\n", n_in, out_size, ws_size); grid = -1; return; }
        int dev = 0, cus = 0, per_cu = 0;
        if (hipGetDevice(&dev) != hipSuccess || hipDeviceGetAttribute(&cus, hipDeviceAttributeMultiprocessorCount, dev) != hipSuccess) { grid = -1; return; }
        if (hipFuncSetAttribute((const void*)fwd_mega, hipFuncAttributeMaxDynamicSharedMemorySize, LDS_BYTES) != hipSuccess) { fprintf(stderr, "kernel_launch: hipFuncSetAttribute failed\n"); grid = -1; return; }
        if (hipOccupancyMaxActiveBlocksPerMultiprocessor(&per_cu, (const void*)fwd_mega, 512, LDS_BYTES) != hipSuccess || per_cu < 1) { fprintf(stderr, "kernel_launch: occupancy query failed (%d)\n", per_cu); (void)hipGetLastError(); per_cu = 1; }
        grid = cus * (per_cu < 1 ? 1 : per_cu);
        if (grid > 256) grid = 256;
        fprintf(stderr, "kernel_launch: %d CUs, %d blocks/CU by the occupancy query, grid %d\n", cus, per_cu, grid);
    }
    if (grid < 0) return;
    (void)hipMemsetAsync((char*)d_ws + WS_CTL, 0, CTL_BYTES, stream);
    Args a{};
    for (int i = 0; i < 19; ++i) a.in[i] = (const float*)d_in[i];
    a.out = (float*)d_out; a.ws = (unsigned char*)d_ws;
#if N_LAUNCH_MODE == 1
    a.ph_lo = 0; a.ph_hi = NPHASE;
    void* kargs[] = {&a};
    hipError_t e = hipLaunchCooperativeKernel((const void*)fwd_mega, dim3(grid), dim3(512), kargs, LDS_BYTES, stream);
    if (e != hipSuccess) fprintf(stderr, "kernel_launch: cooperative launch failed: %s (grid %d)\n", hipGetErrorString(e), grid);
#else
#ifdef DBG_STOP
    for (int ph = 0; ph < DBG_STOP; ++ph) { a.ph_lo = ph; a.ph_hi = ph + 1; hipLaunchKernelGGL(fwd_mega, dim3(grid), dim3(512), LDS_BYTES, stream, a); }
    { unsigned char* ws = (unsigned char*)d_ws; unsigned char* ob = (unsigned char*)d_out; unsigned* flag = (unsigned*)(ws + WS_CTL) + 100000;
      DBG_BUFS
      hipLaunchKernelGGL(dbg_scan, dim3(1024), dim3(512), 0, stream, B0, B1, B2, B3, B4, B5, flag);
      hipLaunchKernelGGL(dbg_write, dim3(1024), dim3(512), 0, stream, (float*)d_out, (size_t)M * DM, (const unsigned*)flag); }
#else
    for (int ph = 0; ph < NPHASE; ++ph) { a.ph_lo = ph; a.ph_hi = ph + 1; hipLaunchKernelGGL(fwd_mega, dim3(grid), dim3(512), LDS_BYTES, stream, a); }
#endif
#endif
}
```
